# Optimizing an MI355X kernel written in HIP

```python
import math
import jax, jax.numpy as jnp
from jax import lax
import numpy as np

D_MODEL = 2048
BATCH = 16
SEQ = 256
DEPTH = 4
DEC_BATCH = 2
DEC_SEQ = 2048
PAST_LEN = 256

GRID_W = 64
N_HEADS = 8
HEAD_DIM = 128
D_ATT = N_HEADS * HEAD_DIM
D_LRU = D_MODEL // 4
LRU_BLOCKS = 4
LRU_BW = D_LRU // LRU_BLOCKS
LRU_CONV = 4
LRU_C = 8.0
D_SC = D_MODEL // 4
SC_CONV = 3
D_MIX = D_ATT + D_LRU + D_SC
D_IN = 3 * D_ATT + 2 * D_LRU + 3 * D_SC
D_FF = ((-(-8 * D_MODEL // 3)) + 255) // 256 * 256
NA_ROWS = 8
NA_COLS = 16
ATTN_BLOCK = 128
EPS = 1e-6
SPLITS = (D_ATT, 2 * D_ATT, 3 * D_ATT, 3 * D_ATT + D_LRU, 3 * D_ATT + 2 * D_LRU,
          3 * D_ATT + 2 * D_LRU + D_SC, 3 * D_ATT + 2 * D_LRU + 2 * D_SC)

kernel_name = "hybrid_diffusion_prefix_trunk_step"


def rms_norm(x, g):
    xf = x.astype(jnp.float32)
    y = xf * lax.rsqrt(jnp.mean(xf * xf, axis=-1, keepdims=True) + EPS)
    return (y * g.astype(jnp.float32)).astype(x.dtype)


def modulation(cond, w_mod, b_mod):
    m = jnp.dot(jax.nn.silu(cond), w_mod) + b_mod
    return [t[:, None, :] for t in jnp.split(m, 6, axis=-1)]


def dw_conv(x, w, left, right):
    T = x.shape[1]
    xp = jnp.pad(x, ((0, 0), (left, right), (0, 0)))
    out = xp[:, 0:T] * w[0]
    for k in range(1, w.shape[0]):
        out = out + xp[:, k:k + T] * w[k]
    return out


def linear_scan(a, u, h0, reverse):
    if reverse:
        a, u = jnp.flip(a, 1), jnp.flip(u, 1)

    def combine(l, r):
        return l[0] * r[0], r[0] * l[1] + r[1]

    a_cum, b_cum = lax.associative_scan(combine, (a, u), axis=1)
    h = a_cum * h0[:, None, :] + b_cum
    final = h[:, -1]
    if reverse:
        h = jnp.flip(h, 1)
    return h, final


def rglru_mixer(xb, yb, lw, h0):
    bn, t, _ = xb.shape
    xc = dw_conv(xb, lw["lru_conv_w"], LRU_CONV // 2, LRU_CONV - 1 - LRU_CONV // 2) + lw["lru_conv_b"]
    xf = xc.astype(jnp.float32)
    xblk = xf.reshape(bn, t, LRU_BLOCKS, LRU_BW)
    hs, finals = [], []
    for d in range(2):
        r = jax.nn.sigmoid(jnp.einsum('btnk,nkj->btnj', xblk, lw["lru_w_a"][d].astype(jnp.float32)).reshape(bn, t, D_LRU) + lw["lru_b_a"][d].astype(jnp.float32))
        i = jax.nn.sigmoid(jnp.einsum('btnk,nkj->btnj', xblk, lw["lru_w_i"][d].astype(jnp.float32)).reshape(bn, t, D_LRU) + lw["lru_b_i"][d].astype(jnp.float32))
        log_a = -LRU_C * r * jax.nn.softplus(-lw["lru_lambda"][d].astype(jnp.float32))
        a = jnp.exp(log_a)
        u = jnp.sqrt(-jnp.expm1(2.0 * log_a)) * (i * xf)
        h, h_final = linear_scan(a, u, h0[:, d].astype(jnp.float32), reverse=(d == 1))
        hs.append(h)
        finals.append(h_final)
    y = (hs[0] + hs[1]) * jax.nn.gelu(yb.astype(jnp.float32))
    return y.astype(xb.dtype), jnp.stack(finals, axis=1)


def short_conv_mixer(b_gate, c_gate, xs, w):
    return b_gate * dw_conv(c_gate * xs, w, SC_CONV // 2, SC_CONV - 1 - SC_CONV // 2)


def heads(t):
    return t.reshape(t.shape[0], t.shape[1], N_HEADS, HEAD_DIM)


def context_attention(q, k, v):
    bn, length = q.shape[:2]
    scale = HEAD_DIM ** -0.5
    qb = q.reshape(bn, length // ATTN_BLOCK, ATTN_BLOCK, N_HEADS, HEAD_DIM).transpose(1, 0, 2, 3, 4)

    def block(qi):
        s = jnp.einsum('bqhd,bkhd->bhqk', qi, k).astype(jnp.float32) * scale
        p = jax.nn.softmax(s, axis=-1).astype(v.dtype)
        return jnp.einsum('bhqk,bkhd->bqhd', p, v)

    o = lax.map(block, qb)
    return o.transpose(1, 0, 2, 3, 4).reshape(bn, length, N_HEADS, HEAD_DIM)


def neighbourhood_attention(q, k, v, k_ctx, v_ctx, rel_bias):
    bn, n = q.shape[:2]
    rows = n // GRID_W
    kr = min(NA_ROWS, rows)
    scale = HEAD_DIM ** -0.5
    qg = q.reshape(bn, rows, GRID_W, N_HEADS, HEAD_DIM)
    kg = k.reshape(bn, rows, GRID_W, N_HEADS, HEAD_DIM)
    vg = v.reshape(bn, rows, GRID_W, N_HEADS, HEAD_DIM)
    row_start = jnp.clip(jnp.arange(rows) - kr // 2, 0, rows - kr)
    cols = jnp.arange(GRID_W)
    col_start = jnp.clip(cols - NA_COLS // 2, 0, GRID_W - NA_COLS)
    col_idx = col_start[:, None] + jnp.arange(NA_COLS)
    dc_idx = col_idx - cols[:, None] + (NA_COLS - 1)
    n_loc = kr * NA_COLS

    def row_block(r):
        rs = row_start[r]
        q_r = lax.dynamic_index_in_dim(qg, r, axis=1, keepdims=False)
        k_rows = lax.dynamic_slice_in_dim(kg, rs, kr, axis=1)
        v_rows = lax.dynamic_slice_in_dim(vg, rs, kr, axis=1)
        k_win = k_rows[:, :, col_idx]
        v_win = v_rows[:, :, col_idx]
        dr_idx = rs + jnp.arange(kr) - r + (NA_ROWS - 1)
        bias = rel_bias[:, dr_idx][:, :, dc_idx].transpose(0, 2, 1, 3)
        s_loc = jnp.einsum('bqhd,biqjhd->bhqij', q_r, k_win).astype(jnp.float32) * scale + bias.astype(jnp.float32)
        s_loc = s_loc.reshape(bn, N_HEADS, GRID_W, n_loc)
        s_ctx = jnp.einsum('bqhd,bkhd->bhqk', q_r, k_ctx).astype(jnp.float32) * scale
        p = jax.nn.softmax(jnp.concatenate([s_loc, s_ctx], axis=-1), axis=-1).astype(v.dtype)
        p_loc = p[..., :n_loc].reshape(bn, N_HEADS, GRID_W, kr, NA_COLS)
        p_ctx = p[..., n_loc:]
        return (jnp.einsum('bhqij,biqjhd->bqhd', p_loc, v_win)
                + jnp.einsum('bhqk,bkhd->bqhd', p_ctx, v_ctx))

    o = lax.map(row_block, jnp.arange(rows))
    return o.transpose(1, 0, 2, 3, 4).reshape(bn, n, N_HEADS, HEAD_DIM)


def swiglu_ffn(h, g, shift, scale, lw):
    u = rms_norm(h, g) * (1 + scale) + shift
    return jnp.dot(jax.nn.silu(jnp.dot(u, lw["w_ffn_gate"])) * jnp.dot(u, lw["w_ffn_up"]), lw["w_ffn_down"])


def trunk_layer(h, mod, lw, ctx):
    sh1, sc1, g1, sh2, sc2, g2 = mod
    bn, t, _ = h.shape
    u = rms_norm(h, lw["g_mix"]) * (1 + sc1) + sh1
    q, k, v, lx, ly, sb, scg, sx = jnp.split(jnp.dot(u, lw["w_in"]), SPLITS, axis=-1)
    q = rms_norm(heads(q), lw["q_gain"])
    k = rms_norm(heads(k), lw["k_gain"])
    v = heads(v)
    if ctx is None:
        att = context_attention(q, k, v)
        lru, lru_final = rglru_mixer(lx, ly, lw, jnp.zeros((bn, 2, D_LRU), jnp.float32))
    else:
        att = neighbourhood_attention(q, k, v, ctx[0], ctx[1], lw["na_bias"])
        lru, lru_final = rglru_mixer(lx, ly, lw, ctx[2])
    conv = short_conv_mixer(sb, scg, sx, lw["sc_conv_w"])
    mixed = jnp.concatenate([att.reshape(bn, t, D_ATT), lru, conv], axis=-1)
    h = h + g1 * jnp.dot(mixed, lw["w_out"])
    h = h + g2 * swiglu_ffn(h, lw["g_ffn"], sh2, sc2, lw)
    if ctx is None:
        return h, (k, v, lru_final)
    return h, None


def setup_inputs(seed: int = 0) -> dict:
    key = jax.random.key(seed)
    ks = jax.random.split(key, 27)
    nrm = jax.random.normal
    f32 = jnp.float32
    a0 = jax.random.uniform(ks[21], (DEPTH, 2, D_LRU), f32, minval=0.9, maxval=0.999)
    s = a0 ** (1.0 / LRU_C)
    lru_lambda = jnp.log(s) - jnp.log1p(-s)
    return {
        "x_prompt": nrm(ks[0], (BATCH, SEQ, D_MODEL), f32),
        "x_sample": nrm(ks[1], (DEC_BATCH, DEC_SEQ, D_MODEL), f32),
        "cache_k": nrm(ks[2], (DEC_BATCH, DEPTH, PAST_LEN, N_HEADS, HEAD_DIM), f32),
        "cache_v": nrm(ks[3], (DEC_BATCH, DEPTH, PAST_LEN, N_HEADS, HEAD_DIM), f32),
        "state_lru": 0.5 * nrm(ks[4], (DEC_BATCH, DEPTH, 2, D_LRU), f32),
        "c": nrm(ks[5], (DEC_BATCH, D_MODEL), f32),
        "c_ctx": nrm(ks[6], (D_MODEL,), f32),
        "w_mod": 0.3 * D_MODEL ** -0.5 * nrm(ks[7], (DEPTH, D_MODEL, 6 * D_MODEL), f32),
        "b_mod": 0.01 * nrm(ks[8], (DEPTH, 6 * D_MODEL), f32),
        "g_mix": 1.0 + 0.01 * nrm(ks[9], (DEPTH, D_MODEL), f32),
        "g_ffn": 1.0 + 0.01 * nrm(ks[10], (DEPTH, D_MODEL), f32),
        "w_in": D_MODEL ** -0.5 * nrm(ks[11], (DEPTH, D_MODEL, D_IN), f32),
        "q_gain": 1.0 + 0.01 * nrm(ks[12], (DEPTH, HEAD_DIM), f32),
        "k_gain": 1.0 + 0.01 * nrm(ks[13], (DEPTH, HEAD_DIM), f32),
        "na_bias": 0.02 * nrm(ks[14], (DEPTH, N_HEADS, 2 * NA_ROWS - 1, 2 * NA_COLS - 1), f32),
        "lru_conv_w": LRU_CONV ** -0.5 * nrm(ks[15], (DEPTH, LRU_CONV, D_LRU), f32),
        "lru_conv_b": 0.01 * nrm(ks[16], (DEPTH, D_LRU), f32),
        "lru_w_a": LRU_BW ** -0.5 * nrm(ks[17], (DEPTH, 2, LRU_BLOCKS, LRU_BW, LRU_BW), f32),
        "lru_b_a": 0.01 * nrm(ks[18], (DEPTH, 2, D_LRU), f32),
        "lru_w_i": LRU_BW ** -0.5 * nrm(ks[19], (DEPTH, 2, LRU_BLOCKS, LRU_BW, LRU_BW), f32),
        "lru_b_i": 0.01 * nrm(ks[20], (DEPTH, 2, D_LRU), f32),
        "lru_lambda": lru_lambda,
        "sc_conv_w": SC_CONV ** -0.5 * nrm(ks[22], (DEPTH, SC_CONV, D_SC), f32),
        "w_out": D_MIX ** -0.5 * nrm(ks[23], (DEPTH, D_MIX, D_MODEL), f32),
        "w_ffn_gate": D_MODEL ** -0.5 * nrm(ks[24], (DEPTH, D_MODEL, D_FF), f32),
        "w_ffn_up": D_MODEL ** -0.5 * nrm(ks[25], (DEPTH, D_MODEL, D_FF), f32),
        "w_ffn_down": D_FF ** -0.5 * nrm(ks[26], (DEPTH, D_FF, D_MODEL), f32),
    }


def reference(x_prompt, x_sample, cache_k, cache_v, state_lru, c, c_ctx, w_mod, b_mod, g_mix, g_ffn,
              w_in, q_gain, k_gain, na_bias, lru_conv_w, lru_conv_b, lru_w_a, lru_b_a, lru_w_i, lru_b_i,
              lru_lambda, sc_conv_w, w_out, w_ffn_gate, w_ffn_up, w_ffn_down):
    hp = x_prompt
    hs = x_sample
    new_k, new_v, new_s = [], [], []
    for l in range(DEPTH):
        lw = {
            "g_mix": g_mix[l], "g_ffn": g_ffn[l], "w_in": w_in[l], "q_gain": q_gain[l],
            "k_gain": k_gain[l], "na_bias": na_bias[l], "lru_conv_w": lru_conv_w[l],
            "lru_conv_b": lru_conv_b[l], "lru_w_a": lru_w_a[l], "lru_b_a": lru_b_a[l],
            "lru_w_i": lru_w_i[l], "lru_b_i": lru_b_i[l], "lru_lambda": lru_lambda[l],
            "sc_conv_w": sc_conv_w[l], "w_out": w_out[l], "w_ffn_gate": w_ffn_gate[l],
            "w_ffn_up": w_ffn_up[l], "w_ffn_down": w_ffn_down[l],
        }
        mod_ctx = modulation(c_ctx[None, :], w_mod[l], b_mod[l])
        mod_lat = modulation(c, w_mod[l], b_mod[l])
        hp, (k_l, v_l, s_l) = trunk_layer(hp, mod_ctx, lw, None)
        new_k.append(k_l)
        new_v.append(v_l)
        new_s.append(s_l)
        hs, _ = trunk_layer(hs, mod_lat, lw, (cache_k[:, l], cache_v[:, l], state_lru[:, l]))
    new_cache_k = jnp.stack(new_k, axis=1)
    new_cache_v = jnp.stack(new_v, axis=1)
    new_state_lru = jnp.stack(new_s, axis=1)
    return (hp, hs, new_cache_k, new_cache_v, new_state_lru)
```

```cpp
#include <hip/hip_runtime.h>
#include <cstdio>
#include <cstdint>
namespace pg8 {
#define PG8_LAS __attribute__((address_space(3)))
typedef unsigned short bf16_t;
typedef short bf16x8 __attribute__((ext_vector_type(8)));
typedef float f32x4 __attribute__((ext_vector_type(4)));
typedef unsigned u32x4 __attribute__((ext_vector_type(4)));
constexpr int BM = 256, BK = 64, HALF = 128, HTB = HALF * BK * 2  , STAGE_BYTES = 8 * HTB, NXCD = 8, WGM = 8;

__host__ __device__ __forceinline__ int lds_byte(int r, int c) { const int st = (r >> 4) * 2 + (c >> 5), rr = r & 15, cc = c & 31, ob = rr * 64 + cc * 2; return st * 1024 + (ob ^ (((ob >> 9) & 1) << 5)); }
__host__ __device__ __forceinline__ void stage_rc(int b, int& R, int& C) { const int st = b / 1024, sb = b % 1024, swz = sb ^ (((sb >> 9) & 1) << 5); R = (st >> 1) * 16 + swz / 64; C = (st & 1) * 32 + (swz % 64) / 2; }
__host__ __device__ __forceinline__ int perm32(int rho) { const int n = rho >> 4, i = rho & 15; return 8 * (i >> 2) + 4 * n + (i & 3); }

struct Unit { int pm, pn; };
struct Gemm { const bf16_t* A; const bf16_t* Bt; int M, N, K; };

struct StaticOrder {
    int nM, nN, nwg, G, c;
    __host__ __device__ void init(int M, int N, int G_, int c_) { nM = M / BM; nN = N / BM; nwg = nM * nN; G = G_; c = c_; }
    __host__ __device__ bool next(int i, Unit& u) const {
        const long L = (long)i * G + c; if (L >= nwg) return false;
        int wgid = (int)L; { const int q = nwg / NXCD, r = nwg % NXCD, xcd = wgid % NXCD, off = wgid / NXCD; wgid = (xcd < r ? xcd * (q + 1) : r * (q + 1) + (xcd - r) * q) + off; }
        const int nig = WGM * nN, gid = wgid / nig, fm = gid * WGM, gsz = (nM - fm) < WGM ? (nM - fm) : WGM;
        u.pm = fm + ((wgid % nig) % gsz); u.pn = (wgid % nig) / gsz; return true;
    }
    __device__ __forceinline__ void a_ready(const Unit&) const {}
    __device__ __forceinline__ void done(const Unit&) const {}
};

__device__ __forceinline__ void st16(void* p, u32x4 v) { *(u32x4*)p = v; }
__device__ __forceinline__ unsigned cvt_pk_bf16(float lo, float hi) { unsigned r; asm volatile("v_cvt_pk_bf16_f32 %0, %1, %2" : "=v"(r) : "v"(lo), "v"(hi)); return r; }

__device__ __forceinline__ float xl16_sum(float s) { s += __builtin_bit_cast(float, __builtin_amdgcn_ds_swizzle(__builtin_bit_cast(int, s), 0x401f)); float a_ = s, b_ = s; asm volatile("s_nop 1\n\tv_permlane32_swap_b32 %0, %1\n\ts_nop 1" : "+v"(a_), "+v"(b_)); return a_ + b_; }
__device__ __forceinline__ void row_rstd(const float* hssq, int row0, int fq, float (&rs)[2][4]) {
#pragma unroll
    for (int ai = 0; ai < 2; ++ai) { f32x4 p[4][2];
#pragma unroll
        for (int m = 0; m < 4; ++m) { const float* hp = hssq + (size_t)(row0 + ai * HALF + m * 16) * 32 + fq * 8; p[m][0] = *(const f32x4*)hp; p[m][1] = *(const f32x4*)(hp + 4); }
#pragma unroll
        for (int m = 0; m < 4; ++m) { const f32x4 q = p[m][0] + p[m][1]; const float t = xl16_sum((q[0] + q[1]) + (q[2] + q[3])); rs[ai][m] = 1.0f / sqrtf(t * (1.0f / 2048.0f) + 1e-6f); } }
}
constexpr int RTAB_OFF = STAGE_BYTES, RTAB_ROWS = 3840;
struct RstdTab { const PG8_LAS float* tab; int row_lo; bool ok; };
template <class Sched>
__device__ __forceinline__ RstdTab rstd_table(PG8_LAS unsigned char* lds, const Sched& S, const float* hssq, int tid) {
    int lo = 1 << 30, hi = -1; Unit u; for (int i = 0; S.next(i, u); ++i) { lo = u.pm < lo ? u.pm : lo; hi = u.pm > hi ? u.pm : hi; }
    RstdTab T; T.tab = (const PG8_LAS float*)(lds + RTAB_OFF); T.row_lo = lo * BM; T.ok = (hi >= lo) && ((hi - lo + 1) * BM <= RTAB_ROWS);
    if (T.ok) { PG8_LAS float* tw = (PG8_LAS float*)(lds + RTAB_OFF); const int nrows = (hi - lo + 1) * BM;
        for (int r = tid; r < nrows; r += 512) { const f32x4* hp = (const f32x4*)(hssq + (size_t)(T.row_lo + r) * 32); f32x4 q = hp[0];
#pragma unroll
            for (int j = 1; j < 8; ++j) q += hp[j];
            tw[r] = 1.0f / sqrtf(((q[0] + q[1]) + (q[2] + q[3])) * (1.0f / 2048.0f) + 1e-6f); } }
    __syncthreads();
    return T;
}
__device__ __forceinline__ void get_rstd(const RstdTab& T, const float* hssq, int row0, int fq, float (&rs)[2][4]) {
    if (T.ok) {
#pragma unroll
        for (int ai = 0; ai < 2; ++ai)
#pragma unroll
            for (int m = 0; m < 4; ++m) rs[ai][m] = T.tab[row0 + ai * HALF + m * 16 - T.row_lo];
    } else row_rstd(hssq, row0, fq, rs);
}
struct EpiIn {
    static constexpr bool PERM = true, AFTER_DRAIN = false;
    bf16_t* O; float* ssq; float* vout; const float* hssq; const float* shw; RstdTab rt;
    __device__ __forceinline__ void operator()(const f32x4 (&acc)[2][2][4][2], const Unit& u, int wr, int wc, int fr, int fq) const {
        const int row0 = u.pm * BM + wr * 64 + fr, col0 = u.pn * BM + wc * 32 + 8 * fq;
        const int cond = u.pm < 16 ? 0 : (u.pm < 24 ? 1 : 2);
        float rs[2][4]; get_rstd(rt, hssq, row0, fq, rs);
        f32x4 bv[2][2];
#pragma unroll
        for (int bj = 0; bj < 2; ++bj)
#pragma unroll
            for (int n = 0; n < 2; ++n) bv[bj][n] = *(const f32x4*)(shw + (size_t)cond * 5632 + col0 + bj * HALF + 4 * n);
#pragma unroll
        for (int ai = 0; ai < 2; ++ai)
#pragma unroll
            for (int m = 0; m < 4; ++m) { const int row = row0 + ai * HALF + m * 16; bf16_t* rowp = O + (size_t)row * 5632 + col0;
#pragma unroll
                for (int bj = 0; bj < 2; ++bj) { const f32x4 v0 = acc[ai][bj][m][0] * rs[ai][m] + bv[bj][0], v1 = acc[ai][bj][m][1] * rs[ai][m] + bv[bj][1];
                    u32x4 w; w.x = cvt_pk_bf16(v0[0], v0[1]); w.y = cvt_pk_bf16(v0[2], v0[3]); w.z = cvt_pk_bf16(v1[0], v1[1]); w.w = cvt_pk_bf16(v1[2], v1[3]);
                    st16(rowp + bj * HALF, w);
                    if (u.pn < 8) {
                        float s = (v0[0] * v0[0] + v0[1] * v0[1]) + (v0[2] * v0[2] + v0[3] * v0[3]) + (v1[0] * v1[0] + v1[1] * v1[1]) + (v1[2] * v1[2] + v1[3] * v1[3]);
                        s = xl16_sum(s);
                        if (fq == 0) ssq[((size_t)row * 16 + (2 * u.pn + bj)) * 4 + wc] = s;
                    } else if (u.pn < 12 && u.pm < 16) {
                        const int b = row >> 8, t = row & 255, col = col0 + bj * HALF - 2048;
                        float* p = vout + ((size_t)b * 1024 + t) * 1024 + col;
                        __builtin_nontemporal_store(v0, (f32x4*)p); __builtin_nontemporal_store(v1, (f32x4*)(p + 4));
                    } } }
    }
};
struct EpiRes {
    static constexpr bool PERM = true, AFTER_DRAIN = false;
    const float* x_lo; const float* x_hi; const bf16_t* hb_in;
    float* y; bf16_t* hb_out;
    const float* gate;
    const float* gsn; bf16_t* un; float* hssq;
    __device__ __forceinline__ void operator()(const f32x4 (&acc)[2][2][4][2], const Unit& u, int wr, int wc, int fr, int fq) const {
        const int row0 = u.pm * BM + wr * 64 + fr, col0 = u.pn * BM + wc * 32 + 8 * fq;
        const int cond = u.pm < 16 ? 0 : (u.pm < 24 ? 1 : 2);
        f32x4 gv[2][2], gs[2][2];
#pragma unroll
        for (int bj = 0; bj < 2; ++bj)
#pragma unroll
            for (int n = 0; n < 2; ++n) { gv[bj][n] = *(const f32x4*)(gate + (size_t)cond * 12288 + col0 + bj * HALF + 4 * n);
                gs[bj][n] = gsn ? *(const f32x4*)(gsn + (size_t)cond * 2048 + col0 + bj * HALF + 4 * n) : (f32x4){0.f, 0.f, 0.f, 0.f}; }
#pragma unroll
        for (int ai = 0; ai < 2; ++ai)
#pragma unroll
            for (int m = 0; m < 4; ++m) { const int row = row0 + ai * HALF + m * 16; const size_t off = (size_t)row * 2048 + col0;
                float s = 0.f;
#pragma unroll
                for (int bj = 0; bj < 2; ++bj) { f32x4 b0, b1;
                    if (hb_in) { const u32x4 w = *(const u32x4*)(hb_in + off + bj * HALF);
                        b0 = (f32x4){__builtin_bit_cast(float, w.x << 16), __builtin_bit_cast(float, w.x & 0xffff0000u), __builtin_bit_cast(float, w.y << 16), __builtin_bit_cast(float, w.y & 0xffff0000u)};
                        b1 = (f32x4){__builtin_bit_cast(float, w.z << 16), __builtin_bit_cast(float, w.z & 0xffff0000u), __builtin_bit_cast(float, w.w << 16), __builtin_bit_cast(float, w.w & 0xffff0000u)}; }
                    else { const float* bp = (u.pm < 16) ? x_lo + off : x_hi + (off - (size_t)4096 * 2048); b0 = *(const f32x4*)(bp + bj * HALF); b1 = *(const f32x4*)(bp + bj * HALF + 4); }
                    const f32x4 o0 = b0 + gv[bj][0] * acc[ai][bj][m][0], o1 = b1 + gv[bj][1] * acc[ai][bj][m][1];
                    if (hb_out) { u32x4 w; w.x = cvt_pk_bf16(o0[0], o0[1]); w.y = cvt_pk_bf16(o0[2], o0[3]); w.z = cvt_pk_bf16(o1[0], o1[1]); w.w = cvt_pk_bf16(o1[2], o1[3]); st16(hb_out + off + bj * HALF, w); }
                    else { __builtin_nontemporal_store(o0, (f32x4*)(y + off + bj * HALF)); __builtin_nontemporal_store(o1, (f32x4*)(y + off + bj * HALF + 4)); }
                    if (gsn) { s += ((o0[0] * o0[0] + o0[1] * o0[1]) + (o0[2] * o0[2] + o0[3] * o0[3])) + ((o1[0] * o1[0] + o1[1] * o1[1]) + (o1[2] * o1[2] + o1[3] * o1[3]));
                        const f32x4 a0 = o0 * gs[bj][0], a1 = o1 * gs[bj][1];
                        u32x4 w; w.x = cvt_pk_bf16(a0[0], a0[1]); w.y = cvt_pk_bf16(a0[2], a0[3]); w.z = cvt_pk_bf16(a1[0], a1[1]); w.w = cvt_pk_bf16(a1[2], a1[3]); st16(un + off + bj * HALF, w); } }
                if (gsn) { s = xl16_sum(s); if (fq == 0) hssq[(size_t)row * 32 + u.pn * 4 + wc] = s; } }
    }
};
__device__ __forceinline__ float silu_f(float g) { return g * __builtin_amdgcn_rcpf(1.0f + __builtin_amdgcn_exp2f(-1.4426950408889634f * g)); }
struct EpiSwiGLU {
    static constexpr bool PERM = true, AFTER_DRAIN = false;
    bf16_t* O; const float* hssq; const float* shw; RstdTab rt;
    __device__ __forceinline__ void operator()(const f32x4 (&acc)[2][2][4][2], const Unit& u, int wr, int wc, int fr, int fq) const {
        const int row0 = u.pm * BM + wr * 64 + fr, col0 = u.pn * HALF + wc * 32 + 8 * fq, bcol0 = u.pn * BM + wc * 32 + 8 * fq;
        const int cond = u.pm < 16 ? 0 : (u.pm < 24 ? 1 : 2);
        float rs[2][4]; get_rstd(rt, hssq, row0, fq, rs);
        f32x4 bv[2][2];
#pragma unroll
        for (int bj = 0; bj < 2; ++bj)
#pragma unroll
            for (int n = 0; n < 2; ++n) bv[bj][n] = *(const f32x4*)(shw + (size_t)cond * 11264 + bcol0 + bj * HALF + 4 * n);
#pragma unroll
        for (int ai = 0; ai < 2; ++ai)
#pragma unroll
            for (int m = 0; m < 4; ++m) { const float r = rs[ai][m];
                const f32x4 g0 = acc[ai][0][m][0] * r + bv[0][0], g1 = acc[ai][0][m][1] * r + bv[0][1], u0 = acc[ai][1][m][0] * r + bv[1][0], u1 = acc[ai][1][m][1] * r + bv[1][1];
                u32x4 w; w.x = cvt_pk_bf16(silu_f(g0[0]) * u0[0], silu_f(g0[1]) * u0[1]); w.y = cvt_pk_bf16(silu_f(g0[2]) * u0[2], silu_f(g0[3]) * u0[3]);
                w.z = cvt_pk_bf16(silu_f(g1[0]) * u1[0], silu_f(g1[1]) * u1[1]); w.w = cvt_pk_bf16(silu_f(g1[2]) * u1[2], silu_f(g1[3]) * u1[3]);
                st16(O + (size_t)(row0 + ai * HALF + m * 16) * 5632 + col0, w); }
    }
};

template <class Epi, class Sched, bool ALIGN_EPI = false, bool SP2 = false>
__device__ __forceinline__ void gemm_phase(PG8_LAS unsigned char* lds, const Gemm g, const Sched& S, const Epi& E, const int wave_id  ) {
    int wv_ = wave_id; asm volatile("" : "+s"(wv_));
    int tid_ = wv_ * 64 + (int)__builtin_amdgcn_mbcnt_hi(~0u, __builtin_amdgcn_mbcnt_lo(~0u, 0u)); asm volatile("" : "+v"(tid_));
    const int tid = tid_, wid = wv_, lane = tid & 63, wr = wid >> 2, wc = wid & 3, fr = lane & 15, fq = lane >> 4;
    const int K = g.K, nt = K / BK;
    unsigned voffA[2], voffB[2];
#pragma unroll
    for (int i = 0; i < 2; ++i) { int R, C; stage_rc(tid * 16 + i * 8192, R, C); const int Rb = Epi::PERM ? ((R & ~31) + perm32(R & 31)) : R;
        voffA[i] = (unsigned)(R * K + C) * 2u; voffB[i] = (unsigned)(Rb * K + C) * 2u; }
    const size_t kstep = (size_t)(BK * 2);
    const size_t hstep = (size_t)HALF * K * 2;
    const size_t tstep = 2 * hstep;
    const unsigned ldsw = (unsigned)wid * 1024u;
    const int aoff = lds_byte(wr * 64 + fr, fq * 8), boff = lds_byte(wc * 32 + fr, fq * 8);
#define PG8_SA(b, h) (((b) * 2 + (h)) * HTB)
#define PG8_SB(b, h) ((4 + (b) * 2 + (h)) * HTB)
#define PG8_STAGE(bufoff, gbase, voff) do { _Pragma("unroll") for (int _i = 0; _i < 2; ++_i) \
        __builtin_amdgcn_global_load_lds((const unsigned*)((const char*)(gbase) + (voff)[_i]), (PG8_LAS unsigned*)(lds + (bufoff) + ldsw + _i * 8192), 16, 0, 0); } while (0)
#define PG8_LDA(dst, b, h) do { _Pragma("unroll") for (int m = 0; m < 4; ++m) _Pragma("unroll") for (int k = 0; k < 2; ++k) dst[m][k] = *(const PG8_LAS bf16x8*)(lds + PG8_SA(b, h) + aoff + m * 2048 + k * 1024); } while (0)
#define PG8_LDB(dst, b, h) do { _Pragma("unroll") for (int n = 0; n < 2; ++n) _Pragma("unroll") for (int k = 0; k < 2; ++k) dst[n][k] = *(const PG8_LAS bf16x8*)(lds + PG8_SB(b, h) + boff + n * 2048 + k * 1024); } while (0)
#define PG8_MMA(ai, bj, At, Bt) do { __builtin_amdgcn_s_setprio(1); _Pragma("unroll") for (int m = 0; m < 4; ++m) _Pragma("unroll") for (int n = 0; n < 2; ++n) _Pragma("unroll") for (int k = 0; k < 2; ++k) \
        acc[ai][bj][m][n] = __builtin_amdgcn_mfma_f32_16x16x32_bf16(Bt[n][k], At[m][k], acc[ai][bj][m][n], 0, 0, 0); __builtin_amdgcn_s_setprio(0); } while (0)
#define PG8_WAIT_V(n) asm volatile("s_waitcnt vmcnt(" #n ")" ::: "memory")
#define PG8_WAIT_L(n) asm volatile("s_waitcnt lgkmcnt(" #n ")" ::: "memory")
#define PG8_BAR __builtin_amdgcn_s_barrier()
#define PG8_SCHED __builtin_amdgcn_sched_barrier(0)
    Unit cur, nxt; int ui = 0;
    if (!S.next(0, cur)) return;
    f32x4 acc[2][2][4][2];
#pragma unroll
    for (int a = 0; a < 2; ++a)
#pragma unroll
        for (int b = 0; b < 2; ++b)
#pragma unroll
            for (int m = 0; m < 4; ++m)
#pragma unroll
                for (int n = 0; n < 2; ++n) acc[a][b][m][n] = (f32x4){0.f, 0.f, 0.f, 0.f};
    bf16x8 At[4][2], B0[2][2], B1[2][2];
    const char* cA = (const char*)g.A + (size_t)cur.pm * tstep; const char* cB = (const char*)g.Bt + (size_t)cur.pn * tstep;
    S.a_ready(cur);
    if constexpr (SP2) {
        PG8_STAGE(PG8_SB(0, 0), cB, voffB); PG8_STAGE(PG8_SB(0, 1), cB + hstep, voffB); PG8_STAGE(PG8_SA(0, 0), cA, voffA); PG8_STAGE(PG8_SA(0, 1), cA + hstep, voffA);
        if (wr == 1) PG8_BAR;
        PG8_WAIT_V(2); PG8_BAR;
        PG8_STAGE(PG8_SB(1, 0), cB + kstep, voffB); PG8_STAGE(PG8_SA(1, 0), cA + kstep, voffA); PG8_STAGE(PG8_SB(1, 1), cB + hstep + kstep, voffB);
        PG8_WAIT_V(6); PG8_BAR;
    } else {
        PG8_STAGE(PG8_SB(0, 0), cB, voffB); PG8_STAGE(PG8_SA(0, 0), cA, voffA); PG8_STAGE(PG8_SB(0, 1), cB + hstep, voffB); PG8_STAGE(PG8_SA(0, 1), cA + hstep, voffA);
        if (wr == 1) PG8_BAR;
        PG8_WAIT_V(4); PG8_BAR;
        PG8_STAGE(PG8_SB(1, 0), cB + kstep, voffB); PG8_STAGE(PG8_SA(1, 0), cA + kstep, voffA); PG8_STAGE(PG8_SB(1, 1), cB + hstep + kstep, voffB);
        PG8_WAIT_V(6); PG8_BAR;
    }
    for (;;) {
        const bool has_next = S.next(ui + 1, nxt);
        const char* nA = has_next ? (const char*)g.A + (size_t)nxt.pm * tstep : cA; const char* nB = has_next ? (const char*)g.Bt + (size_t)nxt.pn * tstep : cB;
        for (int t = 0; t < nt; t += 2) {
            const bool last = (t == nt - 2);
            const char* a1 = cA + (size_t)(t + 1) * kstep;
            const char* a2 = last ? nA : cA + (size_t)(t + 2) * kstep; const char* b2 = last ? nB : cB + (size_t)(t + 2) * kstep;
            const char* a3 = a2 + kstep; const char* b3 = b2 + kstep;
            if (last && has_next) S.a_ready(nxt);
            if constexpr (SP2) {
            PG8_LDB(B0, 0, 0); PG8_LDB(B1, 0, 1); PG8_SCHED; PG8_LDA(At, 0, 0); PG8_STAGE(PG8_SA(1, 1), a1 + hstep, voffA);
            PG8_WAIT_V(8); PG8_WAIT_L(0); PG8_BAR; PG8_MMA(0, 0, At, B0); PG8_MMA(0, 1, At, B1); PG8_BAR; PG8_SCHED;
            PG8_LDA(At, 0, 1); PG8_STAGE(PG8_SB(0, 0), b2, voffB); PG8_STAGE(PG8_SB(0, 1), b2 + hstep, voffB); PG8_STAGE(PG8_SA(0, 0), a2, voffA);
            PG8_WAIT_V(8); PG8_WAIT_L(0); PG8_BAR; PG8_MMA(1, 0, At, B0); PG8_MMA(1, 1, At, B1); PG8_BAR; PG8_SCHED;
            PG8_LDB(B0, 1, 0); PG8_LDB(B1, 1, 1); PG8_SCHED; PG8_LDA(At, 1, 0); PG8_STAGE(PG8_SA(0, 1), a2 + hstep, voffA);
            PG8_WAIT_V(8); PG8_WAIT_L(0); PG8_BAR; PG8_MMA(0, 0, At, B0); PG8_MMA(0, 1, At, B1); PG8_BAR; PG8_SCHED;
            PG8_LDA(At, 1, 1); PG8_STAGE(PG8_SB(1, 0), b3, voffB); PG8_STAGE(PG8_SB(1, 1), b3 + hstep, voffB); PG8_STAGE(PG8_SA(1, 0), a3, voffA);
            PG8_WAIT_V(8); PG8_WAIT_L(0); PG8_BAR; PG8_MMA(1, 0, At, B0); PG8_MMA(1, 1, At, B1); PG8_BAR; PG8_SCHED;
            } else {
            PG8_LDB(B0, 0, 0); PG8_SCHED; PG8_LDA(At, 0, 0); PG8_STAGE(PG8_SA(1, 1), a1 + hstep, voffA);
            PG8_WAIT_L(8); PG8_BAR; PG8_WAIT_L(0); PG8_MMA(0, 0, At, B0); PG8_BAR; PG8_SCHED;
            PG8_LDB(B1, 0, 1); PG8_STAGE(PG8_SB(0, 0), b2, voffB);
            PG8_BAR; PG8_WAIT_L(0); PG8_MMA(0, 1, At, B1); PG8_BAR;
            PG8_LDA(At, 0, 1); PG8_STAGE(PG8_SA(0, 0), a2, voffA);
            PG8_BAR; PG8_WAIT_L(0); PG8_MMA(1, 0, At, B0); PG8_BAR; PG8_SCHED;
            PG8_STAGE(PG8_SB(0, 1), b2 + hstep, voffB);
            PG8_WAIT_V(6); PG8_BAR; PG8_MMA(1, 1, At, B1); PG8_BAR;
            PG8_LDB(B0, 1, 0); PG8_SCHED; PG8_LDA(At, 1, 0); PG8_STAGE(PG8_SA(0, 1), a2 + hstep, voffA);
            PG8_WAIT_L(8); PG8_BAR; PG8_WAIT_L(0); PG8_MMA(0, 0, At, B0); PG8_BAR; PG8_SCHED;
            PG8_LDB(B1, 1, 1); PG8_STAGE(PG8_SB(1, 0), b3, voffB);
            PG8_BAR; PG8_WAIT_L(0); PG8_MMA(0, 1, At, B1); PG8_BAR;
            PG8_LDA(At, 1, 1); PG8_STAGE(PG8_SA(1, 0), a3, voffA);
            PG8_BAR; PG8_WAIT_L(0); PG8_MMA(1, 0, At, B0); PG8_BAR; PG8_SCHED;
            PG8_STAGE(PG8_SB(1, 1), b3 + hstep, voffB);
            PG8_WAIT_V(6); PG8_BAR; PG8_MMA(1, 1, At, B1); PG8_BAR;
            }
        }
        if constexpr (ALIGN_EPI) { if (wr == 0) PG8_BAR; }
        if constexpr (!Epi::AFTER_DRAIN) { E(acc, cur, wr, wc, fr, fq); S.done(cur); }
        if (!has_next) break;
#pragma unroll
        for (int a = 0; a < 2; ++a)
#pragma unroll
            for (int b = 0; b < 2; ++b)
#pragma unroll
                for (int m = 0; m < 4; ++m)
#pragma unroll
                    for (int n = 0; n < 2; ++n) acc[a][b][m][n] = (f32x4){0.f, 0.f, 0.f, 0.f};
        cur = nxt; cA = nA; cB = nB; ++ui;
        if constexpr (ALIGN_EPI) { if (wr == 1) PG8_BAR; }
    }
    PG8_WAIT_V(0);
    if constexpr (!ALIGN_EPI) { if (wr == 0) PG8_BAR; }
    PG8_BAR;
    if constexpr (Epi::AFTER_DRAIN) { E.fused(acc, cur, wr, wc, fr, fq, lds, wid, lane); S.done(cur); }
#undef PG8_SA
#undef PG8_SB
#undef PG8_STAGE
#undef PG8_LDA
#undef PG8_LDB
#undef PG8_MMA
#undef PG8_WAIT_V
#undef PG8_WAIT_L
#undef PG8_BAR
#undef PG8_SCHED
}
}

constexpr int DM = 2048, NCTX = 4096, NLAT = 4096, MTOK = 8192, DEPTH = 4, SEQ = 256, DSEQ = 2048, NB = 16, DB = 2;
constexpr int DIN = 5632, DFF = 5632, DATT = 1024, DLRU = 512, DSC = 512, NH = 8, HD = 128, GW = 64;
constexpr int C_Q = 0, C_K = 1024, C_V = 2048, C_LX = 3072, C_LY = 3584, C_SB = 4096, C_SCG = 4608, C_SX = 5120;
constexpr float EPS = 1e-6f;
constexpr int NWAVES = 8;
#ifndef MK_MODE
#define MK_MODE 0
#endif
constexpr int STEPS_PER_LAYER = 5, NPRO = 4, NSTEPS = NPRO + DEPTH * STEPS_PER_LAYER;

constexpr size_t OUT_Y = 0, OUT_K = (size_t)MTOK * DM, OUT_V = OUT_K + (size_t)NB * DEPTH * SEQ * DATT, OUT_S = OUT_V + (size_t)NB * DEPTH * SEQ * DATT, OUT_END = OUT_S + (size_t)NB * DEPTH * 2 * DLRU;

constexpr size_t MiB = 1u << 20;
constexpr size_t WS_CTL = 0, CTL_ZERO_BYTES = 1 * MiB;
constexpr size_t WS_MOD  = 1 * MiB;
constexpr size_t WS_MODP = 2 * MiB;
constexpr size_t WS_WIN  = 24 * MiB;
constexpr size_t WS_WOUT = WS_WIN + (size_t)DEPTH * DIN * DM * 2;
constexpr size_t WS_WGU  = WS_WOUT + (size_t)DEPTH * DM * DM * 2;
constexpr size_t WS_WDN  = WS_WGU + (size_t)DEPTH * 2 * DFF * DM * 2;
constexpr size_t WS_U    = WS_WDN + (size_t)DEPTH * DM * DFF * 2;
constexpr size_t WS_XIN  = WS_U + (size_t)MTOK * DM * 2;
constexpr size_t WS_ACT  = WS_XIN;
constexpr size_t WS_MIX  = WS_XIN + (size_t)MTOK * DIN * 2;
constexpr size_t WS_SSQ  = WS_MIX + (size_t)MTOK * DM * 2;
constexpr size_t WS_END  = WS_SSQ + (size_t)MTOK * 64 * 4;
constexpr int CW_BAR = 4096;

constexpr int RING_OFF = 0, RING_BYTES = 131072, LDS_BYTES = 147456, LDSCTL_OFF = LDS_BYTES - 512  , MISC_OFF = LDSCTL_OFF + 320;

#define GAS __attribute__((address_space(1)))
#define LAS __attribute__((address_space(3)))
typedef unsigned short bf16;
typedef unsigned v4u __attribute__((ext_vector_type(4)));
typedef float f32x4 __attribute__((ext_vector_type(4)));
typedef GAS unsigned gu32;
#define RLX_AGENT __ATOMIC_RELAXED, __HIP_MEMORY_SCOPE_AGENT
#define LDS_WAIT() asm volatile("s_waitcnt lgkmcnt(0)" ::: "memory")
#define VM_WAIT() asm volatile("s_waitcnt vmcnt(0)" ::: "memory")
__device__ __forceinline__ unsigned f2bf(float f) { unsigned u = __builtin_bit_cast(unsigned, f); return (u + 0x7fffu + ((u >> 16) & 1u)) >> 16; }
__device__ __forceinline__ unsigned pk2(float lo, float hi) { return f2bf(lo) | (f2bf(hi) << 16); }
__device__ __forceinline__ float bflo(unsigned w) { return __builtin_bit_cast(float, w << 16); }
__device__ __forceinline__ float bfhi(unsigned w) { return __builtin_bit_cast(float, w & 0xffff0000u); }
__device__ __forceinline__ float bf2f(bf16 b) { return __builtin_bit_cast(float, ((unsigned)b) << 16); }

#define XB_TMO      128
#define XB_XCNT(j)  (256  + 64 * (j))
#define XB_XSUB(j)  (1280 + 64 * (j))
#define XB_XGEN(j)  (2304 + 64 * (j))
#define XB_TOP      3328
#define XB_TOPGEN   3392
#define XCD_BAR_WORDS 3456
#define XB_SPIN_CAP (1u << 18)

__device__ __forceinline__ unsigned xb_ld(unsigned* p)              { return __hip_atomic_load(p, __ATOMIC_RELAXED, __HIP_MEMORY_SCOPE_AGENT); }
__device__ __forceinline__ unsigned xb_add(unsigned* p, unsigned v) { return __hip_atomic_fetch_add(p, v, __ATOMIC_RELAXED, __HIP_MEMORY_SCOPE_AGENT); }
__device__ __forceinline__ unsigned xb_xcc_id() { return (unsigned)__builtin_amdgcn_s_getreg((3 << 11) | 20) & 0xFu; }
#define XB_SPIN(cond, bar) do { unsigned _sp = 0; while (cond) { __builtin_amdgcn_s_sleep(1); \
    if ((++_sp & 255u) == 0u) { if (xb_ld(&(bar)[XB_TMO])) break; if (_sp > XB_SPIN_CAP) { atomicAdd(&(bar)[XB_TMO], 1u); break; } } } } while (0)

struct XcdBarrier {
    unsigned* bar; unsigned x;
    volatile LAS unsigned* st;
};

__device__ __forceinline__ XcdBarrier xcd_barrier_post(unsigned* bar, volatile LAS unsigned* st) {
    XcdBarrier b; b.bar = bar; b.x = xb_xcc_id(); b.st = st;
    if (threadIdx.x == 0) (void)xb_add(&bar[XB_XCNT(b.x)], 1u);
    return b;
}
__device__ __forceinline__ void xcd_barrier_complete(unsigned* bar, unsigned x, unsigned& nloc, unsigned& nx) {
    const unsigned G = gridDim.x * gridDim.y * gridDim.z;
    unsigned sum, cnt, mine, sp = 0u;
    for (;;) {
        sum = 0u; cnt = 0u; mine = 0u;
#pragma unroll
        for (unsigned j = 0; j < 16; ++j) { const unsigned c = xb_ld(&bar[XB_XCNT(j)]); sum += c; cnt += (c > 0u) ? 1u : 0u; mine = (j == x) ? c : mine; }
        if (sum == G) break;
        __builtin_amdgcn_s_sleep(1);
        if ((++sp & 255u) == 0u) { if (xb_ld(&bar[XB_TMO])) break; if (sp > XB_SPIN_CAP) { atomicAdd(&bar[XB_TMO], 1u); break; } }
    }
    nloc = mine > 0u ? mine : 1u; nx = cnt > 0u ? cnt : 1u;
}

__device__ __forceinline__ void xcd_barrier(const XcdBarrier& b) {
    asm volatile("s_waitcnt vmcnt(0)" ::: "memory");
    __syncthreads();
    if (threadIdx.x == 0) {
        unsigned* bar = b.bar;
        __builtin_amdgcn_s_waitcnt(0);
        unsigned nloc = b.st[0], nx = b.st[1];
        if (nloc == 0u) { xcd_barrier_complete(bar, b.x, nloc, nx); b.st[0] = nloc; b.st[1] = nx; }
        const unsigned old = xb_add(&bar[XB_XSUB(b.x)], 1u);
        const unsigned gen = old / nloc;
        if (old + 1u == (gen + 1u) * nloc) {
            __builtin_amdgcn_fence(__ATOMIC_RELEASE, "agent");
            asm volatile("s_waitcnt vmcnt(0)" ::: "memory");
            const unsigned og = xb_add(&bar[XB_TOP], 1u);
            const unsigned tg = og / nx;
            if (og + 1u == (tg + 1u) * nx) xb_add(&bar[XB_TOPGEN], 1u);
            else XB_SPIN(xb_ld(&bar[XB_TOPGEN]) == tg, bar);
            __builtin_amdgcn_fence(__ATOMIC_ACQUIRE, "agent");
            xb_add(&bar[XB_XGEN(b.x)], 1u);
            asm volatile("s_waitcnt vmcnt(0)" ::: "memory");
        } else {
            XB_SPIN(xb_ld(&bar[XB_XGEN(b.x)]) == gen, bar);
            __builtin_amdgcn_fence(__ATOMIC_ACQUIRE, "agent");
            asm volatile("s_waitcnt vmcnt(0)" ::: "memory");
        }
    }
    __syncthreads();
}

struct Args { const float* in[27]; float* out; unsigned char* ws; int ph_lo, ph_hi; };
typedef const __attribute__((address_space(4))) Args* ArgsP;
struct Ctx { LAS unsigned char* lds; int tid, lane, wave, G, gw, ngw, gt, ngt; };
enum { I_XP = 0, I_XS, I_CK, I_CV, I_ST, I_C, I_CCTX, I_WMOD, I_BMOD, I_GMIX, I_GFFN, I_WIN, I_QG, I_KG, I_NAB, I_LCW, I_LCB, I_LWA, I_LBA, I_LWI, I_LBI, I_LAM, I_SCW, I_WOUT, I_WG, I_WU, I_WD };

template <int XM> __device__ __forceinline__ float swz_xor(float v) { return __builtin_bit_cast(float, __builtin_amdgcn_ds_swizzle(__builtin_bit_cast(int, v), 0x1f | (XM << 10))); }
__device__ __forceinline__ void swap32(float v, float& own, float& other) { own = v; other = v; asm volatile("s_nop 1\n\tv_permlane32_swap_b32 %0, %1\n\ts_nop 1" : "+v"(own), "+v"(other)); }
__device__ __forceinline__ float xor32_sum(float v) { float a, b; swap32(v, a, b); return a + b; }
__device__ __forceinline__ float xor32_max(float v) { float a, b; swap32(v, a, b); return fmaxf(a, b); }
__device__ __forceinline__ float wave_sum(float v) { v += swz_xor<1>(v); v += swz_xor<2>(v); v += swz_xor<4>(v); v += swz_xor<8>(v); v += swz_xor<16>(v); return xor32_sum(v); }
__device__ __forceinline__ float bperm(float v, int byte_idx) { return __builtin_bit_cast(float, __builtin_amdgcn_ds_bpermute(byte_idx, __builtin_bit_cast(int, v))); }

struct ConvItem { const float* W; bf16* WT; const LAS float* sh; float* shwp; int K, N, k0, n0, drow0, ntot; };
__device__ __forceinline__ void conv_load(const ConvItem& d, int lane, float (&v)[32]) {
    const float* wp = d.W + (size_t)(d.k0 + (lane >> 5)) * d.N + d.n0 + (lane & 31);
#pragma unroll
    for (int i = 0; i < 32; ++i) v[i] = __builtin_nontemporal_load(wp + (size_t)(2 * i) * d.N);
}
__device__ __forceinline__ void conv_process(const ConvItem& d, int lane, const float (&v)[32], LAS float* scr) {
#pragma unroll
    for (int i = 0; i < 32; ++i) scr[(2 * i + (lane >> 5)) * 33 + (lane & 31)] = v[i];
    LDS_WAIT(); asm volatile("" ::: "memory");
    const int c = lane & 7;
#pragma unroll
    for (int j = 0; j < 4; ++j) { const int n = (lane >> 3) + 8 * j; const LAS float* s = scr + (8 * c) * 33 + n;
        v4u o; o.x = pk2(s[0 * 33], s[1 * 33]); o.y = pk2(s[2 * 33], s[3 * 33]); o.z = pk2(s[4 * 33], s[5 * 33]); o.w = pk2(s[6 * 33], s[7 * 33]);
        __builtin_nontemporal_store(o, (v4u*)(d.WT + (size_t)(d.drow0 + n) * d.K + d.k0 + 8 * c)); }
    if (d.sh) {
        const int n = lane & 31, hf = lane >> 5; float a0 = 0.f, a1 = 0.f, a2 = 0.f;
#pragma unroll
        for (int q = 0; q < 8; ++q) { const int kk = hf * 32 + q * 4; const LAS float* sp = d.sh + d.k0 + kk;
            const f32x4 s0 = *(const LAS f32x4*)sp, s1 = *(const LAS f32x4*)(sp + 2048), s2 = *(const LAS f32x4*)(sp + 4096);
#pragma unroll
            for (int j = 0; j < 4; ++j) { const float w = scr[(kk + j) * 33 + n]; a0 += s0[j] * w; a1 += s1[j] * w; a2 += s2[j] * w; } }
        a0 = xor32_sum(a0); a1 = xor32_sum(a1); a2 = xor32_sum(a2);
        if (lane < 32) { d.shwp[d.drow0 + n] = a0; d.shwp[(size_t)d.ntot + d.drow0 + n] = a1; d.shwp[2 * (size_t)d.ntot + d.drow0 + n] = a2; }
    }
    LDS_WAIT(); asm volatile("" ::: "memory");
}
typedef short bf16x8_t __attribute__((ext_vector_type(8)));
constexpr int XC_STRIDE = 272;
__device__ __forceinline__ int xaddr(int row, int colb) { return row * XC_STRIDE + (colb ^ (((row >> 4) & 3) << 6)); }
constexpr size_t WS_WFRAG = WS_END;
constexpr size_t WS_CKB   = WS_WFRAG + (size_t)DEPTH * 2 * 4 * 2 * 8 * 4 * 64 * 16;
constexpr size_t WS_CVB   = WS_CKB + (size_t)DB * DEPTH * 256 * 1024 * 2;
constexpr size_t WS_END2  = WS_CVB + (size_t)DB * DEPTH * 256 * 1024 * 2;
constexpr size_t WS_HSSQ  = WS_END2;
constexpr size_t WS_GS    = WS_HSSQ + (size_t)MTOK * 32 * 4;
constexpr size_t WS_SHWI  = WS_GS + (size_t)DEPTH * 2 * 3 * DM * 4;
constexpr size_t WS_SHWG  = WS_SHWI + (size_t)DEPTH * 3 * DIN * 4;
constexpr size_t WS_SHPI  = WS_SHWG + (size_t)DEPTH * 3 * 2 * DFF * 4;
constexpr size_t WS_SHPG  = WS_SHPI + (size_t)DEPTH * 32 * 3 * DIN * 4;
constexpr size_t WS_HB    = WS_SHPG + (size_t)DEPTH * 32 * 3 * 2 * DFF * 4;
constexpr size_t WS_END2B = WS_HB + (size_t)MTOK * DM * 2;
constexpr size_t WS_END3  = WS_END2B;

constexpr size_t CTL_GRAN = 262144;
typedef __attribute__((address_space(1))) unsigned long long gu64_t;
__device__ __forceinline__ void gran_store(gu64_t* g, unsigned tag, float v) { __hip_atomic_store(g, ((unsigned long long)tag << 32) | __builtin_bit_cast(unsigned, v), __ATOMIC_RELAXED, __HIP_MEMORY_SCOPE_AGENT); }
struct Aff { float a, b; };
__device__ __forceinline__ Aff aff_then(const Aff first, const Aff second) { Aff r; r.a = second.a * first.a; r.b = second.a * first.b + second.b; return r; }

__device__ __forceinline__ void lru_gate(float pa, float pi, float x, float sp8l, float& a, float& u) {
    const float L2E = 1.4426950408889634f;
    const float r = __builtin_amdgcn_rcpf(1.0f + __builtin_amdgcn_exp2f(-L2E * pa)), ig = __builtin_amdgcn_rcpf(1.0f + __builtin_amdgcn_exp2f(-L2E * pi));
    a = __builtin_amdgcn_exp2f(sp8l * r);
    const float em = fmaf(-a, a, 1.0f);
    u = __builtin_amdgcn_sqrtf(em) * (ig * x);
}
constexpr int S_OFF = 256 * XC_STRIDE, S_STRIDE = 68;
static_assert(S_OFF + 256 * S_STRIDE * 4 <= LDSCTL_OFF, "LRU LDS tiles below the control words");
__device__ __forceinline__ float gelu_fast(float x) { const float z = 0.7978845608028654f * (x + 0.044715f * x * x * x); return x * __builtin_amdgcn_rcpf(1.0f + __builtin_amdgcn_exp2f(-2.8853900817779268f * z)); }
template <bool FULL>
__device__ __forceinline__ void lru_unit(ArgsP A, const Ctx& C, int l, int sq  , int chunk, int n, int hh, float* outw) {
    const bf16* XIN = (const bf16*)(A->ws + WS_XIN); bf16* MIX = (bf16*)(A->ws + WS_MIX);
    const int T = sq < NB ? SEQ : DSEQ, tlo = chunk * 256, row0 = (sq < NB ? sq * SEQ : NCTX + (sq - NB) * DSEQ) + tlo;
    LAS unsigned char* xl = C.lds;
    LAS float* S = (LAS float*)(C.lds + S_OFF);
    const int tid = C.tid, lane = C.lane, w = C.wave, fr = lane & 15, fq = lane >> 4;
    v4u lyv[4];
    if (FULL) {
#pragma unroll
        for (int k = 0; k < 4; ++k) { const int it = tid + 512 * k, tok = it >> 3, c8 = (it & 7) * 8; lyv[k] = *(const v4u*)(XIN + (size_t)(row0 + tok) * DIN + C_LY + n * 128 + hh * 64 + c8); }
    }
    {
        const int c8 = (tid & 15) * 8, chb = n * 128 + c8; float wt[4][8], bb[8];
#pragma unroll
        for (int i = 0; i < 8; ++i) bb[i] = A->in[I_LCB][l * DLRU + chb + i];
#pragma unroll
        for (int dk = 0; dk < 4; ++dk)
#pragma unroll
            for (int i = 0; i < 8; ++i) wt[dk][i] = A->in[I_LCW][(l * 4 + dk) * DLRU + chb + i];
#pragma unroll
        for (int q = 0; q < 2; ++q) {
            const int tb = 4 * (tid >> 4) + 128 * q;
            v4u xr[7];
#pragma unroll
            for (int j = 0; j < 7; ++j) { const int tt = tlo + tb + j - 2; xr[j] = (v4u){0u, 0u, 0u, 0u}; if (tt >= 0 && tt < T) xr[j] = *(const v4u*)(XIN + (size_t)(row0 + tb + j - 2) * DIN + C_LX + chb); }
#pragma unroll
            for (int t4 = 0; t4 < 4; ++t4) { float xc[8];
#pragma unroll
                for (int i = 0; i < 8; ++i) xc[i] = bb[i];
#pragma unroll
                for (int dk = 0; dk < 4; ++dk) { const v4u x = xr[t4 + dk];
                    xc[0] += wt[dk][0] * bflo(x.x); xc[1] += wt[dk][1] * bfhi(x.x); xc[2] += wt[dk][2] * bflo(x.y); xc[3] += wt[dk][3] * bfhi(x.y);
                    xc[4] += wt[dk][4] * bflo(x.z); xc[5] += wt[dk][5] * bfhi(x.z); xc[6] += wt[dk][6] * bflo(x.w); xc[7] += wt[dk][7] * bfhi(x.w); }
                v4u o; o.x = pk2(xc[0], xc[1]); o.y = pk2(xc[2], xc[3]); o.z = pk2(xc[4], xc[5]); o.w = pk2(xc[6], xc[7]);
                *(LAS v4u*)(xl + xaddr(tb + t4, c8 * 2)) = o; }
        }
    }
    __syncthreads();
    const int d = w >> 2, cg = w & 3, wq = 4 * hh + cg, ch = n * 128 + wq * 16 + fr;
    const bf16x8_t* wfrag = (const bf16x8_t*)(A->ws + WS_WFRAG); gu64_t* gran = (gu64_t*)(A->ws + WS_CTL + CTL_GRAN); const unsigned tag = (unsigned)l + 1u;
    bf16x8_t bfr[2][4];
#pragma unroll
    for (int g = 0; g < 2; ++g)
#pragma unroll
        for (int ks = 0; ks < 4; ++ks) bfr[g][ks] = wfrag[((((((size_t)l * 2 + d) * 4 + n) * 2 + g) * 8 + wq) * 4 + ks) * 64 + lane];
    const float ba = A->in[I_LBA][(l * 2 + d) * DLRU + ch], bi = A->in[I_LBI][(l * 2 + d) * DLRU + ch];
    const float sp8 = -8.0f * 1.4426950408889634f * log1pf(expf(-A->in[I_LAM][(l * 2 + d) * DLRU + ch]));
    float hrun = 0.f; Aff run; run.a = 1.f; run.b = 0.f;
    if (FULL && sq >= NB) {
        const int b = sq - NB; float h = A->in[I_ST][((b * DEPTH + l) * 2 + d) * DLRU + ch];
        float ga[8], gb[8];
        for (unsigned spins = 0; spins < (1u << 20); ++spins) { bool ok = true;
#pragma unroll
            for (int c2 = 0; c2 < 8; ++c2) { const bool need = (d == 0) ? (c2 < chunk) : (c2 > chunk); ga[c2] = 1.f; gb[c2] = 0.f;
                if (need) { gu64_t* sp = gran + ((((size_t)b * 8 + c2) * 2 + d) * DLRU + ch) * 2;
                    const unsigned long long x0 = __hip_atomic_load(sp, __ATOMIC_RELAXED, __HIP_MEMORY_SCOPE_AGENT), x1 = __hip_atomic_load(sp + 1, __ATOMIC_RELAXED, __HIP_MEMORY_SCOPE_AGENT);
                    ok = ok && ((unsigned)(x0 >> 32) == tag) && ((unsigned)(x1 >> 32) == tag); ga[c2] = __builtin_bit_cast(float, (unsigned)x0); gb[c2] = __builtin_bit_cast(float, (unsigned)x1); } }
            if (__all(ok)) break;
            __builtin_amdgcn_s_sleep(2); }
#pragma unroll
        for (int k = 0; k < 8; ++k) { const int c2 = (d == 0) ? k : 7 - k; h = ga[c2] * h + gb[c2]; }
        hrun = h;
    }
    const int up16 = ((lane - 16) & 63) * 4, up32 = ((lane - 32) & 63) * 4, last = (48 + fr) * 4;
    const int taur = 16 * (fr >> 2) + (fr & 3);
#pragma unroll 1
    for (int half = 0; half < 2; ++half) {
#pragma unroll 1
        for (int k = 0; k < 2; ++k) {
            const int si = half * 2 + k, st = d ? 3 - si : si;
            f32x4 accA[4], accI[4];
#pragma unroll
            for (int j = 0; j < 4; ++j) { accA[j] = (f32x4){0.f, 0.f, 0.f, 0.f}; accI[j] = accA[j];
                const int trow = d ? 64 * st + 63 - (taur + 4 * j) : 64 * st + taur + 4 * j;
#pragma unroll
                for (int ks = 0; ks < 4; ++ks) { const bf16x8_t af = *(const LAS bf16x8_t*)(xl + xaddr(trow, (32 * ks + 8 * fq) * 2));
                    accA[j] = __builtin_amdgcn_mfma_f32_16x16x32_bf16(af, bfr[0][ks], accA[j], 0, 0, 0); accI[j] = __builtin_amdgcn_mfma_f32_16x16x32_bf16(af, bfr[1][ks], accI[j], 0, 0, 0); } }
            const int tok0 = d ? 64 * st + 63 - 16 * fq : 64 * st + 16 * fq, tstep = d ? -1 : 1;
            float a[16], u[16];
#pragma unroll
            for (int j = 0; j < 4; ++j)
#pragma unroll
                for (int i = 0; i < 4; ++i) { const int n2 = 4 * j + i; const float x = bf2f(*(const LAS bf16*)(xl + xaddr(tok0 + n2 * tstep, (wq * 16 + fr) * 2))); lru_gate(accA[j][i] + ba, accI[j][i] + bi, x, sp8, a[n2], u[n2]); }
            Aff L; L.a = 1.f; L.b = 0.f;
#pragma unroll
            for (int n2 = 0; n2 < 16; ++n2) { L.b = a[n2] * L.b + u[n2]; L.a = a[n2] * L.a; }
            Aff I = L;
            { Aff Q; Q.a = bperm(I.a, up16); Q.b = bperm(I.b, up16); const Aff J = aff_then(Q, I); const bool has = fq >= 1; I.a = has ? J.a : I.a; I.b = has ? J.b : I.b; }
            { Aff Q; Q.a = bperm(I.a, up32); Q.b = bperm(I.b, up32); const Aff J = aff_then(Q, I); const bool has = fq >= 2; I.a = has ? J.a : I.a; I.b = has ? J.b : I.b; }
            Aff E; E.a = bperm(I.a, up16); E.b = bperm(I.b, up16); if (fq == 0) { E.a = 1.f; E.b = 0.f; }
            Aff Tt; Tt.a = bperm(I.a, last); Tt.b = bperm(I.b, last);
            if (FULL) {
                float h = E.a * hrun + E.b;
#pragma unroll
                for (int n2 = 0; n2 < 16; ++n2) { h = a[n2] * h + u[n2]; LAS float* sp = S + (tok0 + n2 * tstep) * S_STRIDE + cg * 16 + fr; if (half == 0) *sp = h; else *sp += h; }
                hrun = Tt.a * hrun + Tt.b;
            } else { run = aff_then(run, Tt); }
        }
        if (FULL) __syncthreads();
    }
    if (FULL) {
        if (sq < NB && lane < 16) outw[OUT_S + ((size_t)(sq * DEPTH + l) * 2 + d) * DLRU + ch] = hrun;
#pragma unroll
        for (int k = 0; k < 4; ++k) { const int it = tid + 512 * k, tok = it >> 3, c8 = (it & 7) * 8; const size_t row = (size_t)(row0 + tok);
            const f32x4 s0 = *(const LAS f32x4*)(S + tok * S_STRIDE + c8), s1 = *(const LAS f32x4*)(S + tok * S_STRIDE + c8 + 4);
            const v4u ly = lyv[k]; v4u o;
            o.x = pk2(s0.x * gelu_fast(bflo(ly.x)), s0.y * gelu_fast(bfhi(ly.x))); o.y = pk2(s0.z * gelu_fast(bflo(ly.y)), s0.w * gelu_fast(bfhi(ly.y)));
            o.z = pk2(s1.x * gelu_fast(bflo(ly.z)), s1.y * gelu_fast(bfhi(ly.z))); o.w = pk2(s1.z * gelu_fast(bflo(ly.w)), s1.w * gelu_fast(bfhi(ly.w)));
            *(v4u*)(MIX + row * DM + 1024 + n * 128 + hh * 64 + c8) = o; }
    } else if (lane < 16) { gu64_t* sp = gran + ((((size_t)(sq - NB) * 8 + chunk) * 2 + d) * DLRU + ch) * 2; gran_store(sp, tag, run.a); gran_store(sp + 1, tag, run.b); }
    __syncthreads();
}
__device__ __forceinline__ void lru_prep_wfrag(ArgsP A, const Ctx& C) {
    v4u* wf = (v4u*)(A->ws + WS_WFRAG);
    for (int it = C.gt; it < DEPTH * 2 * 4 * 2 * 8 * 4 * 64; it += C.ngt) {
        const int lane = it & 63, ks = (it >> 6) & 3, w = (it >> 8) & 7, g = (it >> 11) & 1, ldn = it >> 12;
        const float* W = (g == 0 ? A->in[I_LWA] : A->in[I_LWI]) + (size_t)ldn * 128 * 128;
        const int k0 = 32 * ks + 8 * (lane >> 4), j = 16 * w + (lane & 15);
        v4u o; o.x = pk2(W[(k0 + 0) * 128 + j], W[(k0 + 1) * 128 + j]); o.y = pk2(W[(k0 + 2) * 128 + j], W[(k0 + 3) * 128 + j]);
        o.z = pk2(W[(k0 + 4) * 128 + j], W[(k0 + 5) * 128 + j]); o.w = pk2(W[(k0 + 6) * 128 + j], W[(k0 + 7) * 128 + j]);
        wf[it] = o;
    }
}
namespace att {
using bf16x8 = __attribute__((ext_vector_type(8))) short;
using s16x4  = __attribute__((ext_vector_type(4))) short;
using f32x16 = __attribute__((ext_vector_type(16))) float;
using u32x4  = __attribute__((ext_vector_type(4))) unsigned;
constexpr float SCALE = 0.088388347648318440f, THR = 8.f;
constexpr int SHM_V = 16384, SHM_K = 16384, OFF_V = 0, OFF_K = 2 * SHM_V, OFF_WS = 2 * SHM_V + 2 * SHM_K, OFF_BT = OFF_WS + 8 * 256, OFF_OT = OFF_BT + 16 * 32 * 4, LDS_ATT = OFF_OT + 8 * 32 * 272;
#define KSWZ(row, colB) ((row) * 256 + ((colB) ^ (((row) & 7) << 4)))
#define SBAR() __builtin_amdgcn_sched_barrier(0)
__device__ __forceinline__ int crow(int r, int hi) { return (r & 3) + 8 * (r >> 2) + 4 * hi; }
__device__ __forceinline__ unsigned cvtpk(float lo, float hi) { unsigned r; asm volatile("v_cvt_pk_bf16_f32 %0, %1, %2" : "=v"(r) : "v"(lo), "v"(hi)); return r; }
__device__ __forceinline__ void partialSM(f32x16& p0, f32x16& p1, float& m_reg, float& mn, float& alpha) {
  constexpr float C = SCALE * 1.4426950408889634f;
  float pmax = p0[0];
#pragma unroll
  for (int r = 1; r < 16; ++r) pmax = fmaxf(pmax, p0[r]);
#pragma unroll
  for (int r = 0; r < 16; ++r) pmax = fmaxf(pmax, p1[r]);
  pmax = xor32_max(pmax);
  if (__builtin_expect(__all(pmax - m_reg <= THR / SCALE), 1)) { mn = m_reg; alpha = 1.f; }
  else { mn = fmaxf(m_reg, pmax); alpha = __builtin_amdgcn_exp2f((m_reg - mn) * C); m_reg = mn; }
  float mnC = -mn * C;
#pragma unroll
  for (int r = 0; r < 16; ++r) p0[r] = fmaf(p0[r], C, mnC);
#pragma unroll
  for (int r = 0; r < 16; ++r) p1[r] = fmaf(p1[r], C, mnC);
#pragma unroll
  for (int r = 0; r < 16; ++r) p0[r] = __builtin_amdgcn_exp2f(p0[r]);
}
__device__ __forceinline__ void finishSM(f32x16& p0, f32x16& p1, float alpha, float& l_reg, bf16x8& pa0, bf16x8& pa1, bf16x8& pa2, bf16x8& pa3) {
#pragma unroll
  for (int r = 0; r < 16; ++r) p1[r] = __builtin_amdgcn_exp2f(p1[r]);
  float ps = 0;
#pragma unroll
  for (int r = 0; r < 16; ++r) ps += p0[r];
#pragma unroll
  for (int r = 0; r < 16; ++r) ps += p1[r];
  ps = xor32_sum(ps);
  l_reg = l_reg * alpha + ps;
#define PK4(P, BASE, OUT) do { unsigned a0 = cvtpk(P[BASE + 0], P[BASE + 1]), a1 = cvtpk(P[BASE + 2], P[BASE + 3]);   \
    unsigned b0 = cvtpk(P[BASE + 4], P[BASE + 5]), b1 = cvtpk(P[BASE + 6], P[BASE + 7]);                              \
    auto r0 = __builtin_amdgcn_permlane32_swap(a0, b0, false, false); auto r1 = __builtin_amdgcn_permlane32_swap(a1, b1, false, false); \
    u32x4 w = {r0[0], r1[0], r0[1], r1[1]}; OUT = *reinterpret_cast<bf16x8*>(&w); } while (0)
  PK4(p0, 0, pa0); PK4(p0, 8, pa1); PK4(p1, 0, pa2); PK4(p1, 8, pa3);
#undef PK4
}
__device__ __forceinline__ void qkt(f32x16& p0, f32x16& p1, const LAS unsigned char* Ks, const bf16x8* qr, int r32, int hi) {
  p0 = f32x16{}; p1 = f32x16{};
#pragma unroll
  for (int d0 = 0; d0 < 8; ++d0) { int cb = (d0 * 16 + hi * 8) * 2;
    bf16x8 b0 = *reinterpret_cast<const LAS bf16x8*>(Ks + KSWZ(r32, cb));
    bf16x8 b1 = *reinterpret_cast<const LAS bf16x8*>(Ks + KSWZ(32 + r32, cb));
    p0 = __builtin_amdgcn_mfma_f32_32x32x16_bf16(b0, qr[d0], p0, 0, 0, 0);
    p1 = __builtin_amdgcn_mfma_f32_32x32x16_bf16(b1, qr[d0], p1, 0, 0, 0); }
}
__device__ __forceinline__ int v_st(int k, int c) { const int kk = (k & ~0xC) | ((k & 4) << 1) | ((k & 8) >> 1); return ((kk >> 3) * 4 + (c >> 5)) * 512 + ((kk & 7) * 32 + (c & 31)) * 2; }
__device__ __forceinline__ int v_rd_base(int lane) { return ((lane & 3) << 3) | (((lane >> 2) & 3) << 6) | (((lane >> 4) & 1) << 5) | (((lane >> 5) & 1) << 8); }
constexpr int v_rd_off(int d0, int ks, int half) { return d0 * 512 + ks * 4096 + half * 2048; }
template <int OFF> __device__ __forceinline__ s16x4 tr_read(int vb) {
  s16x4 r; asm volatile("ds_read_b64_tr_b16 %0, %1 offset:%2" : "=&v"(r) : "v"(vb), "i"(OFF) : "memory"); return r;
}
template <int D0> __device__ __forceinline__ void pv_one(f32x16& od, int vb, bf16x8 pa0, bf16x8 pa1, bf16x8 pa2, bf16x8 pa3) {
  const s16x4 l0 = tr_read<v_rd_off(D0, 0, 0)>(vb), h0 = tr_read<v_rd_off(D0, 0, 1)>(vb), l1 = tr_read<v_rd_off(D0, 1, 0)>(vb), h1 = tr_read<v_rd_off(D0, 1, 1)>(vb);
  const s16x4 l2 = tr_read<v_rd_off(D0, 2, 0)>(vb), h2 = tr_read<v_rd_off(D0, 2, 1)>(vb), l3 = tr_read<v_rd_off(D0, 3, 0)>(vb), h3 = tr_read<v_rd_off(D0, 3, 1)>(vb);
  asm volatile("s_waitcnt lgkmcnt(0)" ::: "memory"); SBAR();
#define PK(L, H) (bf16x8){L[0], L[1], L[2], L[3], H[0], H[1], H[2], H[3]}
  od = __builtin_amdgcn_mfma_f32_32x32x16_bf16(pa0, PK(l0, h0), od, 0, 0, 0);
  od = __builtin_amdgcn_mfma_f32_32x32x16_bf16(pa1, PK(l1, h1), od, 0, 0, 0);
  od = __builtin_amdgcn_mfma_f32_32x32x16_bf16(pa2, PK(l2, h2), od, 0, 0, 0);
  od = __builtin_amdgcn_mfma_f32_32x32x16_bf16(pa3, PK(l3, h3), od, 0, 0, 0);
#undef PK
}
__device__ __forceinline__ void pv_d0(f32x16* o, int vb, bf16x8 pa0, bf16x8 pa1, bf16x8 pa2, bf16x8 pa3) {
  pv_one<0>(o[0], vb, pa0, pa1, pa2, pa3); pv_one<1>(o[1], vb, pa0, pa1, pa2, pa3); pv_one<2>(o[2], vb, pa0, pa1, pa2, pa3); pv_one<3>(o[3], vb, pa0, pa1, pa2, pa3);
}
}

template <bool LATENT>
__device__ __forceinline__ void attn_unit(ArgsP A, const Ctx& C, int l, int uidx, float* outw) {
  using namespace att;
  const bf16* XIN = (const bf16*)(A->ws + WS_XIN); bf16* MIX = (bf16*)(A->ws + WS_MIX);
  const int tid = C.tid, wid = C.wave, lane = C.lane, r32 = lane & 31, hi = lane >> 5;
  const int h = uidx & 7, b = LATENT ? (uidx >> 6) : (uidx >> 3), rg = (uidx >> 3) & 7;
  const int q0 = LATENT ? NCTX + b * DSEQ + rg * 256 : b * SEQ;
  const int R0 = (rg == 7) ? 24 : max(4 * rg - 4, 0);
  const int NT = LATENT ? ((rg == 0 || rg == 7) ? 12 : 15) : 4;
  LAS unsigned char* lds = C.lds;
  LAS float* wsf = (LAS float*)(lds + OFF_WS) + wid * 64; LAS float* li_l = wsf; LAS float* al_l = wsf + 32;
  LAS float* btab = (LAS float*)(lds + OFF_BT);
  const float* ssq = (const float*)(A->ws + WS_SSQ);
  const float* gkb = A->in[I_KG] + l * HD;
  const int sr = tid >> 4, sc = (tid & 15) * 8, vst0 = v_st(sr, sc), vst1 = v_st(32 + sr, sc);
  const int vb0 = (int)(uintptr_t)(lds + OFF_V) + v_rd_base(lane);
  bf16x8 sv0, sv1, sk0, sk1; f32x4 sq0 = {0.f, 0.f, 0.f, 0.f}, sq1 = sq0; int skrow = 0;
#define SLOAD(j) do { const bf16* kp; const bf16* vp; int ld; \
    if (!LATENT) { skrow = b * SEQ + 64 * (j) + sr; const size_t ro = (size_t)(b * SEQ + 64 * (j)) * DIN + h * HD; kp = XIN + ro + C_K; vp = XIN + ro + C_V; ld = DIN; } \
    else if ((j) < 4) { const size_t ro = (((size_t)b * DEPTH + l) * 256 + 64 * (j)) * 1024 + h * HD; kp = (const bf16*)(A->ws + WS_CKB) + ro; vp = (const bf16*)(A->ws + WS_CVB) + ro; ld = 1024; } \
    else { skrow = NCTX + b * DSEQ + (R0 + (j) - 4) * GW + sr; const size_t ro = (size_t)(NCTX + b * DSEQ + (R0 + (j) - 4) * GW) * DIN + h * HD; kp = XIN + ro + C_K; vp = XIN + ro + C_V; ld = DIN; } \
    if (!LATENT || (j) >= 4) { sq0 = *(const f32x4*)(ssq + ((size_t)skrow * 16 + 8 + h) * 4); sq1 = *(const f32x4*)(ssq + ((size_t)(skrow + 32) * 16 + 8 + h) * 4); } \
    sv0 = *reinterpret_cast<const bf16x8*>(vp + (size_t)sr * ld + sc); sv1 = *reinterpret_cast<const bf16x8*>(vp + (size_t)(32 + sr) * ld + sc); \
    sk0 = *reinterpret_cast<const bf16x8*>(kp + (size_t)sr * ld + sc); sk1 = *reinterpret_cast<const bf16x8*>(kp + (size_t)(32 + sr) * ld + sc); } while (0)
#define KNORM(skx, sqx, rowx) do { const float rk = 1.0f / sqrtf(((sqx.x + sqx.y) + (sqx.z + sqx.w)) * (1.0f / HD) + EPS); const u32x4 w = *reinterpret_cast<const u32x4*>(&skx); \
    const f32x4 y0 = {bflo(w.x) * rk * gk0.x, bfhi(w.x) * rk * gk0.y, bflo(w.y) * rk * gk0.z, bfhi(w.y) * rk * gk0.w}, y1 = {bflo(w.z) * rk * gk1.x, bfhi(w.z) * rk * gk1.y, bflo(w.w) * rk * gk1.z, bfhi(w.w) * rk * gk1.w}; \
    u32x4 o; o.x = cvtpk(y0.x, y0.y); o.y = cvtpk(y0.z, y0.w); o.z = cvtpk(y1.x, y1.y); o.w = cvtpk(y1.z, y1.w); skx = *reinterpret_cast<bf16x8*>(&o); \
    if (!LATENT) { float* op = outw + OUT_K + (((size_t)b * DEPTH + l) * SEQ + ((rowx) & 255)) * DATT + h * HD + sc; __builtin_nontemporal_store(y0, (f32x4*)op); __builtin_nontemporal_store(y1, (f32x4*)(op + 4)); } } while (0)
#define SWRITE(bu, jn) do { if (!LATENT || (jn) >= 4) { int sc_ = sc; asm volatile("" : "+v"(sc_)); const f32x4 gk0 = *(const f32x4*)(gkb + sc_), gk1 = *(const f32x4*)(gkb + sc_ + 4); KNORM(sk0, sq0, skrow); KNORM(sk1, sq1, skrow + 32); } \
    *(LAS bf16x8*)(lds + OFF_V + (bu) * SHM_V + vst0) = sv0; *(LAS bf16x8*)(lds + OFF_V + (bu) * SHM_V + vst1) = sv1; const int kc = sc * 2; \
    *(LAS bf16x8*)(lds + OFF_K + (bu) * SHM_K + KSWZ(sr, kc)) = sk0; *(LAS bf16x8*)(lds + OFF_K + (bu) * SHM_K + KSWZ(32 + sr, kc)) = sk1; } while (0)
  if (wid >= 4) __builtin_amdgcn_s_setprio(1);
  float m_reg = -1e30f, l_reg = 0.f; f32x16 o[4] = {};
  const int qrow = 4 * rg + (wid >> 1), qcol = 32 * (wid & 1) + r32, rs = min(max(qrow - 4, 0), 24), cs = min(max(qcol - 8, 0), 48);
  SLOAD(0);
  bf16x8 qr[8];
  { const int qrow_ = q0 + wid * 32 + r32; const bf16* Qw = XIN + (size_t)qrow_ * DIN + C_Q + h * HD + hi * 8;
    const f32x4 pq = *(const f32x4*)(ssq + ((size_t)qrow_ * 16 + h) * 4); const float rq = 1.0f / sqrtf(((pq.x + pq.y) + (pq.z + pq.w)) * (1.0f / HD) + EPS);
    const float* gq = A->in[I_QG] + l * HD + hi * 8;
#pragma unroll
    for (int d0 = 0; d0 < 8; ++d0) { const u32x4 w = *reinterpret_cast<const u32x4*>(Qw + d0 * 16); const f32x4 g0 = *(const f32x4*)(gq + d0 * 16), g1 = *(const f32x4*)(gq + d0 * 16 + 4);
      u32x4 o; o.x = cvtpk(bflo(w.x) * rq * g0.x, bfhi(w.x) * rq * g0.y); o.y = cvtpk(bflo(w.y) * rq * g0.z, bfhi(w.y) * rq * g0.w);
      o.z = cvtpk(bflo(w.z) * rq * g1.x, bfhi(w.z) * rq * g1.y); o.w = cvtpk(bflo(w.w) * rq * g1.z, bfhi(w.w) * rq * g1.w); qr[d0] = *reinterpret_cast<bf16x8*>(&o); } }
  if (LATENT) { for (int i = tid; i < 15 * 31; i += 512) { const int dr = i / 31, dc = i % 31; btab[dr * 32 + dc] = A->in[I_NAB][((l * NH + h) * 15 + dr) * 31 + dc] * (1.0f / SCALE); } }
  asm volatile("s_waitcnt vmcnt(0)" ::: "memory"); SWRITE(0, 0); __syncthreads();
#pragma unroll 1
  for (int j = 0; j < NT; ++j) {
    const int bu = j & 1;
    if (j + 1 < NT) SLOAD(j + 1);
    bool act = true; int kr = 0;
    if (LATENT && j >= 4) { kr = R0 + j - 4; act = (kr >= rs) && (kr < rs + 8); }
    if (act) {
      f32x16 p0, p1; float mn, alpha; bf16x8 pa0, pa1, pa2, pa3;
      qkt(p0, p1, lds + OFF_K + bu * SHM_K, qr, r32, hi);
      if (LATENT && j >= 4) {
        const LAS float* brow = btab + (kr - qrow + 7) * 32 + (15 - qcol);
        const float ninf = -__builtin_inff();
#pragma unroll
        for (int r = 0; r < 16; ++r) { const int kc0 = crow(r, hi), kc1 = 32 + kc0;
          const float b0 = brow[kc0], b1 = brow[kc1];
          p0[r] = ((unsigned)(kc0 - cs) < 16u) ? p0[r] + b0 : ninf; p1[r] = ((unsigned)(kc1 - cs) < 16u) ? p1[r] + b1 : ninf; }
      }
      partialSM(p0, p1, m_reg, mn, alpha);
      if (__any(alpha < 1.f)) { if (hi == 0) al_l[r32] = alpha; asm volatile("s_waitcnt lgkmcnt(0)" ::: "memory");
#pragma unroll
        for (int d = 0; d < 4; ++d)
#pragma unroll
          for (int r = 0; r < 16; ++r) o[d][r] *= al_l[crow(r, hi)];
        asm volatile("s_waitcnt lgkmcnt(0)" ::: "memory"); }
      finishSM(p0, p1, alpha, l_reg, pa0, pa1, pa2, pa3); SBAR();
      pv_d0(o, vb0 + bu * SHM_V, pa0, pa1, pa2, pa3);
    }
    if (j + 1 < NT) { asm volatile("s_waitcnt vmcnt(0)" ::: "memory"); SWRITE(bu ^ 1, j + 1); }
    __syncthreads();
  }
  __builtin_amdgcn_s_setprio(0);
  int ln2 = lane; asm volatile("" : "+v"(ln2)); const int r32e = ln2 & 31, hie = ln2 >> 5;
  if (hie == 0) li_l[r32e] = l_reg; asm volatile("s_waitcnt lgkmcnt(0)" ::: "memory");
  float rli[16];
#pragma unroll
  for (int r = 0; r < 16; ++r) rli[r] = __builtin_amdgcn_rcpf(li_l[crow(r, hie)]);
  LAS unsigned char* ot = lds + OFF_OT + wid * (32 * 272);
#pragma unroll
  for (int r = 0; r < 16; ++r) { const int orow = crow(r, hie);
#pragma unroll
    for (int d0 = 0; d0 < 4; ++d0) *(LAS bf16*)(ot + orow * 272 + (d0 * 32 + r32e) * 2) = (bf16)f2bf(o[d0][r] * rli[r]); }
  asm volatile("s_waitcnt lgkmcnt(0)" ::: "memory");
  bf16* Ow = MIX + (size_t)(q0 + wid * 32) * DM + h * HD;
#pragma unroll
  for (int i = 0; i < 8; ++i) { const int orow = 4 * i + (ln2 >> 4), oc = (ln2 & 15) * 8; *(u32x4*)(Ow + (size_t)orow * DM + oc) = *(const LAS u32x4*)(ot + orow * 272 + oc * 2); }
  __syncthreads();
#undef SLOAD
#undef SWRITE
#undef KNORM
}
#undef KSWZ
#undef SBAR
__device__ __forceinline__ ConvItem conv_desc(ArgsP A, int l, int set, int r, const LAS float* sht) {
    ConvItem d;
    if (set == 0) {
        if (r < 5632) { const int kb = r / 176, nb = r % 176, n0 = 32 * nb; d.W = A->in[I_WIN] + (size_t)l * DM * DIN; d.WT = (bf16*)(A->ws + WS_WIN) + (size_t)l * DIN * DM; d.K = DM; d.N = DIN; d.k0 = 64 * kb; d.n0 = n0; d.drow0 = n0;
            d.sh = sht; d.shwp = (float*)(A->ws + WS_SHPI) + ((size_t)l * 32 + kb) * 3 * DIN; d.ntot = DIN; }
        else { const int q = r - 5632, kb = q / 64, nb = q % 64; d.W = A->in[I_WOUT] + (size_t)l * DM * DM; d.WT = (bf16*)(A->ws + WS_WOUT) + (size_t)l * DM * DM; d.K = DM; d.N = DM; d.k0 = 64 * kb; d.n0 = 32 * nb; d.drow0 = 32 * nb; d.sh = nullptr; d.shwp = nullptr; d.ntot = 0; }
    } else { const int m = r / 5632, q = r % 5632;
        if (m < 2) { const int kb = q / 176, nb = q % 176, n0 = 32 * nb; d.W = (m ? A->in[I_WU] : A->in[I_WG]) + (size_t)l * DM * DFF; d.WT = (bf16*)(A->ws + WS_WGU) + (size_t)l * 2 * DFF * DM; d.K = DM; d.N = DFF; d.k0 = 64 * kb; d.n0 = n0;
            d.drow0 = 256 * (n0 >> 7) + 128 * m + (n0 & 127); d.sh = sht; d.shwp = (float*)(A->ws + WS_SHPG) + ((size_t)l * 32 + kb) * 3 * 2 * DFF; d.ntot = 2 * DFF; }
        else { const int kb = q / 64, nb = q % 64; d.W = A->in[I_WD] + (size_t)l * DFF * DM; d.WT = (bf16*)(A->ws + WS_WDN) + (size_t)l * DM * DFF; d.K = DFF; d.N = DM; d.k0 = 64 * kb; d.n0 = 32 * nb; d.drow0 = 32 * nb; d.sh = nullptr; d.shwp = nullptr; d.ntot = 0; }
    }
    return d;
}
__device__ __forceinline__ void convert_layer(ArgsP A, const Ctx& C, int l, int set, int jw, int nw) {
    LAS float* scr = (LAS float*)(C.lds + C.wave * 8448);
    LAS float* sht = (LAS float*)(C.lds + 69632);
    const float* mod = (const float*)(A->ws + WS_MOD);
    __syncthreads();
    for (int i = C.tid; i < 3 * DM; i += 512) { const int c = i / DM, k = i % DM; sht[i] = mod[((size_t)l * 3 + c) * 12288 + (set ? 6144 : 0) + k]; }
    __syncthreads();
    const int nitems = set ? 3 * 5632 : 5632 + 2048;
    if (jw < nitems) {
        ConvItem cur = conv_desc(A, l, set, jw, sht); float v[32]; conv_load(cur, C.lane, v);
        for (int r = jw; r < nitems; r += nw) {
            const bool more = r + nw < nitems; ConvItem nxt = cur; float vn[32];
            if (more) { nxt = conv_desc(A, l, set, r + nw, sht); conv_load(nxt, C.lane, vn); }
            conv_process(cur, C.lane, v, scr);
            if (more) { cur = nxt;
#pragma unroll
                for (int i = 0; i < 32; ++i) v[i] = vn[i]; }
        }
    }
    __syncthreads();
}
__device__ __forceinline__ void reduce_shw(ArgsP A, const Ctx& C, int l, int which, bool half_grid = true) {
    const int g0 = half_grid ? C.G / 2 : 0, t0 = ((int)blockIdx.x - g0) * (NWAVES * 64) + C.tid, nt = (C.G - g0) * NWAVES * 64;
    if (which == 0) { const float* shpi = (const float*)(A->ws + WS_SHPI); float* shwi = (float*)(A->ws + WS_SHWI);
        for (int r = t0; r < 3 * DIN; r += nt) { float s = 0.f; for (int kb = 0; kb < 32; ++kb) s += shpi[((size_t)l * 32 + kb) * 3 * DIN + r]; shwi[(size_t)l * 3 * DIN + r] = s; } }
    else { const float* shpg = (const float*)(A->ws + WS_SHPG); float* shwg = (float*)(A->ws + WS_SHWG);
        for (int r = t0; r < 3 * 2 * DFF; r += nt) { float s = 0.f; for (int kb = 0; kb < 32; ++kb) s += shpg[((size_t)l * 32 + kb) * 3 * 2 * DFF + r]; shwg[(size_t)l * 3 * 2 * DFF + r] = s; } }
}
__device__ __forceinline__ void p0a(ArgsP A, const Ctx& C) {
    LAS float* st = (LAS float*)(C.lds + 98304);
    for (int i = C.tid; i < 3 * DM; i += 512) { const int c = i / DM, k = i % DM; const float x = (c == 0) ? A->in[I_CCTX][k] : A->in[I_C][(c - 1) * DM + k]; st[i] = x / (1.0f + expf(-x)); }
    __syncthreads();
    float* modp = (float*)(A->ws + WS_MODP);
    for (int it = C.gw; it < DEPTH * 32 * 48; it += C.ngw) {
        const int nb = it % 48, ks = (it / 48) % 32, l = it / (48 * 32), n = nb * 256 + C.lane * 4;
        const float* w = A->in[I_WMOD] + ((size_t)l * DM + ks * 64) * 12288 + n;
        f32x4 a0 = {0.f, 0.f, 0.f, 0.f}, a1 = a0, a2 = a0;
#pragma unroll 8
        for (int kk = 0; kk < 64; ++kk) { const f32x4 wv = __builtin_nontemporal_load((const f32x4*)(w + (size_t)kk * 12288)); const int k = ks * 64 + kk; a0 += st[k] * wv; a1 += st[DM + k] * wv; a2 += st[2 * DM + k] * wv; }
        float* o = modp + (((size_t)l * 32 + ks) * 3) * 12288 + n;
        *(f32x4*)o = a0; *(f32x4*)(o + 12288) = a1; *(f32x4*)(o + 2 * 12288) = a2;
    }
    lru_prep_wfrag(A, C);
    for (int i = C.gt; i < 2 * DB * DEPTH * 256 * 1024 / 8; i += C.ngt) {
        const int half = DB * DEPTH * 256 * 1024 / 8; const bool isk = i < half; const int j = isk ? i : i - half;
        const float* src = (isk ? A->in[I_CK] : A->in[I_CV]) + (size_t)j * 8; const f32x4 x0 = __builtin_nontemporal_load((const f32x4*)src), x1 = __builtin_nontemporal_load((const f32x4*)(src + 4));
        v4u o; o.x = pk2(x0.x, x0.y); o.y = pk2(x0.z, x0.w); o.z = pk2(x1.x, x1.y); o.w = pk2(x1.z, x1.w);
        *(v4u*)(A->ws + (isk ? WS_CKB : WS_CVB) + (size_t)j * 16) = o; }
}
__device__ __forceinline__ void p0b(ArgsP A, const Ctx& C) {
    const float* modp = (const float*)(A->ws + WS_MODP); float* mod = (float*)(A->ws + WS_MOD); float* gs = (float*)(A->ws + WS_GS);
    for (int i = C.gt; i < DEPTH * 3 * 12288; i += C.ngt) { const int n = i % 12288, c = (i / 12288) % 3, l = i / (3 * 12288);
        float s = A->in[I_BMOD][l * 12288 + n];
        for (int ks = 0; ks < 32; ++ks) s += modp[(((size_t)l * 32 + ks) * 3 + c) * 12288 + n];
        mod[i] = s;
        if (n >= 2048 && n < 4096) gs[(((size_t)l * 2 + 0) * 3 + c) * DM + (n - 2048)] = A->in[I_GMIX][l * DM + n - 2048] * (1.0f + s);
        if (n >= 8192 && n < 10240) gs[(((size_t)l * 2 + 1) * 3 + c) * DM + (n - 8192)] = A->in[I_GFFN][l * DM + n - 8192] * (1.0f + s); }
}
__device__ __forceinline__ void p0c(ArgsP A, const Ctx& C) {
    convert_layer(A, C, 0, 0, C.gw, C.ngw); convert_layer(A, C, 0, 1, C.gw, C.ngw);
    bf16* U = (bf16*)(A->ws + WS_U); float* hssq = (float*)(A->ws + WS_HSSQ); const float* gs0 = (const float*)(A->ws + WS_GS);
    for (int row = C.gw; row < MTOK; row += C.ngw) {
        const int cond = row < NCTX ? 0 : 1 + ((row - NCTX) >> 11);
        const float* hr = row < NCTX ? A->in[I_XP] + (size_t)row * DM : A->in[I_XS] + (size_t)(row - NCTX) * DM;
        const f32x4* xr = (const f32x4*)hr + C.lane; f32x4 v[8]; float s = 0.f;
#pragma unroll
        for (int j = 0; j < 8; ++j) { v[j] = __builtin_nontemporal_load(xr + 64 * j); s += (v[j].x * v[j].x + v[j].y * v[j].y) + (v[j].z * v[j].z + v[j].w * v[j].w); }
        s = wave_sum(s);
        if (C.lane < 32) hssq[(size_t)row * 32 + C.lane] = (C.lane == 0) ? s : 0.f;
#pragma unroll
        for (int j = 0; j < 8; ++j) { const int col = 4 * C.lane + 256 * j; const f32x4 y = v[j] * *(const f32x4*)(gs0 + (size_t)cond * DM + col);
            *(unsigned long long*)(U + (size_t)row * DM + col) = (unsigned long long)pk2(y.x, y.y) | ((unsigned long long)pk2(y.z, y.w) << 32); }
    }
}
__device__ __forceinline__ void p0d(ArgsP A, const Ctx& C) { reduce_shw(A, C, 0, 0, false); reduce_shw(A, C, 0, 1, false); }
__device__ __forceinline__ void mkctx(Ctx& C, LAS unsigned char* lds, const int wave) {
    int wv = wave; asm volatile("" : "+s"(wv));
    int t = wv * 64 + (int)__builtin_amdgcn_mbcnt_hi(~0u, __builtin_amdgcn_mbcnt_lo(~0u, 0u)); asm volatile("" : "+v"(t));
    C.lds = lds; C.tid = t; C.lane = t & 63; C.wave = wv;
    C.G = gridDim.x; C.gw = blockIdx.x * NWAVES + C.wave; C.ngw = C.G * NWAVES; C.gt = blockIdx.x * (NWAVES * 64) + t; C.ngt = C.G * NWAVES * 64;
}
__device__ __forceinline__ void m1_phase(ArgsP A, const Ctx& C, int l, float* outw) {
    const bf16* XIN = (const bf16*)(A->ws + WS_XIN); bf16* MIX = (bf16*)(A->ws + WS_MIX);
    const int half_g = C.G / 2, lt = ((int)blockIdx.x - half_g) * (NWAVES * 64) + C.tid, nlt = (C.G - half_g) * NWAVES * 64;
    if ((int)blockIdx.x >= half_g)
    for (int it = lt; it < (MTOK / 4) * 64; it += nlt) {
        const int ch = it & 63, row0 = (it >> 6) * 4, c0 = ch * 8; int t0, T; if (row0 < NCTX) { t0 = row0 & 255; T = SEQ; } else { t0 = (row0 - NCTX) & 2047; T = DSEQ; }
        v4u cg[6], sx[6], sb[4];
#pragma unroll
        for (int j = 0; j < 6; ++j) { const int tt = t0 + j - 1; cg[j] = (v4u){0u, 0u, 0u, 0u}; sx[j] = cg[j];
            if (tt >= 0 && tt < T) { const bf16* rp = XIN + (size_t)(row0 + j - 1) * DIN; cg[j] = *(const v4u*)(rp + C_SCG + c0); sx[j] = *(const v4u*)(rp + C_SX + c0); } }
#pragma unroll
        for (int j = 0; j < 4; ++j) sb[j] = *(const v4u*)(XIN + (size_t)(row0 + j) * DIN + C_SB + c0);
        float w[3][8];
#pragma unroll
        for (int dk = 0; dk < 3; ++dk)
#pragma unroll
            for (int i = 0; i < 8; ++i) w[dk][i] = A->in[I_SCW][(l * 3 + dk) * DSC + c0 + i];
        float z[6][8];
#pragma unroll
        for (int j = 0; j < 6; ++j) { z[j][0] = bflo(cg[j].x) * bflo(sx[j].x); z[j][1] = bfhi(cg[j].x) * bfhi(sx[j].x); z[j][2] = bflo(cg[j].y) * bflo(sx[j].y); z[j][3] = bfhi(cg[j].y) * bfhi(sx[j].y);
            z[j][4] = bflo(cg[j].z) * bflo(sx[j].z); z[j][5] = bfhi(cg[j].z) * bfhi(sx[j].z); z[j][6] = bflo(cg[j].w) * bflo(sx[j].w); z[j][7] = bfhi(cg[j].w) * bfhi(sx[j].w); }
#pragma unroll
        for (int j = 0; j < 4; ++j) { float acc[8];
#pragma unroll
            for (int i = 0; i < 8; ++i) acc[i] = w[0][i] * z[j][i] + w[1][i] * z[j + 1][i] + w[2][i] * z[j + 2][i];
            v4u o; o.x = pk2(bflo(sb[j].x) * acc[0], bfhi(sb[j].x) * acc[1]); o.y = pk2(bflo(sb[j].y) * acc[2], bfhi(sb[j].y) * acc[3]); o.z = pk2(bflo(sb[j].z) * acc[4], bfhi(sb[j].z) * acc[5]); o.w = pk2(bflo(sb[j].w) * acc[6], bfhi(sb[j].w) * acc[7]);
            *(v4u*)(MIX + (size_t)(row0 + j) * DM + 1536 + c0) = o; }
    }
    for (int u = blockIdx.x; u < 256; u += C.G) {
        if (u < 128) lru_unit<false>(A, C, l, NB + (u >> 6), (u >> 3) & 7, (u >> 1) & 3, u & 1, outw);
        else { const int v = u - 128; lru_unit<true>(A, C, l, v >> 3, 0, (v >> 1) & 3, v & 1, outw); }
    }
}
__device__ __forceinline__ void m2_phase(ArgsP A, LAS unsigned char* lds, const int wave0, int l, float* outw) {
    { Ctx C; mkctx(C, lds, wave0);
      for (int u = blockIdx.x; u < 256; u += C.G) { if (u < 128) attn_unit<true>(A, C, l, u, outw); else attn_unit<false>(A, C, l, u - 128, outw); } }
    { Ctx C; mkctx(C, lds, wave0);
      for (int u = (int)((blockIdx.x + (unsigned)C.G - (128u % (unsigned)C.G)) % (unsigned)C.G); u < 128; u += C.G) lru_unit<true>(A, C, l, NB + (u >> 6), (u >> 3) & 7, (u >> 1) & 3, u & 1, outw); }
}

#define PHASE_BEGIN() ArgsP A = (ArgsP)__builtin_amdgcn_kernarg_segment_ptr(); asm volatile("" : "+s"(A)); Ctx C; mkctx(C, (LAS unsigned char*)lds_raw, wave0); \
    float* mod = (float*)(A->ws + WS_MOD); bf16* U = (bf16*)(A->ws + WS_U); bf16* XIN = (bf16*)(A->ws + WS_XIN); bf16* ACT = (bf16*)(A->ws + WS_ACT); bf16* MIX = (bf16*)(A->ws + WS_MIX); \
    float* outw = A->out; (void)mod; (void)U; (void)XIN; (void)ACT; (void)MIX; (void)outw;
__global__ void __launch_bounds__(NWAVES * 64, 2) fwd(Args A_) {
    extern __shared__ __attribute__((aligned(16))) unsigned char lds_raw[];
    const int wave0 = __builtin_amdgcn_readfirstlane((int)threadIdx.x >> 6);
    { const int t0 = threadIdx.x; for (int u = t0; u < (LDS_BYTES - LDSCTL_OFF) / 4; u += NWAVES * 64) ((LAS unsigned*)((LAS unsigned char*)lds_raw + LDSCTL_OFF))[u] = 0u; }
    __syncthreads();
    volatile LAS unsigned* MISC = (volatile LAS unsigned*)((LAS unsigned char*)lds_raw + MISC_OFF);
    unsigned* barw = (unsigned*)(A_.ws + WS_CTL) + CW_BAR;
    XcdBarrier bar; bar.bar = barw; bar.x = 0; bar.st = nullptr;
    if (MK_MODE == 0) bar = xcd_barrier_post(barw, MISC + 8);
    const int lo = A_.ph_lo, hi = A_.ph_hi;
#define IN(k) (lo <= (k) && (k) < hi)
#define SEAM(k) do { if (IN(k) && IN((k) + 1)) xcd_barrier(bar); } while (0)
    if (IN(0)) { PHASE_BEGIN(); p0a(A, C); } SEAM(0);
    if (IN(1)) { PHASE_BEGIN(); p0b(A, C); } SEAM(1);
    if (IN(2)) { PHASE_BEGIN(); p0c(A, C); } SEAM(2);
    if (IN(3)) { PHASE_BEGIN(); p0d(A, C); } SEAM(3);
    for (int l = 0; l < DEPTH; ++l) {
        const int s0 = NPRO + l * STEPS_PER_LAYER;
        if (IN(s0 + 0)) { PHASE_BEGIN();
            pg8::Gemm g{U, (const bf16*)(A->ws + WS_WIN) + (size_t)l * DIN * DM, MTOK, DIN, DM}; pg8::StaticOrder S; S.init(MTOK, DIN, C.G, (int)blockIdx.x);
            const pg8::RstdTab rt = pg8::rstd_table(C.lds, S, (const float*)(A->ws + WS_HSSQ), C.tid);
            pg8::EpiIn E{XIN, (float*)(A->ws + WS_SSQ), outw + OUT_V + (size_t)l * SEQ * DATT, (const float*)(A->ws + WS_HSSQ), (const float*)(A->ws + WS_SHWI) + (size_t)l * 3 * DIN, rt};
            pg8::gemm_phase<pg8::EpiIn, pg8::StaticOrder, false, true>(C.lds + RING_OFF, g, S, E, wave0);
            { const int rem = (MTOK / 256 * (DIN / 256)) % C.G; if (l + 1 < DEPTH && rem && (int)blockIdx.x >= rem) convert_layer(A, C, l + 1, 0, ((int)blockIdx.x - rem) * NWAVES + C.wave, (C.G - rem) * NWAVES); }
        } SEAM(s0 + 0);
        if (IN(s0 + 1)) { PHASE_BEGIN(); if ((int)blockIdx.x >= C.G / 2) { if (l + 1 < DEPTH) reduce_shw(A, C, l + 1, 0); if (l >= 1) reduce_shw(A, C, l, 1); } m1_phase(A, C, l, outw); m2_phase(A, (LAS unsigned char*)lds_raw, wave0, l, outw); } SEAM(s0 + 1);
        if (IN(s0 + 2)) { PHASE_BEGIN();
            pg8::Gemm g{MIX, (const bf16*)(A->ws + WS_WOUT) + (size_t)l * DM * DM, MTOK, DM, DM}; pg8::StaticOrder S; S.init(MTOK, DM, C.G, (int)blockIdx.x);
            bf16* HB = (bf16*)(A->ws + WS_HB);
            pg8::EpiRes E{A->in[I_XP], A->in[I_XS], (l == 0) ? (const bf16*)nullptr : (const bf16*)HB, nullptr, HB, mod + (size_t)l * 3 * 12288 + 4096, (const float*)(A->ws + WS_GS) + ((size_t)l * 2 + 1) * 3 * DM, U, (float*)(A->ws + WS_HSSQ)};
            pg8::gemm_phase<pg8::EpiRes, pg8::StaticOrder, true, true>(C.lds + RING_OFF, g, S, E, wave0);
        } SEAM(s0 + 2);
        if (IN(s0 + 3)) { PHASE_BEGIN();
            pg8::Gemm g{U, (const bf16*)(A->ws + WS_WGU) + (size_t)l * 2 * DFF * DM, MTOK, 2 * DFF, DM}; pg8::StaticOrder S; S.init(MTOK, 2 * DFF, C.G, (int)blockIdx.x);
            const pg8::RstdTab rt = pg8::rstd_table(C.lds, S, (const float*)(A->ws + WS_HSSQ), C.tid);
            pg8::EpiSwiGLU E{ACT, (const float*)(A->ws + WS_HSSQ), (const float*)(A->ws + WS_SHWG) + (size_t)l * 3 * 2 * DFF, rt};
            pg8::gemm_phase<pg8::EpiSwiGLU, pg8::StaticOrder, false, true>(C.lds + RING_OFF, g, S, E, wave0);
            { const int rem = (MTOK / 256 * (2 * DFF / 256)) % C.G; if (l + 1 < DEPTH && rem && (int)blockIdx.x >= rem) convert_layer(A, C, l + 1, 1, ((int)blockIdx.x - rem) * NWAVES + C.wave, (C.G - rem) * NWAVES); }
        } SEAM(s0 + 3);
        if (IN(s0 + 4)) { PHASE_BEGIN();
            pg8::Gemm g{ACT, (const bf16*)(A->ws + WS_WDN) + (size_t)l * DM * DFF, MTOK, DM, DFF}; pg8::StaticOrder S; S.init(MTOK, DM, C.G, (int)blockIdx.x);
            bf16* HB = (bf16*)(A->ws + WS_HB); const bool last = (l + 1 == DEPTH);
            pg8::EpiRes E{nullptr, nullptr, HB, outw, last ? (bf16*)nullptr : HB, mod + (size_t)l * 3 * 12288 + 10240, last ? (const float*)nullptr : (const float*)(A->ws + WS_GS) + ((size_t)(l + 1) * 2 + 0) * 3 * DM, U, (float*)(A->ws + WS_HSSQ)};
            pg8::gemm_phase<pg8::EpiRes, pg8::StaticOrder, true, true>(C.lds + RING_OFF, g, S, E, wave0);
        } SEAM(s0 + 4);
    }
#undef IN
#undef SEAM
}

extern "C" void kernel_launch(void* const* d_in, const int* in_sizes, int n_in, void* d_out, int out_size, void* d_ws, size_t ws_size, hipStream_t stream) {
    static int grid = 0;
    if (grid == 0) {
        if (n_in != 27 || (size_t)out_size != OUT_END || ws_size < WS_END3) { fprintf(stderr, "kernel_launch: shape mismatch: n_in %d out %d ws %zu (need 27, %zu, >= %zu)\n", n_in, out_size, ws_size, (size_t)OUT_END, (size_t)WS_END3); grid = -1; return; }
        int dev = 0, cus = 0, per_cu = 0;
        if (hipGetDevice(&dev) != hipSuccess || hipDeviceGetAttribute(&cus, hipDeviceAttributeMultiprocessorCount, dev) != hipSuccess) { fprintf(stderr, "kernel_launch: device query failed\n"); grid = -1; return; }
        if (hipFuncSetAttribute((const void*)fwd, hipFuncAttributeMaxDynamicSharedMemorySize, LDS_BYTES) != hipSuccess) { fprintf(stderr, "kernel_launch: hipFuncSetAttribute failed\n"); grid = -1; return; }
        if (hipOccupancyMaxActiveBlocksPerMultiprocessor(&per_cu, (const void*)fwd, NWAVES * 64, LDS_BYTES) != hipSuccess || per_cu < 1) fprintf(stderr, "kernel_launch: note: occupancy query reports %d workgroups per CU\n", per_cu);
        (void)hipGetLastError();
        grid = cus;
    }
    if (grid < 0) return;
    if (hipMemsetAsync((char*)d_ws + WS_CTL, 0, CTL_ZERO_BYTES, stream) != hipSuccess) { fprintf(stderr, "kernel_launch: memset failed\n"); return; }
    Args a{};
    for (int i = 0; i < 27; ++i) a.in[i] = (const float*)d_in[i];
    a.out = (float*)d_out; a.ws = (unsigned char*)d_ws;
#if MK_MODE == 0
    a.ph_lo = 0; a.ph_hi = NSTEPS;
    hipLaunchKernelGGL(fwd, dim3(grid), dim3(NWAVES * 64), LDS_BYTES, stream, a);
#else
    for (int s = 0; s < NSTEPS; ++s) { a.ph_lo = s; a.ph_hi = s + 1; hipLaunchKernelGGL(fwd, dim3(grid), dim3(NWAVES * 64), LDS_BYTES, stream, a); }
#endif
    const hipError_t le = hipPeekAtLastError();
    if (le != hipSuccess) fprintf(stderr, "kernel_launch: launch failed: %s\n", hipGetErrorName(le));
}
```

```cpp
#include <hip/hip_runtime.h>
#include <cstdio>
#include <cstdint>
namespace pg8 {
#define PG8_LAS __attribute__((address_space(3)))
typedef unsigned short bf16_t;
typedef short bf16x8 __attribute__((ext_vector_type(8)));
typedef float f32x4 __attribute__((ext_vector_type(4)));
typedef unsigned u32x4 __attribute__((ext_vector_type(4)));
constexpr int BM = 256, BK = 64, HALF = 128, HTB = HALF * BK * 2  , STAGE_BYTES = 8 * HTB, NXCD = 8, WGM = 8;

__host__ __device__ __forceinline__ int lds_byte(int r, int c) { const int st = (r >> 4) * 2 + (c >> 5), rr = r & 15, cc = c & 31, ob = rr * 64 + cc * 2; return st * 1024 + (ob ^ (((ob >> 9) & 1) << 5)); }
__host__ __device__ __forceinline__ void stage_rc(int b, int& R, int& C) { const int st = b / 1024, sb = b % 1024, swz = sb ^ (((sb >> 9) & 1) << 5); R = (st >> 1) * 16 + swz / 64; C = (st & 1) * 32 + (swz % 64) / 2; }
__host__ __device__ __forceinline__ int perm32(int rho) { const int n = rho >> 4, i = rho & 15; return 8 * (i >> 2) + 4 * n + (i & 3); }

struct Unit { int pm, pn; };
struct Gemm { const bf16_t* A; const bf16_t* Bt; int M, N, K; };

struct StaticOrder {
    int nM, nN, nwg, G, c;
    __host__ __device__ void init(int M, int N, int G_, int c_) { nM = M / BM; nN = N / BM; nwg = nM * nN; G = G_; c = c_; }
    __host__ __device__ bool next(int i, Unit& u) const {
        const long L = (long)i * G + c; if (L >= nwg) return false;
        int wgid = (int)L; { const int q = nwg / NXCD, r = nwg % NXCD, xcd = wgid % NXCD, off = wgid / NXCD; wgid = (xcd < r ? xcd * (q + 1) : r * (q + 1) + (xcd - r) * q) + off; }
        const int nig = WGM * nN, gid = wgid / nig, fm = gid * WGM, gsz = (nM - fm) < WGM ? (nM - fm) : WGM;
        u.pm = fm + ((wgid % nig) % gsz); u.pn = (wgid % nig) / gsz; return true;
    }
    __device__ __forceinline__ void a_ready(const Unit&) const {}
    __device__ __forceinline__ void done(const Unit&) const {}
};

__device__ __forceinline__ void st16(void* p, u32x4 v) { *(u32x4*)p = v; }
__device__ __forceinline__ unsigned cvt_pk_bf16(float lo, float hi) { unsigned r; asm volatile("v_cvt_pk_bf16_f32 %0, %1, %2" : "=v"(r) : "v"(lo), "v"(hi)); return r; }

__device__ __forceinline__ float xl16_sum(float s) { s += __builtin_bit_cast(float, __builtin_amdgcn_ds_swizzle(__builtin_bit_cast(int, s), 0x401f)); float a_ = s, b_ = s; asm volatile("s_nop 1\n\tv_permlane32_swap_b32 %0, %1\n\ts_nop 1" : "+v"(a_), "+v"(b_)); return a_ + b_; }
__device__ __forceinline__ void row_rstd(const float* hssq, int row0, int fq, float (&rs)[2][4]) {
#pragma unroll
    for (int ai = 0; ai < 2; ++ai) { f32x4 p[4][2];
#pragma unroll
        for (int m = 0; m < 4; ++m) { const float* hp = hssq + (size_t)(row0 + ai * HALF + m * 16) * 32 + fq * 8; p[m][0] = *(const f32x4*)hp; p[m][1] = *(const f32x4*)(hp + 4); }
#pragma unroll
        for (int m = 0; m < 4; ++m) { const f32x4 q = p[m][0] + p[m][1]; const float t = xl16_sum((q[0] + q[1]) + (q[2] + q[3])); rs[ai][m] = 1.0f / sqrtf(t * (1.0f / 2048.0f) + 1e-6f); } }
}
constexpr int RTAB_OFF = STAGE_BYTES, RTAB_ROWS = 3840;
struct RstdTab { const PG8_LAS float* tab; int row_lo; bool ok; };
template <class Sched>
__device__ __forceinline__ RstdTab rstd_table(PG8_LAS unsigned char* lds, const Sched& S, const float* hssq, int tid) {
    int lo = 1 << 30, hi = -1; Unit u; for (int i = 0; S.next(i, u); ++i) { lo = u.pm < lo ? u.pm : lo; hi = u.pm > hi ? u.pm : hi; }
    RstdTab T; T.tab = (const PG8_LAS float*)(lds + RTAB_OFF); T.row_lo = lo * BM; T.ok = (hi >= lo) && ((hi - lo + 1) * BM <= RTAB_ROWS);
    if (T.ok) { PG8_LAS float* tw = (PG8_LAS float*)(lds + RTAB_OFF); const int nrows = (hi - lo + 1) * BM;
        for (int r = tid; r < nrows; r += 512) { const f32x4* hp = (const f32x4*)(hssq + (size_t)(T.row_lo + r) * 32); f32x4 q = hp[0];
#pragma unroll
            for (int j = 1; j < 8; ++j) q += hp[j];
            tw[r] = 1.0f / sqrtf(((q[0] + q[1]) + (q[2] + q[3])) * (1.0f / 2048.0f) + 1e-6f); } }
    __syncthreads();
    return T;
}
__device__ __forceinline__ void get_rstd(const RstdTab& T, const float* hssq, int row0, int fq, float (&rs)[2][4]) {
    if (T.ok) {
#pragma unroll
        for (int ai = 0; ai < 2; ++ai)
#pragma unroll
            for (int m = 0; m < 4; ++m) rs[ai][m] = T.tab[row0 + ai * HALF + m * 16 - T.row_lo];
    } else row_rstd(hssq, row0, fq, rs);
}
struct EpiIn {
    static constexpr bool PERM = true, AFTER_DRAIN = false;
    bf16_t* O; float* ssq; float* vout; const float* hssq; const float* shw; RstdTab rt;
    __device__ __forceinline__ void operator()(const f32x4 (&acc)[2][2][4][2], const Unit& u, int wr, int wc, int fr, int fq) const {
        const int row0 = u.pm * BM + wr * 64 + fr, col0 = u.pn * BM + wc * 32 + 8 * fq;
        const int cond = u.pm < 16 ? 0 : (u.pm < 24 ? 1 : 2);
        float rs[2][4]; get_rstd(rt, hssq, row0, fq, rs);
        f32x4 bv[2][2];
#pragma unroll
        for (int bj = 0; bj < 2; ++bj)
#pragma unroll
            for (int n = 0; n < 2; ++n) bv[bj][n] = *(const f32x4*)(shw + (size_t)cond * 5632 + col0 + bj * HALF + 4 * n);
#pragma unroll
        for (int ai = 0; ai < 2; ++ai)
#pragma unroll
            for (int m = 0; m < 4; ++m) { const int row = row0 + ai * HALF + m * 16; bf16_t* rowp = O + (size_t)row * 5632 + col0;
#pragma unroll
                for (int bj = 0; bj < 2; ++bj) { const f32x4 v0 = acc[ai][bj][m][0] * rs[ai][m] + bv[bj][0], v1 = acc[ai][bj][m][1] * rs[ai][m] + bv[bj][1];
                    u32x4 w; w.x = cvt_pk_bf16(v0[0], v0[1]); w.y = cvt_pk_bf16(v0[2], v0[3]); w.z = cvt_pk_bf16(v1[0], v1[1]); w.w = cvt_pk_bf16(v1[2], v1[3]);
                    st16(rowp + bj * HALF, w);
                    if (u.pn < 8) {
                        float s = (v0[0] * v0[0] + v0[1] * v0[1]) + (v0[2] * v0[2] + v0[3] * v0[3]) + (v1[0] * v1[0] + v1[1] * v1[1]) + (v1[2] * v1[2] + v1[3] * v1[3]);
                        s = xl16_sum(s);
                        if (fq == 0) ssq[((size_t)row * 16 + (2 * u.pn + bj)) * 4 + wc] = s;
                    } else if (u.pn < 12 && u.pm < 16) {
                        const int b = row >> 8, t = row & 255, col = col0 + bj * HALF - 2048;
                        float* p = vout + ((size_t)b * 1024 + t) * 1024 + col;
                        __builtin_nontemporal_store(v0, (f32x4*)p); __builtin_nontemporal_store(v1, (f32x4*)(p + 4));
                    } } }
    }
};
struct EpiRes {
    static constexpr bool PERM = true, AFTER_DRAIN = false;
    const float* x_lo; const float* x_hi; const bf16_t* hb_in;
    float* y; bf16_t* hb_out;
    const float* gate;
    const float* gsn; bf16_t* un; float* hssq;
    __device__ __forceinline__ void operator()(const f32x4 (&acc)[2][2][4][2], const Unit& u, int wr, int wc, int fr, int fq) const {
        const int row0 = u.pm * BM + wr * 64 + fr, col0 = u.pn * BM + wc * 32 + 8 * fq;
        const int cond = u.pm < 16 ? 0 : (u.pm < 24 ? 1 : 2);
        f32x4 gv[2][2], gs[2][2];
#pragma unroll
        for (int bj = 0; bj < 2; ++bj)
#pragma unroll
            for (int n = 0; n < 2; ++n) { gv[bj][n] = *(const f32x4*)(gate + (size_t)cond * 12288 + col0 + bj * HALF + 4 * n);
                gs[bj][n] = gsn ? *(const f32x4*)(gsn + (size_t)cond * 2048 + col0 + bj * HALF + 4 * n) : (f32x4){0.f, 0.f, 0.f, 0.f}; }
#pragma unroll
        for (int ai = 0; ai < 2; ++ai)
#pragma unroll
            for (int m = 0; m < 4; ++m) { const int row = row0 + ai * HALF + m * 16; const size_t off = (size_t)row * 2048 + col0;
                float s = 0.f;
#pragma unroll
                for (int bj = 0; bj < 2; ++bj) { f32x4 b0, b1;
                    if (hb_in) { const u32x4 w = *(const u32x4*)(hb_in + off + bj * HALF);
                        b0 = (f32x4){__builtin_bit_cast(float, w.x << 16), __builtin_bit_cast(float, w.x & 0xffff0000u), __builtin_bit_cast(float, w.y << 16), __builtin_bit_cast(float, w.y & 0xffff0000u)};
                        b1 = (f32x4){__builtin_bit_cast(float, w.z << 16), __builtin_bit_cast(float, w.z & 0xffff0000u), __builtin_bit_cast(float, w.w << 16), __builtin_bit_cast(float, w.w & 0xffff0000u)}; }
                    else { const float* bp = (u.pm < 16) ? x_lo + off : x_hi + (off - (size_t)4096 * 2048); b0 = *(const f32x4*)(bp + bj * HALF); b1 = *(const f32x4*)(bp + bj * HALF + 4); }
                    const f32x4 o0 = b0 + gv[bj][0] * acc[ai][bj][m][0], o1 = b1 + gv[bj][1] * acc[ai][bj][m][1];
                    if (hb_out) { u32x4 w; w.x = cvt_pk_bf16(o0[0], o0[1]); w.y = cvt_pk_bf16(o0[2], o0[3]); w.z = cvt_pk_bf16(o1[0], o1[1]); w.w = cvt_pk_bf16(o1[2], o1[3]); st16(hb_out + off + bj * HALF, w); }
                    else { __builtin_nontemporal_store(o0, (f32x4*)(y + off + bj * HALF)); __builtin_nontemporal_store(o1, (f32x4*)(y + off + bj * HALF + 4)); }
                    if (gsn) { s += ((o0[0] * o0[0] + o0[1] * o0[1]) + (o0[2] * o0[2] + o0[3] * o0[3])) + ((o1[0] * o1[0] + o1[1] * o1[1]) + (o1[2] * o1[2] + o1[3] * o1[3]));
                        const f32x4 a0 = o0 * gs[bj][0], a1 = o1 * gs[bj][1];
                        u32x4 w; w.x = cvt_pk_bf16(a0[0], a0[1]); w.y = cvt_pk_bf16(a0[2], a0[3]); w.z = cvt_pk_bf16(a1[0], a1[1]); w.w = cvt_pk_bf16(a1[2], a1[3]); st16(un + off + bj * HALF, w); } }
                if (gsn) { s = xl16_sum(s); if (fq == 0) hssq[(size_t)row * 32 + u.pn * 4 + wc] = s; } }
    }
};
__device__ __forceinline__ float silu_f(float g) { return g * __builtin_amdgcn_rcpf(1.0f + __builtin_amdgcn_exp2f(-1.4426950408889634f * g)); }
struct EpiSwiGLU {
    static constexpr bool PERM = true, AFTER_DRAIN = false;
    bf16_t* O; const float* hssq; const float* shw; RstdTab rt;
    __device__ __forceinline__ void operator()(const f32x4 (&acc)[2][2][4][2], const Unit& u, int wr, int wc, int fr, int fq) const {
        const int row0 = u.pm * BM + wr * 64 + fr, col0 = u.pn * HALF + wc * 32 + 8 * fq, bcol0 = u.pn * BM + wc * 32 + 8 * fq;
        const int cond = u.pm < 16 ? 0 : (u.pm < 24 ? 1 : 2);
        float rs[2][4]; get_rstd(rt, hssq, row0, fq, rs);
        f32x4 bv[2][2];
#pragma unroll
        for (int bj = 0; bj < 2; ++bj)
#pragma unroll
            for (int n = 0; n < 2; ++n) bv[bj][n] = *(const f32x4*)(shw + (size_t)cond * 11264 + bcol0 + bj * HALF + 4 * n);
#pragma unroll
        for (int ai = 0; ai < 2; ++ai)
#pragma unroll
            for (int m = 0; m < 4; ++m) { const float r = rs[ai][m];
                const f32x4 g0 = acc[ai][0][m][0] * r + bv[0][0], g1 = acc[ai][0][m][1] * r + bv[0][1], u0 = acc[ai][1][m][0] * r + bv[1][0], u1 = acc[ai][1][m][1] * r + bv[1][1];
                u32x4 w; w.x = cvt_pk_bf16(silu_f(g0[0]) * u0[0], silu_f(g0[1]) * u0[1]); w.y = cvt_pk_bf16(silu_f(g0[2]) * u0[2], silu_f(g0[3]) * u0[3]);
                w.z = cvt_pk_bf16(silu_f(g1[0]) * u1[0], silu_f(g1[1]) * u1[1]); w.w = cvt_pk_bf16(silu_f(g1[2]) * u1[2], silu_f(g1[3]) * u1[3]);
                st16(O + (size_t)(row0 + ai * HALF + m * 16) * 5632 + col0, w); }
    }
};

template <class Epi, class Sched, bool ALIGN_EPI = false, bool SP2 = false>
__device__ __forceinline__ void gemm_phase(PG8_LAS unsigned char* lds, const Gemm g, const Sched& S, const Epi& E, const int wave_id  ) {
    int wv_ = wave_id; asm volatile("" : "+s"(wv_));
    int tid_ = wv_ * 64 + (int)__builtin_amdgcn_mbcnt_hi(~0u, __builtin_amdgcn_mbcnt_lo(~0u, 0u)); asm volatile("" : "+v"(tid_));
    const int tid = tid_, wid = wv_, lane = tid & 63, wr = wid >> 2, wc = wid & 3, fr = lane & 15, fq = lane >> 4;
    const int K = g.K, nt = K / BK;
    unsigned voffA[2], voffB[2];
#pragma unroll
    for (int i = 0; i < 2; ++i) { int R, C; stage_rc(tid * 16 + i * 8192, R, C); const int Rb = Epi::PERM ? ((R & ~31) + perm32(R & 31)) : R;
        voffA[i] = (unsigned)(R * K + C) * 2u; voffB[i] = (unsigned)(Rb * K + C) * 2u; }
    const size_t kstep = (size_t)(BK * 2);
    const size_t hstep = (size_t)HALF * K * 2;
    const size_t tstep = 2 * hstep;
    const unsigned ldsw = (unsigned)wid * 1024u;
    const int aoff = lds_byte(wr * 64 + fr, fq * 8), boff = lds_byte(wc * 32 + fr, fq * 8);
#define PG8_SA(b, h) (((b) * 2 + (h)) * HTB)
#define PG8_SB(b, h) ((4 + (b) * 2 + (h)) * HTB)
#define PG8_STAGE(bufoff, gbase, voff) do { _Pragma("unroll") for (int _i = 0; _i < 2; ++_i) \
        __builtin_amdgcn_global_load_lds((const unsigned*)((const char*)(gbase) + (voff)[_i]), (PG8_LAS unsigned*)(lds + (bufoff) + ldsw + _i * 8192), 16, 0, 0); } while (0)
#define PG8_LDA(dst, b, h) do { _Pragma("unroll") for (int m = 0; m < 4; ++m) _Pragma("unroll") for (int k = 0; k < 2; ++k) dst[m][k] = *(const PG8_LAS bf16x8*)(lds + PG8_SA(b, h) + aoff + m * 2048 + k * 1024); } while (0)
#define PG8_LDB(dst, b, h) do { _Pragma("unroll") for (int n = 0; n < 2; ++n) _Pragma("unroll") for (int k = 0; k < 2; ++k) dst[n][k] = *(const PG8_LAS bf16x8*)(lds + PG8_SB(b, h) + boff + n * 2048 + k * 1024); } while (0)
#define PG8_MMA(ai, bj, At, Bt) do { __builtin_amdgcn_s_setprio(1); _Pragma("unroll") for (int m = 0; m < 4; ++m) _Pragma("unroll") for (int n = 0; n < 2; ++n) _Pragma("unroll") for (int k = 0; k < 2; ++k) \
        acc[ai][bj][m][n] = __builtin_amdgcn_mfma_f32_16x16x32_bf16(Bt[n][k], At[m][k], acc[ai][bj][m][n], 0, 0, 0); __builtin_amdgcn_s_setprio(0); } while (0)
#define PG8_WAIT_V(n) asm volatile("s_waitcnt vmcnt(" #n ")" ::: "memory")
#define PG8_WAIT_L(n) asm volatile("s_waitcnt lgkmcnt(" #n ")" ::: "memory")
#define PG8_BAR __builtin_amdgcn_s_barrier()
#define PG8_SCHED __builtin_amdgcn_sched_barrier(0)
    Unit cur, nxt; int ui = 0;
    if (!S.next(0, cur)) return;
    f32x4 acc[2][2][4][2];
#pragma unroll
    for (int a = 0; a < 2; ++a)
#pragma unroll
        for (int b = 0; b < 2; ++b)
#pragma unroll
            for (int m = 0; m < 4; ++m)
#pragma unroll
                for (int n = 0; n < 2; ++n) acc[a][b][m][n] = (f32x4){0.f, 0.f, 0.f, 0.f};
    bf16x8 At[4][2], B0[2][2], B1[2][2];
    const char* cA = (const char*)g.A + (size_t)cur.pm * tstep; const char* cB = (const char*)g.Bt + (size_t)cur.pn * tstep;
    S.a_ready(cur);
    if constexpr (SP2) {
        PG8_STAGE(PG8_SB(0, 0), cB, voffB); PG8_STAGE(PG8_SB(0, 1), cB + hstep, voffB); PG8_STAGE(PG8_SA(0, 0), cA, voffA); PG8_STAGE(PG8_SA(0, 1), cA + hstep, voffA);
        if (wr == 1) PG8_BAR;
        PG8_WAIT_V(2); PG8_BAR;
        PG8_STAGE(PG8_SB(1, 0), cB + kstep, voffB); PG8_STAGE(PG8_SA(1, 0), cA + kstep, voffA); PG8_STAGE(PG8_SB(1, 1), cB + hstep + kstep, voffB);
        PG8_WAIT_V(6); PG8_BAR;
    } else {
        PG8_STAGE(PG8_SB(0, 0), cB, voffB); PG8_STAGE(PG8_SA(0, 0), cA, voffA); PG8_STAGE(PG8_SB(0, 1), cB + hstep, voffB); PG8_STAGE(PG8_SA(0, 1), cA + hstep, voffA);
        if (wr == 1) PG8_BAR;
        PG8_WAIT_V(4); PG8_BAR;
        PG8_STAGE(PG8_SB(1, 0), cB + kstep, voffB); PG8_STAGE(PG8_SA(1, 0), cA + kstep, voffA); PG8_STAGE(PG8_SB(1, 1), cB + hstep + kstep, voffB);
        PG8_WAIT_V(6); PG8_BAR;
    }
    for (;;) {
        const bool has_next = S.next(ui + 1, nxt);
        const char* nA = has_next ? (const char*)g.A + (size_t)nxt.pm * tstep : cA; const char* nB = has_next ? (const char*)g.Bt + (size_t)nxt.pn * tstep : cB;
        for (int t = 0; t < nt; t += 2) {
            const bool last = (t == nt - 2);
            const char* a1 = cA + (size_t)(t + 1) * kstep;
            const char* a2 = last ? nA : cA + (size_t)(t + 2) * kstep; const char* b2 = last ? nB : cB + (size_t)(t + 2) * kstep;
            const char* a3 = a2 + kstep; const char* b3 = b2 + kstep;
            if (last && has_next) S.a_ready(nxt);
            if constexpr (SP2) {
            PG8_LDB(B0, 0, 0); PG8_LDB(B1, 0, 1); PG8_SCHED; PG8_LDA(At, 0, 0); PG8_STAGE(PG8_SA(1, 1), a1 + hstep, voffA);
            PG8_WAIT_V(8); PG8_WAIT_L(0); PG8_BAR; PG8_MMA(0, 0, At, B0); PG8_MMA(0, 1, At, B1); PG8_BAR; PG8_SCHED;
            PG8_LDA(At, 0, 1); PG8_STAGE(PG8_SB(0, 0), b2, voffB); PG8_STAGE(PG8_SB(0, 1), b2 + hstep, voffB); PG8_STAGE(PG8_SA(0, 0), a2, voffA);
            PG8_WAIT_V(8); PG8_WAIT_L(0); PG8_BAR; PG8_MMA(1, 0, At, B0); PG8_MMA(1, 1, At, B1); PG8_BAR; PG8_SCHED;
            PG8_LDB(B0, 1, 0); PG8_LDB(B1, 1, 1); PG8_SCHED; PG8_LDA(At, 1, 0); PG8_STAGE(PG8_SA(0, 1), a2 + hstep, voffA);
            PG8_WAIT_V(8); PG8_WAIT_L(0); PG8_BAR; PG8_MMA(0, 0, At, B0); PG8_MMA(0, 1, At, B1); PG8_BAR; PG8_SCHED;
            PG8_LDA(At, 1, 1); PG8_STAGE(PG8_SB(1, 0), b3, voffB); PG8_STAGE(PG8_SB(1, 1), b3 + hstep, voffB); PG8_STAGE(PG8_SA(1, 0), a3, voffA);
            PG8_WAIT_V(8); PG8_WAIT_L(0); PG8_BAR; PG8_MMA(1, 0, At, B0); PG8_MMA(1, 1, At, B1); PG8_BAR; PG8_SCHED;
            } else {
            PG8_LDB(B0, 0, 0); PG8_SCHED; PG8_LDA(At, 0, 0); PG8_STAGE(PG8_SA(1, 1), a1 + hstep, voffA);
            PG8_WAIT_L(8); PG8_BAR; PG8_WAIT_L(0); PG8_MMA(0, 0, At, B0); PG8_BAR; PG8_SCHED;
            PG8_LDB(B1, 0, 1); PG8_STAGE(PG8_SB(0, 0), b2, voffB);
            PG8_BAR; PG8_WAIT_L(0); PG8_MMA(0, 1, At, B1); PG8_BAR;
            PG8_LDA(At, 0, 1); PG8_STAGE(PG8_SA(0, 0), a2, voffA);
            PG8_BAR; PG8_WAIT_L(0); PG8_MMA(1, 0, At, B0); PG8_BAR; PG8_SCHED;
            PG8_STAGE(PG8_SB(0, 1), b2 + hstep, voffB);
            PG8_WAIT_V(6); PG8_BAR; PG8_MMA(1, 1, At, B1); PG8_BAR;
            PG8_LDB(B0, 1, 0); PG8_SCHED; PG8_LDA(At, 1, 0); PG8_STAGE(PG8_SA(0, 1), a2 + hstep, voffA);
            PG8_WAIT_L(8); PG8_BAR; PG8_WAIT_L(0); PG8_MMA(0, 0, At, B0); PG8_BAR; PG8_SCHED;
            PG8_LDB(B1, 1, 1); PG8_STAGE(PG8_SB(1, 0), b3, voffB);
            PG8_BAR; PG8_WAIT_L(0); PG8_MMA(0, 1, At, B1); PG8_BAR;
            PG8_LDA(At, 1, 1); PG8_STAGE(PG8_SA(1, 0), a3, voffA);
            PG8_BAR; PG8_WAIT_L(0); PG8_MMA(1, 0, At, B0); PG8_BAR; PG8_SCHED;
            PG8_STAGE(PG8_SB(1, 1), b3 + hstep, voffB);
            PG8_WAIT_V(6); PG8_BAR; PG8_MMA(1, 1, At, B1); PG8_BAR;
            }
        }
        if constexpr (ALIGN_EPI) { if (wr == 0) PG8_BAR; }
        if constexpr (!Epi::AFTER_DRAIN) { E(acc, cur, wr, wc, fr, fq); S.done(cur); }
        if (!has_next) break;
#pragma unroll
        for (int a = 0; a < 2; ++a)
#pragma unroll
            for (int b = 0; b < 2; ++b)
#pragma unroll
                for (int m = 0; m < 4; ++m)
#pragma unroll
                    for (int n = 0; n < 2; ++n) acc[a][b][m][n] = (f32x4){0.f, 0.f, 0.f, 0.f};
        cur = nxt; cA = nA; cB = nB; ++ui;
        if constexpr (ALIGN_EPI) { if (wr == 1) PG8_BAR; }
    }
    PG8_WAIT_V(0);
    if constexpr (!ALIGN_EPI) { if (wr == 0) PG8_BAR; }
    PG8_BAR;
    if constexpr (Epi::AFTER_DRAIN) { E.fused(acc, cur, wr, wc, fr, fq, lds, wid, lane); S.done(cur); }
#undef PG8_SA
#undef PG8_SB
#undef PG8_STAGE
#undef PG8_LDA
#undef PG8_LDB
#undef PG8_MMA
#undef PG8_WAIT_V
#undef PG8_WAIT_L
#undef PG8_BAR
#undef PG8_SCHED
}
}

constexpr int DM = 2048, NCTX = 4096, NLAT = 4096, MTOK = 8192, DEPTH = 4, SEQ = 256, DSEQ = 2048, NB = 16, DB = 2;
constexpr int DIN = 5632, DFF = 5632, DATT = 1024, DLRU = 512, DSC = 512, NH = 8, HD = 128, GW = 64;
constexpr int C_Q = 0, C_K = 1024, C_V = 2048, C_LX = 3072, C_LY = 3584, C_SB = 4096, C_SCG = 4608, C_SX = 5120;
constexpr float EPS = 1e-6f;
constexpr int NWAVES = 8;
#ifndef MK_MODE
#define MK_MODE 0
#endif
constexpr int STEPS_PER_LAYER = 5, NPRO = 4, NSTEPS = NPRO + DEPTH * STEPS_PER_LAYER;

constexpr size_t OUT_Y = 0, OUT_K = (size_t)MTOK * DM, OUT_V = OUT_K + (size_t)NB * DEPTH * SEQ * DATT, OUT_S = OUT_V + (size_t)NB * DEPTH * SEQ * DATT, OUT_END = OUT_S + (size_t)NB * DEPTH * 2 * DLRU;

constexpr size_t MiB = 1u << 20;
constexpr size_t WS_CTL = 0, CTL_ZERO_BYTES = 1 * MiB;
constexpr size_t WS_MOD  = 1 * MiB;
constexpr size_t WS_MODP = 2 * MiB;
constexpr size_t WS_WIN  = 24 * MiB;
constexpr size_t WS_WOUT = WS_WIN + (size_t)DEPTH * DIN * DM * 2;
constexpr size_t WS_WGU  = WS_WOUT + (size_t)DEPTH * DM * DM * 2;
constexpr size_t WS_WDN  = WS_WGU + (size_t)DEPTH * 2 * DFF * DM * 2;
constexpr size_t WS_U    = WS_WDN + (size_t)DEPTH * DM * DFF * 2;
constexpr size_t WS_XIN  = WS_U + (size_t)MTOK * DM * 2;
constexpr size_t WS_ACT  = WS_XIN;
constexpr size_t WS_MIX  = WS_XIN + (size_t)MTOK * DIN * 2;
constexpr size_t WS_SSQ  = WS_MIX + (size_t)MTOK * DM * 2;
constexpr size_t WS_END  = WS_SSQ + (size_t)MTOK * 64 * 4;
constexpr int CW_BAR = 4096;

constexpr int RING_OFF = 0, RING_BYTES = 131072, LDS_BYTES = 147456, LDSCTL_OFF = LDS_BYTES - 512  , MISC_OFF = LDSCTL_OFF + 320;

#define GAS __attribute__((address_space(1)))
#define LAS __attribute__((address_space(3)))
typedef unsigned short bf16;
typedef unsigned v4u __attribute__((ext_vector_type(4)));
typedef float f32x4 __attribute__((ext_vector_type(4)));
typedef GAS unsigned gu32;
#define RLX_AGENT __ATOMIC_RELAXED, __HIP_MEMORY_SCOPE_AGENT
#define LDS_WAIT() asm volatile("s_waitcnt lgkmcnt(0)" ::: "memory")
#define VM_WAIT() asm volatile("s_waitcnt vmcnt(0)" ::: "memory")
__device__ __forceinline__ unsigned f2bf(float f) { unsigned u = __builtin_bit_cast(unsigned, f); return (u + 0x7fffu + ((u >> 16) & 1u)) >> 16; }
__device__ __forceinline__ unsigned pk2(float lo, float hi) { return f2bf(lo) | (f2bf(hi) << 16); }
__device__ __forceinline__ float bflo(unsigned w) { return __builtin_bit_cast(float, w << 16); }
__device__ __forceinline__ float bfhi(unsigned w) { return __builtin_bit_cast(float, w & 0xffff0000u); }
__device__ __forceinline__ float bf2f(bf16 b) { return __builtin_bit_cast(float, ((unsigned)b) << 16); }

#define XB_TMO      128
#define XB_XCNT(j)  (256  + 64 * (j))
#define XB_XSUB(j)  (1280 + 64 * (j))
#define XB_XGEN(j)  (2304 + 64 * (j))
#define XB_TOP      3328
#define XB_TOPGEN   3392
#define XCD_BAR_WORDS 3456
#define XB_SPIN_CAP (1u << 18)

__device__ __forceinline__ unsigned xb_ld(unsigned* p)              { return __hip_atomic_load(p, __ATOMIC_RELAXED, __HIP_MEMORY_SCOPE_AGENT); }
__device__ __forceinline__ unsigned xb_add(unsigned* p, unsigned v) { return __hip_atomic_fetch_add(p, v, __ATOMIC_RELAXED, __HIP_MEMORY_SCOPE_AGENT); }
__device__ __forceinline__ unsigned xb_xcc_id() { return (unsigned)__builtin_amdgcn_s_getreg((3 << 11) | 20) & 0xFu; }
#define XB_SPIN(cond, bar) do { unsigned _sp = 0; while (cond) { __builtin_amdgcn_s_sleep(1); \
    if ((++_sp & 255u) == 0u) { if (xb_ld(&(bar)[XB_TMO])) break; if (_sp > XB_SPIN_CAP) { atomicAdd(&(bar)[XB_TMO], 1u); break; } } } } while (0)

struct XcdBarrier {
    unsigned* bar; unsigned x;
    volatile LAS unsigned* st;
};

__device__ __forceinline__ XcdBarrier xcd_barrier_post(unsigned* bar, volatile LAS unsigned* st) {
    XcdBarrier b; b.bar = bar; b.x = xb_xcc_id(); b.st = st;
    if (threadIdx.x == 0) (void)xb_add(&bar[XB_XCNT(b.x)], 1u);
    return b;
}
__device__ __forceinline__ void xcd_barrier_complete(unsigned* bar, unsigned x, unsigned& nloc, unsigned& nx) {
    const unsigned G = gridDim.x * gridDim.y * gridDim.z;
    unsigned sum, cnt, mine, sp = 0u;
    for (;;) {
        sum = 0u; cnt = 0u; mine = 0u;
#pragma unroll
        for (unsigned j = 0; j < 16; ++j) { const unsigned c = xb_ld(&bar[XB_XCNT(j)]); sum += c; cnt += (c > 0u) ? 1u : 0u; mine = (j == x) ? c : mine; }
        if (sum == G) break;
        __builtin_amdgcn_s_sleep(1);
        if ((++sp & 255u) == 0u) { if (xb_ld(&bar[XB_TMO])) break; if (sp > XB_SPIN_CAP) { atomicAdd(&bar[XB_TMO], 1u); break; } }
    }
    nloc = mine > 0u ? mine : 1u; nx = cnt > 0u ? cnt : 1u;
}

__device__ __forceinline__ void xcd_barrier(const XcdBarrier& b) {
    asm volatile("s_waitcnt vmcnt(0)" ::: "memory");
    __syncthreads();
    if (threadIdx.x == 0) {
        unsigned* bar = b.bar;
        __builtin_amdgcn_s_waitcnt(0);
        unsigned nloc = b.st[0], nx = b.st[1];
        if (nloc == 0u) { xcd_barrier_complete(bar, b.x, nloc, nx); b.st[0] = nloc; b.st[1] = nx; }
        const unsigned old = xb_add(&bar[XB_XSUB(b.x)], 1u);
        const unsigned gen = old / nloc;
        if (old + 1u == (gen + 1u) * nloc) {
            __builtin_amdgcn_fence(__ATOMIC_RELEASE, "agent");
            asm volatile("s_waitcnt vmcnt(0)" ::: "memory");
            const unsigned og = xb_add(&bar[XB_TOP], 1u);
            const unsigned tg = og / nx;
            if (og + 1u == (tg + 1u) * nx) xb_add(&bar[XB_TOPGEN], 1u);
            else XB_SPIN(xb_ld(&bar[XB_TOPGEN]) == tg, bar);
            __builtin_amdgcn_fence(__ATOMIC_ACQUIRE, "agent");
            xb_add(&bar[XB_XGEN(b.x)], 1u);
            asm volatile("s_waitcnt vmcnt(0)" ::: "memory");
        } else {
            XB_SPIN(xb_ld(&bar[XB_XGEN(b.x)]) == gen, bar);
            __builtin_amdgcn_fence(__ATOMIC_ACQUIRE, "agent");
            asm volatile("s_waitcnt vmcnt(0)" ::: "memory");
        }
    }
    __syncthreads();
}

struct Args { const float* in[27]; float* out; unsigned char* ws; int ph_lo, ph_hi; };
typedef const __attribute__((address_space(4))) Args* ArgsP;
struct Ctx { LAS unsigned char* lds; int tid, lane, wave, G, gw, ngw, gt, ngt; };
enum { I_XP = 0, I_XS, I_CK, I_CV, I_ST, I_C, I_CCTX, I_WMOD, I_BMOD, I_GMIX, I_GFFN, I_WIN, I_QG, I_KG, I_NAB, I_LCW, I_LCB, I_LWA, I_LBA, I_LWI, I_LBI, I_LAM, I_SCW, I_WOUT, I_WG, I_WU, I_WD };

template <int XM> __device__ __forceinline__ float swz_xor(float v) { return __builtin_bit_cast(float, __builtin_amdgcn_ds_swizzle(__builtin_bit_cast(int, v), 0x1f | (XM << 10))); }
__device__ __forceinline__ void swap32(float v, float& own, float& other) { own = v; other = v; asm volatile("s_nop 1\n\tv_permlane32_swap_b32 %0, %1\n\ts_nop 1" : "+v"(own), "+v"(other)); }
__device__ __forceinline__ float xor32_sum(float v) { float a, b; swap32(v, a, b); return a + b; }
__device__ __forceinline__ float xor32_max(float v) { float a, b; swap32(v, a, b); return fmaxf(a, b); }
__device__ __forceinline__ float wave_sum(float v) { v += swz_xor<1>(v); v += swz_xor<2>(v); v += swz_xor<4>(v); v += swz_xor<8>(v); v += swz_xor<16>(v); return xor32_sum(v); }
__device__ __forceinline__ float bperm(float v, int byte_idx) { return __builtin_bit_cast(float, __builtin_amdgcn_ds_bpermute(byte_idx, __builtin_bit_cast(int, v))); }

struct ConvItem { const float* W; bf16* WT; const LAS float* sh; float* shwp; int K, N, k0, n0, drow0, ntot; };
__device__ __forceinline__ void conv_load(const ConvItem& d, int lane, float (&v)[32]) {
    const float* wp = d.W + (size_t)(d.k0 + (lane >> 5)) * d.N + d.n0 + (lane & 31);
#pragma unroll
    for (int i = 0; i < 32; ++i) v[i] = __builtin_nontemporal_load(wp + (size_t)(2 * i) * d.N);
}
__device__ __forceinline__ void conv_process(const ConvItem& d, int lane, const float (&v)[32], LAS float* scr) {
#pragma unroll
    for (int i = 0; i < 32; ++i) scr[(2 * i + (lane >> 5)) * 33 + (lane & 31)] = v[i];
    LDS_WAIT(); asm volatile("" ::: "memory");
    const int c = lane & 7;
#pragma unroll
    for (int j = 0; j < 4; ++j) { const int n = (lane >> 3) + 8 * j; const LAS float* s = scr + (8 * c) * 33 + n;
        v4u o; o.x = pk2(s[0 * 33], s[1 * 33]); o.y = pk2(s[2 * 33], s[3 * 33]); o.z = pk2(s[4 * 33], s[5 * 33]); o.w = pk2(s[6 * 33], s[7 * 33]);
        __builtin_nontemporal_store(o, (v4u*)(d.WT + (size_t)(d.drow0 + n) * d.K + d.k0 + 8 * c)); }
    if (d.sh) {
        const int n = lane & 31, hf = lane >> 5; float a0 = 0.f, a1 = 0.f, a2 = 0.f;
#pragma unroll
        for (int q = 0; q < 8; ++q) { const int kk = hf * 32 + q * 4; const LAS float* sp = d.sh + d.k0 + kk;
            const f32x4 s0 = *(const LAS f32x4*)sp, s1 = *(const LAS f32x4*)(sp + 2048), s2 = *(const LAS f32x4*)(sp + 4096);
#pragma unroll
            for (int j = 0; j < 4; ++j) { const float w = scr[(kk + j) * 33 + n]; a0 += s0[j] * w; a1 += s1[j] * w; a2 += s2[j] * w; } }
        a0 = xor32_sum(a0); a1 = xor32_sum(a1); a2 = xor32_sum(a2);
        if (lane < 32) { d.shwp[d.drow0 + n] = a0; d.shwp[(size_t)d.ntot + d.drow0 + n] = a1; d.shwp[2 * (size_t)d.ntot + d.drow0 + n] = a2; }
    }
    LDS_WAIT(); asm volatile("" ::: "memory");
}
typedef short bf16x8_t __attribute__((ext_vector_type(8)));
constexpr int XC_STRIDE = 272;
__device__ __forceinline__ int xaddr(int row, int colb) { return row * XC_STRIDE + (colb ^ (((row >> 4) & 3) << 6)); }
constexpr size_t WS_WFRAG = WS_END;
constexpr size_t WS_CKB   = WS_WFRAG + (size_t)DEPTH * 2 * 4 * 2 * 8 * 4 * 64 * 16;
constexpr size_t WS_CVB   = WS_CKB + (size_t)DB * DEPTH * 256 * 1024 * 2;
constexpr size_t WS_END2  = WS_CVB + (size_t)DB * DEPTH * 256 * 1024 * 2;
constexpr size_t WS_HSSQ  = WS_END2;
constexpr size_t WS_GS    = WS_HSSQ + (size_t)MTOK * 32 * 4;
constexpr size_t WS_SHWI  = WS_GS + (size_t)DEPTH * 2 * 3 * DM * 4;
constexpr size_t WS_SHWG  = WS_SHWI + (size_t)DEPTH * 3 * DIN * 4;
constexpr size_t WS_SHPI  = WS_SHWG + (size_t)DEPTH * 3 * 2 * DFF * 4;
constexpr size_t WS_SHPG  = WS_SHPI + (size_t)DEPTH * 32 * 3 * DIN * 4;
constexpr size_t WS_HB    = WS_SHPG + (size_t)DEPTH * 32 * 3 * 2 * DFF * 4;
constexpr size_t WS_END2B = WS_HB + (size_t)MTOK * DM * 2;
constexpr size_t WS_END3  = WS_END2B;

constexpr size_t CTL_GRAN = 262144;
typedef __attribute__((address_space(1))) unsigned long long gu64_t;
__device__ __forceinline__ void gran_store(gu64_t* g, unsigned tag, float v) { __hip_atomic_store(g, ((unsigned long long)tag << 32) | __builtin_bit_cast(unsigned, v), __ATOMIC_RELAXED, __HIP_MEMORY_SCOPE_AGENT); }
struct Aff { float a, b; };
__device__ __forceinline__ Aff aff_then(const Aff first, const Aff second) { Aff r; r.a = second.a * first.a; r.b = second.a * first.b + second.b; return r; }

__device__ __forceinline__ void lru_gate(float pa, float pi, float x, float sp8l, float& a, float& u) {
    const float r = __builtin_amdgcn_rcpf(1.0f + __builtin_amdgcn_exp2f(pa)), ig = __builtin_amdgcn_rcpf(1.0f + __builtin_amdgcn_exp2f(pi));
    a = __builtin_amdgcn_exp2f(sp8l * r);
    const float em = fmaf(-a, a, 1.0f);
    u = __builtin_amdgcn_sqrtf(em) * (ig * x);
}
constexpr int S_OFF = 256 * XC_STRIDE, S_STRIDE = 68;
static_assert(S_OFF + 256 * S_STRIDE * 4 <= LDSCTL_OFF, "LRU LDS tiles below the control words");
__device__ __forceinline__ float gelu_fast(float x) { const float z = 0.7978845608028654f * (x + 0.044715f * x * x * x); return x * __builtin_amdgcn_rcpf(1.0f + __builtin_amdgcn_exp2f(-2.8853900817779268f * z)); }
template <bool FULL>
__device__ __forceinline__ void lru_unit(ArgsP A, const Ctx& C, int l, int sq  , int chunk, int n, int hh, float* outw) {
    const bf16* XIN = (const bf16*)(A->ws + WS_XIN); bf16* MIX = (bf16*)(A->ws + WS_MIX);
    const int T = sq < NB ? SEQ : DSEQ, tlo = chunk * 256, row0 = (sq < NB ? sq * SEQ : NCTX + (sq - NB) * DSEQ) + tlo;
    LAS unsigned char* xl = C.lds;
    LAS float* S = (LAS float*)(C.lds + S_OFF);
    const int tid = C.tid, lane = C.lane, w = C.wave, fr = lane & 15, fq = lane >> 4;
    v4u lyv[4];
    if (FULL) {
#pragma unroll
        for (int k = 0; k < 4; ++k) { const int it = tid + 512 * k, tok = it >> 3, c8 = (it & 7) * 8; lyv[k] = *(const v4u*)(XIN + (size_t)(row0 + tok) * DIN + C_LY + n * 128 + hh * 64 + c8); }
    }
    {
        const int c8 = (tid & 15) * 8, chb = n * 128 + c8; float wt[4][8], bb[8];
#pragma unroll
        for (int i = 0; i < 8; ++i) bb[i] = A->in[I_LCB][l * DLRU + chb + i];
#pragma unroll
        for (int dk = 0; dk < 4; ++dk)
#pragma unroll
            for (int i = 0; i < 8; ++i) wt[dk][i] = A->in[I_LCW][(l * 4 + dk) * DLRU + chb + i];
#pragma unroll
        for (int q = 0; q < 2; ++q) {
            const int tb = 4 * (tid >> 4) + 128 * q;
            v4u xr[7];
#pragma unroll
            for (int j = 0; j < 7; ++j) { const int tt = tlo + tb + j - 2; xr[j] = (v4u){0u, 0u, 0u, 0u}; if (tt >= 0 && tt < T) xr[j] = *(const v4u*)(XIN + (size_t)(row0 + tb + j - 2) * DIN + C_LX + chb); }
#pragma unroll
            for (int t4 = 0; t4 < 4; ++t4) { float xc[8];
#pragma unroll
                for (int i = 0; i < 8; ++i) xc[i] = bb[i];
#pragma unroll
                for (int dk = 0; dk < 4; ++dk) { const v4u x = xr[t4 + dk];
                    xc[0] += wt[dk][0] * bflo(x.x); xc[1] += wt[dk][1] * bfhi(x.x); xc[2] += wt[dk][2] * bflo(x.y); xc[3] += wt[dk][3] * bfhi(x.y);
                    xc[4] += wt[dk][4] * bflo(x.z); xc[5] += wt[dk][5] * bfhi(x.z); xc[6] += wt[dk][6] * bflo(x.w); xc[7] += wt[dk][7] * bfhi(x.w); }
                v4u o; o.x = pk2(xc[0], xc[1]); o.y = pk2(xc[2], xc[3]); o.z = pk2(xc[4], xc[5]); o.w = pk2(xc[6], xc[7]);
                *(LAS v4u*)(xl + xaddr(tb + t4, c8 * 2)) = o; }
        }
    }
    __syncthreads();
    const int d = w >> 2, cg = w & 3, wq = 4 * hh + cg, ch = n * 128 + wq * 16 + fr;
    const bf16x8_t* wfrag = (const bf16x8_t*)(A->ws + WS_WFRAG); gu64_t* gran = (gu64_t*)(A->ws + WS_CTL + CTL_GRAN); const unsigned tag = (unsigned)l + 1u;
    bf16x8_t bfr[2][4];
#pragma unroll
    for (int g = 0; g < 2; ++g)
#pragma unroll
        for (int ks = 0; ks < 4; ++ks) bfr[g][ks] = wfrag[((((((size_t)l * 2 + d) * 4 + n) * 2 + g) * 8 + wq) * 4 + ks) * 64 + lane];
    const float ba = -1.4426950408889634f * A->in[I_LBA][(l * 2 + d) * DLRU + ch], bi = -1.4426950408889634f * A->in[I_LBI][(l * 2 + d) * DLRU + ch];
    const float sp8 = -8.0f * 1.4426950408889634f * log1pf(expf(-A->in[I_LAM][(l * 2 + d) * DLRU + ch]));
    float hrun = 0.f; Aff run; run.a = 1.f; run.b = 0.f;
    if (FULL && sq >= NB) {
        const int b = sq - NB; float h = A->in[I_ST][((b * DEPTH + l) * 2 + d) * DLRU + ch];
        float ga[8], gb[8];
        for (unsigned spins = 0; spins < (1u << 20); ++spins) { bool ok = true;
#pragma unroll
            for (int c2 = 0; c2 < 8; ++c2) { const bool need = (d == 0) ? (c2 < chunk) : (c2 > chunk); ga[c2] = 1.f; gb[c2] = 0.f;
                if (need) { gu64_t* sp = gran + ((((size_t)b * 8 + c2) * 2 + d) * DLRU + ch) * 2;
                    const unsigned long long x0 = __hip_atomic_load(sp, __ATOMIC_RELAXED, __HIP_MEMORY_SCOPE_AGENT), x1 = __hip_atomic_load(sp + 1, __ATOMIC_RELAXED, __HIP_MEMORY_SCOPE_AGENT);
                    ok = ok && ((unsigned)(x0 >> 32) == tag) && ((unsigned)(x1 >> 32) == tag); ga[c2] = __builtin_bit_cast(float, (unsigned)x0); gb[c2] = __builtin_bit_cast(float, (unsigned)x1); } }
            if (__all(ok)) break;
            __builtin_amdgcn_s_sleep(2); }
#pragma unroll
        for (int k = 0; k < 8; ++k) { const int c2 = (d == 0) ? k : 7 - k; h = ga[c2] * h + gb[c2]; }
        hrun = h;
    }
    const int up16 = ((lane - 16) & 63) * 4, up32 = ((lane - 32) & 63) * 4, last = (48 + fr) * 4;
    const int taur = 16 * (fr >> 2) + (fr & 3);
#pragma unroll 1
    for (int half = 0; half < 2; ++half) {
#pragma unroll 1
        for (int k = 0; k < 2; ++k) {
            const int si = half * 2 + k, st = d ? 3 - si : si;
            f32x4 accA[4], accI[4];
#pragma unroll
            for (int j = 0; j < 4; ++j) { accA[j] = (f32x4){ba, ba, ba, ba}; accI[j] = (f32x4){bi, bi, bi, bi};
                const int trow = d ? 64 * st + 63 - (taur + 4 * j) : 64 * st + taur + 4 * j;
#pragma unroll
                for (int ks = 0; ks < 4; ++ks) { const bf16x8_t af = *(const LAS bf16x8_t*)(xl + xaddr(trow, (32 * ks + 8 * fq) * 2));
                    accA[j] = __builtin_amdgcn_mfma_f32_16x16x32_bf16(af, bfr[0][ks], accA[j], 0, 0, 0); accI[j] = __builtin_amdgcn_mfma_f32_16x16x32_bf16(af, bfr[1][ks], accI[j], 0, 0, 0); } }
            const int tokb = d ? 64 * st + 48 - 16 * fq : 64 * st + 16 * fq;
            float a[16], u[16];
            { const LAS unsigned char* xp = xl + xaddr(tokb, (wq * 16 + fr) * 2); float xs[16];
#pragma unroll
              for (int k = 0; k < 16; ++k) xs[k] = bf2f(*(const LAS bf16*)(xp + k * XC_STRIDE));
#pragma unroll
              for (int j = 0; j < 4; ++j)
#pragma unroll
                for (int i = 0; i < 4; ++i) { const int n2 = 4 * j + i; const float x = d ? xs[15 - n2] : xs[n2]; lru_gate(accA[j][i], accI[j][i], x, sp8, a[n2], u[n2]); } }
            Aff L; L.a = 1.f; L.b = 0.f;
#pragma unroll
            for (int n2 = 0; n2 < 16; ++n2) { L.b = a[n2] * L.b + u[n2]; L.a = a[n2] * L.a; }
            Aff I = L;
            { Aff Q; Q.a = bperm(I.a, up16); Q.b = bperm(I.b, up16); const Aff J = aff_then(Q, I); const bool has = fq >= 1; I.a = has ? J.a : I.a; I.b = has ? J.b : I.b; }
            { Aff Q; Q.a = bperm(I.a, up32); Q.b = bperm(I.b, up32); const Aff J = aff_then(Q, I); const bool has = fq >= 2; I.a = has ? J.a : I.a; I.b = has ? J.b : I.b; }
            Aff E; E.a = bperm(I.a, up16); E.b = bperm(I.b, up16); if (fq == 0) { E.a = 1.f; E.b = 0.f; }
            Aff Tt; Tt.a = bperm(I.a, last); Tt.b = bperm(I.b, last);
            if (FULL) {
                float h = E.a * hrun + E.b;
#pragma unroll
                for (int n2 = 0; n2 < 16; ++n2) { h = a[n2] * h + u[n2]; u[n2] = h; }
                LAS float* sp = S + tokb * S_STRIDE + cg * 16 + fr;
                if (half == 0) {
#pragma unroll
                    for (int k = 0; k < 16; ++k) sp[k * S_STRIDE] = d ? u[15 - k] : u[k];
                } else {
#pragma unroll
                    for (int k = 0; k < 16; ++k) sp[k * S_STRIDE] += d ? u[15 - k] : u[k];
                }
                hrun = Tt.a * hrun + Tt.b;
            } else { run = aff_then(run, Tt); }
        }
        if (FULL) __syncthreads();
    }
    if (FULL) {
        if (sq < NB && lane < 16) outw[OUT_S + ((size_t)(sq * DEPTH + l) * 2 + d) * DLRU + ch] = hrun;
#pragma unroll
        for (int k = 0; k < 4; ++k) { const int it = tid + 512 * k, tok = it >> 3, c8 = (it & 7) * 8; const size_t row = (size_t)(row0 + tok);
            const f32x4 s0 = *(const LAS f32x4*)(S + tok * S_STRIDE + c8), s1 = *(const LAS f32x4*)(S + tok * S_STRIDE + c8 + 4);
            const v4u ly = lyv[k]; v4u o;
            o.x = pk2(s0.x * gelu_fast(bflo(ly.x)), s0.y * gelu_fast(bfhi(ly.x))); o.y = pk2(s0.z * gelu_fast(bflo(ly.y)), s0.w * gelu_fast(bfhi(ly.y)));
            o.z = pk2(s1.x * gelu_fast(bflo(ly.z)), s1.y * gelu_fast(bfhi(ly.z))); o.w = pk2(s1.z * gelu_fast(bflo(ly.w)), s1.w * gelu_fast(bfhi(ly.w)));
            *(v4u*)(MIX + row * DM + 1024 + n * 128 + hh * 64 + c8) = o; }
    } else if (lane < 16) { gu64_t* sp = gran + ((((size_t)(sq - NB) * 8 + chunk) * 2 + d) * DLRU + ch) * 2; gran_store(sp, tag, run.a); gran_store(sp + 1, tag, run.b); }
    __syncthreads();
}
__device__ __forceinline__ void lru_prep_wfrag(ArgsP A, const Ctx& C) {
    v4u* wf = (v4u*)(A->ws + WS_WFRAG);
    for (int it = C.gt; it < DEPTH * 2 * 4 * 2 * 8 * 4 * 64; it += C.ngt) {
        const int lane = it & 63, ks = (it >> 6) & 3, w = (it >> 8) & 7, g = (it >> 11) & 1, ldn = it >> 12;
        const float* W = (g == 0 ? A->in[I_LWA] : A->in[I_LWI]) + (size_t)ldn * 128 * 128;
        const int k0 = 32 * ks + 8 * (lane >> 4), j = 16 * w + (lane & 15);
        const float sc = -1.4426950408889634f;
        v4u o; o.x = pk2(sc * W[(k0 + 0) * 128 + j], sc * W[(k0 + 1) * 128 + j]); o.y = pk2(sc * W[(k0 + 2) * 128 + j], sc * W[(k0 + 3) * 128 + j]);
        o.z = pk2(sc * W[(k0 + 4) * 128 + j], sc * W[(k0 + 5) * 128 + j]); o.w = pk2(sc * W[(k0 + 6) * 128 + j], sc * W[(k0 + 7) * 128 + j]);
        wf[it] = o;
    }
}
namespace att {
using bf16x8 = __attribute__((ext_vector_type(8))) short;
using s16x4  = __attribute__((ext_vector_type(4))) short;
using f32x16 = __attribute__((ext_vector_type(16))) float;
using u32x4  = __attribute__((ext_vector_type(4))) unsigned;
constexpr float SCALE = 0.088388347648318440f, THR = 8.f;
constexpr int SHM_V = 16384, SHM_K = 16384, OFF_V = 0, OFF_K = 2 * SHM_V, OFF_WS = 2 * SHM_V + 2 * SHM_K, OFF_BT = OFF_WS + 8 * 256, BT_PITCH = 36, OFF_OT = OFF_BT + 4 * 15 * BT_PITCH * 4 + 64, LDS_ATT = OFF_OT + 8 * 32 * 272;
static_assert(LDS_ATT <= LDSCTL_OFF, "attention LDS tiles below the control words");
#define KSWZ(row, colB) ((row) * 256 + ((colB) ^ (((row) & 7) << 4)))
#define SBAR() __builtin_amdgcn_sched_barrier(0)
__device__ __forceinline__ int crow(int r, int hi) { return (r & 3) + 8 * (r >> 2) + 4 * hi; }
__device__ __forceinline__ unsigned cvtpk(float lo, float hi) { unsigned r; asm volatile("v_cvt_pk_bf16_f32 %0, %1, %2" : "=v"(r) : "v"(lo), "v"(hi)); return r; }
__device__ __forceinline__ void partialSM(f32x16& p0, f32x16& p1, float& m_reg, float& mn, float& alpha) {
  constexpr float C = SCALE * 1.4426950408889634f;
  float pmax = p0[0];
#pragma unroll
  for (int r = 1; r < 16; ++r) pmax = fmaxf(pmax, p0[r]);
#pragma unroll
  for (int r = 0; r < 16; ++r) pmax = fmaxf(pmax, p1[r]);
  pmax = xor32_max(pmax);
  if (__builtin_expect(__all(pmax - m_reg <= THR / SCALE), 1)) { mn = m_reg; alpha = 1.f; }
  else { mn = fmaxf(m_reg, pmax); alpha = __builtin_amdgcn_exp2f((m_reg - mn) * C); m_reg = mn; }
  float mnC = -mn * C;
#pragma unroll
  for (int r = 0; r < 16; ++r) p0[r] = fmaf(p0[r], C, mnC);
#pragma unroll
  for (int r = 0; r < 16; ++r) p1[r] = fmaf(p1[r], C, mnC);
#pragma unroll
  for (int r = 0; r < 16; ++r) p0[r] = __builtin_amdgcn_exp2f(p0[r]);
}
__device__ __forceinline__ void finishSM(f32x16& p0, f32x16& p1, float alpha, float& l_reg, bf16x8& pa0, bf16x8& pa1, bf16x8& pa2, bf16x8& pa3) {
#pragma unroll
  for (int r = 0; r < 16; ++r) p1[r] = __builtin_amdgcn_exp2f(p1[r]);
  float ps = 0;
#pragma unroll
  for (int r = 0; r < 16; ++r) ps += p0[r];
#pragma unroll
  for (int r = 0; r < 16; ++r) ps += p1[r];
  ps = xor32_sum(ps);
  l_reg = l_reg * alpha + ps;
#define PK4(P, BASE, OUT) do { unsigned a0 = cvtpk(P[BASE + 0], P[BASE + 1]), a1 = cvtpk(P[BASE + 2], P[BASE + 3]);   \
    unsigned b0 = cvtpk(P[BASE + 4], P[BASE + 5]), b1 = cvtpk(P[BASE + 6], P[BASE + 7]);                              \
    auto r0 = __builtin_amdgcn_permlane32_swap(a0, b0, false, false); auto r1 = __builtin_amdgcn_permlane32_swap(a1, b1, false, false); \
    u32x4 w = {r0[0], r1[0], r0[1], r1[1]}; OUT = *reinterpret_cast<bf16x8*>(&w); } while (0)
  PK4(p0, 0, pa0); PK4(p0, 8, pa1); PK4(p1, 0, pa2); PK4(p1, 8, pa3);
#undef PK4
}
__device__ __forceinline__ void qkt(f32x16& p0, f32x16& p1, const LAS unsigned char* Ks, const bf16x8* qr, int r32, int hi) {
  p0 = f32x16{}; p1 = f32x16{};
#pragma unroll
  for (int d0 = 0; d0 < 8; ++d0) { int cb = (d0 * 16 + hi * 8) * 2;
    bf16x8 b0 = *reinterpret_cast<const LAS bf16x8*>(Ks + KSWZ(r32, cb));
    bf16x8 b1 = *reinterpret_cast<const LAS bf16x8*>(Ks + KSWZ(32 + r32, cb));
    p0 = __builtin_amdgcn_mfma_f32_32x32x16_bf16(b0, qr[d0], p0, 0, 0, 0);
    p1 = __builtin_amdgcn_mfma_f32_32x32x16_bf16(b1, qr[d0], p1, 0, 0, 0); }
}
__device__ __forceinline__ int v_st(int k, int c) { const int kk = (k & ~0xC) | ((k & 4) << 1) | ((k & 8) >> 1); return ((kk >> 3) * 4 + (c >> 5)) * 512 + ((kk & 7) * 32 + (c & 31)) * 2; }
__device__ __forceinline__ int v_rd_base(int lane) { return ((lane & 3) << 3) | (((lane >> 2) & 3) << 6) | (((lane >> 4) & 1) << 5) | (((lane >> 5) & 1) << 8); }
constexpr int v_rd_off(int d0, int ks, int half) { return d0 * 512 + ks * 4096 + half * 2048; }
template <int OFF> __device__ __forceinline__ s16x4 tr_read(int vb) {
  s16x4 r; asm volatile("ds_read_b64_tr_b16 %0, %1 offset:%2" : "=&v"(r) : "v"(vb), "i"(OFF) : "memory"); return r;
}
template <int D0> __device__ __forceinline__ void pv_one(f32x16& od, int vb, bf16x8 pa0, bf16x8 pa1, bf16x8 pa2, bf16x8 pa3) {
  const s16x4 l0 = tr_read<v_rd_off(D0, 0, 0)>(vb), h0 = tr_read<v_rd_off(D0, 0, 1)>(vb), l1 = tr_read<v_rd_off(D0, 1, 0)>(vb), h1 = tr_read<v_rd_off(D0, 1, 1)>(vb);
  const s16x4 l2 = tr_read<v_rd_off(D0, 2, 0)>(vb), h2 = tr_read<v_rd_off(D0, 2, 1)>(vb), l3 = tr_read<v_rd_off(D0, 3, 0)>(vb), h3 = tr_read<v_rd_off(D0, 3, 1)>(vb);
  asm volatile("s_waitcnt lgkmcnt(0)" ::: "memory"); SBAR();
#define PK(L, H) (bf16x8){L[0], L[1], L[2], L[3], H[0], H[1], H[2], H[3]}
  od = __builtin_amdgcn_mfma_f32_32x32x16_bf16(pa0, PK(l0, h0), od, 0, 0, 0);
  od = __builtin_amdgcn_mfma_f32_32x32x16_bf16(pa1, PK(l1, h1), od, 0, 0, 0);
  od = __builtin_amdgcn_mfma_f32_32x32x16_bf16(pa2, PK(l2, h2), od, 0, 0, 0);
  od = __builtin_amdgcn_mfma_f32_32x32x16_bf16(pa3, PK(l3, h3), od, 0, 0, 0);
#undef PK
}
__device__ __forceinline__ void pv_d0(f32x16* o, int vb, bf16x8 pa0, bf16x8 pa1, bf16x8 pa2, bf16x8 pa3) {
  pv_one<0>(o[0], vb, pa0, pa1, pa2, pa3); pv_one<1>(o[1], vb, pa0, pa1, pa2, pa3); pv_one<2>(o[2], vb, pa0, pa1, pa2, pa3); pv_one<3>(o[3], vb, pa0, pa1, pa2, pa3);
}
}

template <bool LATENT>
__device__ __forceinline__ void attn_unit(ArgsP A, const Ctx& C, int l, int uidx, float* outw) {
  using namespace att;
  const bf16* XIN = (const bf16*)(A->ws + WS_XIN); bf16* MIX = (bf16*)(A->ws + WS_MIX);
  int tid_ = C.tid, wid_ = C.wave; asm volatile("" : "+v"(tid_)); asm volatile("" : "+s"(wid_));
  const int tid = tid_, wid = wid_, lane = tid & 63, r32 = lane & 31, hi = lane >> 5;
  const int h = uidx & 7, b = LATENT ? (uidx >> 6) : (uidx >> 3), rg = (uidx >> 3) & 7;
  const int q0 = LATENT ? NCTX + b * DSEQ + rg * 256 : b * SEQ;
  const int R0 = (rg == 7) ? 24 : max(4 * rg - 4, 0);
  const int NT = LATENT ? ((rg == 0 || rg == 7) ? 12 : 15) : 4;
  LAS unsigned char* lds = C.lds;
  LAS float* wsf = (LAS float*)(lds + OFF_WS) + wid * 64; LAS float* li_l = wsf; LAS float* al_l = wsf + 32;
  LAS float* btab = (LAS float*)(lds + OFF_BT);
  const float* ssq = (const float*)(A->ws + WS_SSQ);
  const float* gkb = A->in[I_KG] + l * HD;
  const int sr = tid >> 4, sc = (tid & 15) * 8, vst0 = v_st(sr, sc), vst1 = v_st(32 + sr, sc);
  const int vb0 = (int)(uintptr_t)(lds + OFF_V) + v_rd_base(lane);
  bf16x8 sv0, sv1, sk0, sk1; f32x4 sq0 = {0.f, 0.f, 0.f, 0.f}, sq1 = sq0; int skrow = 0;
#define SLOAD(j) do { const bf16* kp; const bf16* vp; int ld; \
    if (!LATENT) { skrow = b * SEQ + 64 * (j) + sr; const size_t ro = (size_t)(b * SEQ + 64 * (j)) * DIN + h * HD; kp = XIN + ro + C_K; vp = XIN + ro + C_V; ld = DIN; } \
    else if ((j) < 4) { const size_t ro = (((size_t)b * DEPTH + l) * 256 + 64 * (j)) * 1024 + h * HD; kp = (const bf16*)(A->ws + WS_CKB) + ro; vp = (const bf16*)(A->ws + WS_CVB) + ro; ld = 1024; } \
    else { skrow = NCTX + b * DSEQ + (R0 + (j) - 4) * GW + sr; const size_t ro = (size_t)(NCTX + b * DSEQ + (R0 + (j) - 4) * GW) * DIN + h * HD; kp = XIN + ro + C_K; vp = XIN + ro + C_V; ld = DIN; } \
    if (!LATENT || (j) >= 4) { sq0 = *(const f32x4*)(ssq + ((size_t)skrow * 16 + 8 + h) * 4); sq1 = *(const f32x4*)(ssq + ((size_t)(skrow + 32) * 16 + 8 + h) * 4); } \
    sv0 = *reinterpret_cast<const bf16x8*>(vp + (size_t)sr * ld + sc); sv1 = *reinterpret_cast<const bf16x8*>(vp + (size_t)(32 + sr) * ld + sc); \
    sk0 = *reinterpret_cast<const bf16x8*>(kp + (size_t)sr * ld + sc); sk1 = *reinterpret_cast<const bf16x8*>(kp + (size_t)(32 + sr) * ld + sc); } while (0)
#define KNORM(skx, sqx, rowx) do { const float rk = __builtin_amdgcn_rsqf(((sqx.x + sqx.y) + (sqx.z + sqx.w)) * (1.0f / HD) + EPS); const u32x4 w = *reinterpret_cast<const u32x4*>(&skx); \
    const f32x4 y0 = {bflo(w.x) * rk * gk0.x, bfhi(w.x) * rk * gk0.y, bflo(w.y) * rk * gk0.z, bfhi(w.y) * rk * gk0.w}, y1 = {bflo(w.z) * rk * gk1.x, bfhi(w.z) * rk * gk1.y, bflo(w.w) * rk * gk1.z, bfhi(w.w) * rk * gk1.w}; \
    u32x4 o; o.x = cvtpk(y0.x, y0.y); o.y = cvtpk(y0.z, y0.w); o.z = cvtpk(y1.x, y1.y); o.w = cvtpk(y1.z, y1.w); skx = *reinterpret_cast<bf16x8*>(&o); \
    if (!LATENT) { float* op = outw + OUT_K + (((size_t)b * DEPTH + l) * SEQ + ((rowx) & 255)) * DATT + h * HD + sc; __builtin_nontemporal_store(y0, (f32x4*)op); __builtin_nontemporal_store(y1, (f32x4*)(op + 4)); } } while (0)
#define SWRITE(bu, jn) do { if (!LATENT || (jn) >= 4) { int sc_ = sc; asm volatile("" : "+v"(sc_)); const f32x4 gk0 = *(const f32x4*)(gkb + sc_), gk1 = *(const f32x4*)(gkb + sc_ + 4); KNORM(sk0, sq0, skrow); KNORM(sk1, sq1, skrow + 32); } \
    *(LAS bf16x8*)(lds + OFF_V + (bu) * SHM_V + vst0) = sv0; *(LAS bf16x8*)(lds + OFF_V + (bu) * SHM_V + vst1) = sv1; const int kc = sc * 2; \
    *(LAS bf16x8*)(lds + OFF_K + (bu) * SHM_K + KSWZ(sr, kc)) = sk0; *(LAS bf16x8*)(lds + OFF_K + (bu) * SHM_K + KSWZ(32 + sr, kc)) = sk1; } while (0)
  float m_reg = -1e30f, l_reg = 0.f; f32x16 o[4] = {};
  const int qrow = 4 * rg + (wid >> 1), qcol = 32 * (wid & 1) + r32, rs = min(max(qrow - 4, 0), 24), cs = min(max(qcol - 8, 0), 48);
  const int wsh = cs - 4 * hi;
  const unsigned long long wmask = wsh >= 0 ? (0xFFFFull << wsh) : (0xFFFFull >> (-wsh));
  const unsigned wlo = (unsigned)wmask, whi = (unsigned)(wmask >> 32);
  SLOAD(0);
  bf16x8 qr[8];
  { const int qrow_ = q0 + wid * 32 + r32; const bf16* Qw = XIN + (size_t)qrow_ * DIN + C_Q + h * HD + hi * 8;
    const f32x4 pq = *(const f32x4*)(ssq + ((size_t)qrow_ * 16 + h) * 4); const float rq = __builtin_amdgcn_rsqf(((pq.x + pq.y) + (pq.z + pq.w)) * (1.0f / HD) + EPS);
    const float* gq = A->in[I_QG] + l * HD + hi * 8;
#pragma unroll
    for (int d0 = 0; d0 < 8; ++d0) { const u32x4 w = *reinterpret_cast<const u32x4*>(Qw + d0 * 16); const f32x4 g0 = *(const f32x4*)(gq + d0 * 16), g1 = *(const f32x4*)(gq + d0 * 16 + 4);
      u32x4 o; o.x = cvtpk(bflo(w.x) * rq * g0.x, bfhi(w.x) * rq * g0.y); o.y = cvtpk(bflo(w.y) * rq * g0.z, bfhi(w.y) * rq * g0.w);
      o.z = cvtpk(bflo(w.z) * rq * g1.x, bfhi(w.z) * rq * g1.y); o.w = cvtpk(bflo(w.w) * rq * g1.z, bfhi(w.w) * rq * g1.w); qr[d0] = *reinterpret_cast<bf16x8*>(&o); } }
  if (LATENT) { for (int i = tid; i < 4 * 15 * 31; i += 512) { const int sft = i / 465, q = i % 465, dr = q / 31, dc = q % 31; btab[(sft * 15 + dr) * BT_PITCH + dc + sft] = A->in[I_NAB][((l * NH + h) * 15 + dr) * 31 + dc] * (1.0f / SCALE); } }
  asm volatile("s_waitcnt vmcnt(0)" ::: "memory"); SWRITE(0, 0); __syncthreads();
#pragma unroll 1
  for (int j = 0; j < NT; ++j) {
    const int bu = j & 1;
    if (j + 1 < NT) SLOAD(j + 1);
    bool act = true; int kr = 0;
    if (LATENT && j >= 4) { kr = R0 + j - 4; act = (kr >= rs) && (kr < rs + 8); }
    if (act) {
      f32x16 p0, p1; float mn, alpha; bf16x8 pa0, pa1, pa2, pa3;
      qkt(p0, p1, lds + OFF_K + bu * SHM_K, qr, r32, hi);
      if (LATENT && j >= 4) {
        const LAS f32x4* brow = (const LAS f32x4*)(btab + (((qcol + 1) & 3) * 15 + (kr - qrow + 7)) * BT_PITCH + (15 - qcol) + ((qcol + 1) & 3) + 4 * hi);
        unsigned wl = wlo, wh = whi; asm volatile("" : "+v"(wl), "+v"(wh));
#define MSK1(V, B, X, W) do { const int m_ = ((int)((W) << (31 - (X)))) >> 31; const unsigned t_ = __builtin_bit_cast(unsigned, (V) + (B)); V = __builtin_bit_cast(float, (t_ & (unsigned)m_) | (0xff800000u & ~(unsigned)m_)); } while (0)
#pragma unroll
        for (int g = 0; g < 4; ++g) { const f32x4 b0 = brow[2 * g], b1 = brow[2 * g + 8];
          MSK1(p0[4 * g + 0], b0.x, 8 * g + 0, wl); MSK1(p0[4 * g + 1], b0.y, 8 * g + 1, wl); MSK1(p0[4 * g + 2], b0.z, 8 * g + 2, wl); MSK1(p0[4 * g + 3], b0.w, 8 * g + 3, wl);
          MSK1(p1[4 * g + 0], b1.x, 8 * g + 0, wh); MSK1(p1[4 * g + 1], b1.y, 8 * g + 1, wh); MSK1(p1[4 * g + 2], b1.z, 8 * g + 2, wh); MSK1(p1[4 * g + 3], b1.w, 8 * g + 3, wh); }
#undef MSK1
      }
      partialSM(p0, p1, m_reg, mn, alpha);
      if (__any(alpha < 1.f)) { if (hi == 0) al_l[r32] = alpha; asm volatile("s_waitcnt lgkmcnt(0)" ::: "memory");
#pragma unroll
        for (int d = 0; d < 4; ++d)
#pragma unroll
          for (int r = 0; r < 16; ++r) o[d][r] *= al_l[crow(r, hi)];
        asm volatile("s_waitcnt lgkmcnt(0)" ::: "memory"); }
      finishSM(p0, p1, alpha, l_reg, pa0, pa1, pa2, pa3); SBAR();
      pv_d0(o, vb0 + bu * SHM_V, pa0, pa1, pa2, pa3);
    }
    if (j + 1 < NT) { asm volatile("s_waitcnt vmcnt(0)" ::: "memory"); SWRITE(bu ^ 1, j + 1); }
    __syncthreads();
  }
  int ln2 = lane; asm volatile("" : "+v"(ln2)); const int r32e = ln2 & 31, hie = ln2 >> 5;
  if (hie == 0) li_l[r32e] = l_reg; asm volatile("s_waitcnt lgkmcnt(0)" ::: "memory");
  float rli[16];
#pragma unroll
  for (int r = 0; r < 16; ++r) rli[r] = __builtin_amdgcn_rcpf(li_l[crow(r, hie)]);
  LAS unsigned char* ot = lds + OFF_OT + wid * (32 * 272);
#pragma unroll
  for (int r = 0; r < 16; ++r) { const int orow = crow(r, hie);
#pragma unroll
    for (int d0 = 0; d0 < 4; ++d0) *(LAS bf16*)(ot + orow * 272 + (d0 * 32 + r32e) * 2) = (bf16)f2bf(o[d0][r] * rli[r]); }
  asm volatile("s_waitcnt lgkmcnt(0)" ::: "memory");
  bf16* Ow = MIX + (size_t)(q0 + wid * 32) * DM + h * HD;
#pragma unroll
  for (int i = 0; i < 8; ++i) { const int orow = 4 * i + (ln2 >> 4), oc = (ln2 & 15) * 8; *(u32x4*)(Ow + (size_t)orow * DM + oc) = *(const LAS u32x4*)(ot + orow * 272 + oc * 2); }
  __syncthreads();
#undef SLOAD
#undef SWRITE
#undef KNORM
}
#undef KSWZ
#undef SBAR
__device__ __forceinline__ ConvItem conv_desc(ArgsP A, int l, int set, int r, const LAS float* sht) {
    ConvItem d;
    if (set == 0) {
        if (r < 5632) { const int kb = r / 176, nb = r % 176, n0 = 32 * nb; d.W = A->in[I_WIN] + (size_t)l * DM * DIN; d.WT = (bf16*)(A->ws + WS_WIN) + (size_t)l * DIN * DM; d.K = DM; d.N = DIN; d.k0 = 64 * kb; d.n0 = n0; d.drow0 = n0;
            d.sh = sht; d.shwp = (float*)(A->ws + WS_SHPI) + ((size_t)l * 32 + kb) * 3 * DIN; d.ntot = DIN; }
        else { const int q = r - 5632, kb = q / 64, nb = q % 64; d.W = A->in[I_WOUT] + (size_t)l * DM * DM; d.WT = (bf16*)(A->ws + WS_WOUT) + (size_t)l * DM * DM; d.K = DM; d.N = DM; d.k0 = 64 * kb; d.n0 = 32 * nb; d.drow0 = 32 * nb; d.sh = nullptr; d.shwp = nullptr; d.ntot = 0; }
    } else { const int m = r / 5632, q = r % 5632;
        if (m < 2) { const int kb = q / 176, nb = q % 176, n0 = 32 * nb; d.W = (m ? A->in[I_WU] : A->in[I_WG]) + (size_t)l * DM * DFF; d.WT = (bf16*)(A->ws + WS_WGU) + (size_t)l * 2 * DFF * DM; d.K = DM; d.N = DFF; d.k0 = 64 * kb; d.n0 = n0;
            d.drow0 = 256 * (n0 >> 7) + 128 * m + (n0 & 127); d.sh = sht; d.shwp = (float*)(A->ws + WS_SHPG) + ((size_t)l * 32 + kb) * 3 * 2 * DFF; d.ntot = 2 * DFF; }
        else { const int kb = q / 64, nb = q % 64; d.W = A->in[I_WD] + (size_t)l * DFF * DM; d.WT = (bf16*)(A->ws + WS_WDN) + (size_t)l * DM * DFF; d.K = DFF; d.N = DM; d.k0 = 64 * kb; d.n0 = 32 * nb; d.drow0 = 32 * nb; d.sh = nullptr; d.shwp = nullptr; d.ntot = 0; }
    }
    return d;
}
__device__ __forceinline__ void convert_layer(ArgsP A, const Ctx& C, int l, int set, int jw, int nw) {
    LAS float* scr = (LAS float*)(C.lds + C.wave * 8448);
    LAS float* sht = (LAS float*)(C.lds + 69632);
    const float* mod = (const float*)(A->ws + WS_MOD);
    __syncthreads();
    for (int i = C.tid; i < 3 * DM; i += 512) { const int c = i / DM, k = i % DM; sht[i] = mod[((size_t)l * 3 + c) * 12288 + (set ? 6144 : 0) + k]; }
    __syncthreads();
    const int nitems = set ? 3 * 5632 : 5632 + 2048;
    if (jw < nitems) {
        ConvItem cur = conv_desc(A, l, set, jw, sht); float v[32]; conv_load(cur, C.lane, v);
        for (int r = jw; r < nitems; r += nw) {
            const bool more = r + nw < nitems; ConvItem nxt = cur; float vn[32];
            if (more) { nxt = conv_desc(A, l, set, r + nw, sht); conv_load(nxt, C.lane, vn); }
            conv_process(cur, C.lane, v, scr);
            if (more) { cur = nxt;
#pragma unroll
                for (int i = 0; i < 32; ++i) v[i] = vn[i]; }
        }
    }
    __syncthreads();
}
__device__ __forceinline__ void reduce_shw(ArgsP A, const Ctx& C, int l, int which, bool half_grid = true) {
    const int t0 = (int)blockIdx.x * (NWAVES * 64) + C.tid, nt = (half_grid ? C.G / 2 : C.G) * NWAVES * 64;
    if (which == 0) { const float* shpi = (const float*)(A->ws + WS_SHPI); float* shwi = (float*)(A->ws + WS_SHWI);
        for (int r = t0; r < 3 * DIN; r += nt) { float s = 0.f; for (int kb = 0; kb < 32; ++kb) s += shpi[((size_t)l * 32 + kb) * 3 * DIN + r]; shwi[(size_t)l * 3 * DIN + r] = s; } }
    else { const float* shpg = (const float*)(A->ws + WS_SHPG); float* shwg = (float*)(A->ws + WS_SHWG);
        for (int r = t0; r < 3 * 2 * DFF; r += nt) { float s = 0.f; for (int kb = 0; kb < 32; ++kb) s += shpg[((size_t)l * 32 + kb) * 3 * 2 * DFF + r]; shwg[(size_t)l * 3 * 2 * DFF + r] = s; } }
}
__device__ __forceinline__ void p0a(ArgsP A, const Ctx& C) {
    LAS float* st = (LAS float*)(C.lds + 98304);
    for (int i = C.tid; i < 3 * DM; i += 512) { const int c = i / DM, k = i % DM; const float x = (c == 0) ? A->in[I_CCTX][k] : A->in[I_C][(c - 1) * DM + k]; st[i] = x / (1.0f + expf(-x)); }
    __syncthreads();
    float* modp = (float*)(A->ws + WS_MODP);
    for (int it = C.gw; it < DEPTH * 32 * 48; it += C.ngw) {
        const int nb = it % 48, ks = (it / 48) % 32, l = it / (48 * 32), n = nb * 256 + C.lane * 4;
        const float* w = A->in[I_WMOD] + ((size_t)l * DM + ks * 64) * 12288 + n;
        f32x4 a0 = {0.f, 0.f, 0.f, 0.f}, a1 = a0, a2 = a0;
#pragma unroll 8
        for (int kk = 0; kk < 64; ++kk) { const f32x4 wv = __builtin_nontemporal_load((const f32x4*)(w + (size_t)kk * 12288)); const int k = ks * 64 + kk; a0 += st[k] * wv; a1 += st[DM + k] * wv; a2 += st[2 * DM + k] * wv; }
        float* o = modp + (((size_t)l * 32 + ks) * 3) * 12288 + n;
        *(f32x4*)o = a0; *(f32x4*)(o + 12288) = a1; *(f32x4*)(o + 2 * 12288) = a2;
    }
    lru_prep_wfrag(A, C);
    for (int i = C.gt; i < 2 * DB * DEPTH * 256 * 1024 / 8; i += C.ngt) {
        const int half = DB * DEPTH * 256 * 1024 / 8; const bool isk = i < half; const int j = isk ? i : i - half;
        const float* src = (isk ? A->in[I_CK] : A->in[I_CV]) + (size_t)j * 8; const f32x4 x0 = __builtin_nontemporal_load((const f32x4*)src), x1 = __builtin_nontemporal_load((const f32x4*)(src + 4));
        v4u o; o.x = pk2(x0.x, x0.y); o.y = pk2(x0.z, x0.w); o.z = pk2(x1.x, x1.y); o.w = pk2(x1.z, x1.w);
        *(v4u*)(A->ws + (isk ? WS_CKB : WS_CVB) + (size_t)j * 16) = o; }
}
__device__ __forceinline__ void p0b(ArgsP A, const Ctx& C) {
    const float* modp = (const float*)(A->ws + WS_MODP); float* mod = (float*)(A->ws + WS_MOD); float* gs = (float*)(A->ws + WS_GS);
    for (int i = C.gt; i < DEPTH * 3 * 12288; i += C.ngt) { const int n = i % 12288, c = (i / 12288) % 3, l = i / (3 * 12288);
        float s = A->in[I_BMOD][l * 12288 + n];
        for (int ks = 0; ks < 32; ++ks) s += modp[(((size_t)l * 32 + ks) * 3 + c) * 12288 + n];
        mod[i] = s;
        if (n >= 2048 && n < 4096) gs[(((size_t)l * 2 + 0) * 3 + c) * DM + (n - 2048)] = A->in[I_GMIX][l * DM + n - 2048] * (1.0f + s);
        if (n >= 8192 && n < 10240) gs[(((size_t)l * 2 + 1) * 3 + c) * DM + (n - 8192)] = A->in[I_GFFN][l * DM + n - 8192] * (1.0f + s); }
}
__device__ __forceinline__ void p0c(ArgsP A, const Ctx& C) {
    convert_layer(A, C, 0, 0, C.gw, C.ngw); convert_layer(A, C, 0, 1, C.gw, C.ngw);
    bf16* U = (bf16*)(A->ws + WS_U); float* hssq = (float*)(A->ws + WS_HSSQ); const float* gs0 = (const float*)(A->ws + WS_GS);
    for (int row = C.gw; row < MTOK; row += C.ngw) {
        const int cond = row < NCTX ? 0 : 1 + ((row - NCTX) >> 11);
        const float* hr = row < NCTX ? A->in[I_XP] + (size_t)row * DM : A->in[I_XS] + (size_t)(row - NCTX) * DM;
        const f32x4* xr = (const f32x4*)hr + C.lane; f32x4 v[8]; float s = 0.f;
#pragma unroll
        for (int j = 0; j < 8; ++j) { v[j] = __builtin_nontemporal_load(xr + 64 * j); s += (v[j].x * v[j].x + v[j].y * v[j].y) + (v[j].z * v[j].z + v[j].w * v[j].w); }
        s = wave_sum(s);
        if (C.lane < 32) hssq[(size_t)row * 32 + C.lane] = (C.lane == 0) ? s : 0.f;
#pragma unroll
        for (int j = 0; j < 8; ++j) { const int col = 4 * C.lane + 256 * j; const f32x4 y = v[j] * *(const f32x4*)(gs0 + (size_t)cond * DM + col);
            *(unsigned long long*)(U + (size_t)row * DM + col) = (unsigned long long)pk2(y.x, y.y) | ((unsigned long long)pk2(y.z, y.w) << 32); }
    }
}
__device__ __forceinline__ void p0d(ArgsP A, const Ctx& C) { reduce_shw(A, C, 0, 0, false); reduce_shw(A, C, 0, 1, false); }
__device__ __forceinline__ void mkctx(Ctx& C, LAS unsigned char* lds, const int wave) {
    int wv = wave; asm volatile("" : "+s"(wv));
    int t = wv * 64 + (int)__builtin_amdgcn_mbcnt_hi(~0u, __builtin_amdgcn_mbcnt_lo(~0u, 0u)); asm volatile("" : "+v"(t));
    C.lds = lds; C.tid = t; C.lane = t & 63; C.wave = wv;
    C.G = gridDim.x; C.gw = blockIdx.x * NWAVES + C.wave; C.ngw = C.G * NWAVES; C.gt = blockIdx.x * (NWAVES * 64) + t; C.ngt = C.G * NWAVES * 64;
}
__device__ __forceinline__ void m1_phase(ArgsP A, const Ctx& C, int l, float* outw) {
    const bf16* XIN = (const bf16*)(A->ws + WS_XIN); bf16* MIX = (bf16*)(A->ws + WS_MIX);
    const int half_g = C.G / 2, lt = ((int)blockIdx.x - half_g) * (NWAVES * 64) + C.tid, nlt = (C.G - half_g) * NWAVES * 64;
    if ((int)blockIdx.x >= half_g)
    for (int it = lt; it < (MTOK / 4) * 64; it += nlt) {
        const int ch = it & 63, row0 = (it >> 6) * 4, c0 = ch * 8; int t0, T; if (row0 < NCTX) { t0 = row0 & 255; T = SEQ; } else { t0 = (row0 - NCTX) & 2047; T = DSEQ; }
        v4u cg[6], sx[6], sb[4];
#pragma unroll
        for (int j = 0; j < 6; ++j) { const int tt = t0 + j - 1; cg[j] = (v4u){0u, 0u, 0u, 0u}; sx[j] = cg[j];
            if (tt >= 0 && tt < T) { const bf16* rp = XIN + (size_t)(row0 + j - 1) * DIN; cg[j] = *(const v4u*)(rp + C_SCG + c0); sx[j] = *(const v4u*)(rp + C_SX + c0); } }
#pragma unroll
        for (int j = 0; j < 4; ++j) sb[j] = *(const v4u*)(XIN + (size_t)(row0 + j) * DIN + C_SB + c0);
        float w[3][8];
#pragma unroll
        for (int dk = 0; dk < 3; ++dk)
#pragma unroll
            for (int i = 0; i < 8; ++i) w[dk][i] = A->in[I_SCW][(l * 3 + dk) * DSC + c0 + i];
        float z[6][8];
#pragma unroll
        for (int j = 0; j < 6; ++j) { z[j][0] = bflo(cg[j].x) * bflo(sx[j].x); z[j][1] = bfhi(cg[j].x) * bfhi(sx[j].x); z[j][2] = bflo(cg[j].y) * bflo(sx[j].y); z[j][3] = bfhi(cg[j].y) * bfhi(sx[j].y);
            z[j][4] = bflo(cg[j].z) * bflo(sx[j].z); z[j][5] = bfhi(cg[j].z) * bfhi(sx[j].z); z[j][6] = bflo(cg[j].w) * bflo(sx[j].w); z[j][7] = bfhi(cg[j].w) * bfhi(sx[j].w); }
#pragma unroll
        for (int j = 0; j < 4; ++j) { float acc[8];
#pragma unroll
            for (int i = 0; i < 8; ++i) acc[i] = w[0][i] * z[j][i] + w[1][i] * z[j + 1][i] + w[2][i] * z[j + 2][i];
            v4u o; o.x = pk2(bflo(sb[j].x) * acc[0], bfhi(sb[j].x) * acc[1]); o.y = pk2(bflo(sb[j].y) * acc[2], bfhi(sb[j].y) * acc[3]); o.z = pk2(bflo(sb[j].z) * acc[4], bfhi(sb[j].z) * acc[5]); o.w = pk2(bflo(sb[j].w) * acc[6], bfhi(sb[j].w) * acc[7]);
            *(v4u*)(MIX + (size_t)(row0 + j) * DM + 1536 + c0) = o; }
    }
    for (int u = blockIdx.x; u < 256; u += C.G) {
        if (u < 128) lru_unit<false>(A, C, l, NB + (u >> 6), (u >> 3) & 7, (u >> 1) & 3, u & 1, outw);
        else { const int v = u - 128; lru_unit<true>(A, C, l, v >> 3, 0, (v >> 1) & 3, v & 1, outw); }
    }
}
__device__ __forceinline__ void m2_phase(ArgsP A, LAS unsigned char* lds, const int wave0, int l, float* outw) {
    { Ctx C; mkctx(C, lds, wave0);
      for (int u = blockIdx.x; u < 256; u += C.G) { if (u < 128) attn_unit<true>(A, C, l, u, outw); else attn_unit<false>(A, C, l, u - 128, outw); } }
    { Ctx C; mkctx(C, lds, wave0);
      for (int u = (int)((blockIdx.x + (unsigned)C.G - (128u % (unsigned)C.G)) % (unsigned)C.G); u < 128; u += C.G) lru_unit<true>(A, C, l, NB + (u >> 6), (u >> 3) & 7, (u >> 1) & 3, u & 1, outw); }
}

#define PHASE_BEGIN() ArgsP A = (ArgsP)__builtin_amdgcn_kernarg_segment_ptr(); asm volatile("" : "+s"(A)); Ctx C; mkctx(C, (LAS unsigned char*)lds_raw, wave0); \
    float* mod = (float*)(A->ws + WS_MOD); bf16* U = (bf16*)(A->ws + WS_U); bf16* XIN = (bf16*)(A->ws + WS_XIN); bf16* ACT = (bf16*)(A->ws + WS_ACT); bf16* MIX = (bf16*)(A->ws + WS_MIX); \
    float* outw = A->out; (void)mod; (void)U; (void)XIN; (void)ACT; (void)MIX; (void)outw;
__global__ void __launch_bounds__(NWAVES * 64, 2) fwd(Args A_) {
    extern __shared__ __attribute__((aligned(16))) unsigned char lds_raw[];
    const int wave0 = __builtin_amdgcn_readfirstlane((int)threadIdx.x >> 6);
    { const int t0 = threadIdx.x; for (int u = t0; u < (LDS_BYTES - LDSCTL_OFF) / 4; u += NWAVES * 64) ((LAS unsigned*)((LAS unsigned char*)lds_raw + LDSCTL_OFF))[u] = 0u; }
    __syncthreads();
    volatile LAS unsigned* MISC = (volatile LAS unsigned*)((LAS unsigned char*)lds_raw + MISC_OFF);
    unsigned* barw = (unsigned*)(A_.ws + WS_CTL) + CW_BAR;
    XcdBarrier bar; bar.bar = barw; bar.x = 0; bar.st = nullptr;
    if (MK_MODE == 0) bar = xcd_barrier_post(barw, MISC + 8);
    const int lo = A_.ph_lo, hi = A_.ph_hi;
#define IN(k) (lo <= (k) && (k) < hi)
#define SEAM(k) do { if (IN(k) && IN((k) + 1)) xcd_barrier(bar); } while (0)
    if (IN(0)) { PHASE_BEGIN(); p0a(A, C); } SEAM(0);
    if (IN(1)) { PHASE_BEGIN(); p0b(A, C); } SEAM(1);
    if (IN(2)) { PHASE_BEGIN(); p0c(A, C); } SEAM(2);
    if (IN(3)) { PHASE_BEGIN(); p0d(A, C); } SEAM(3);
    for (int l = 0; l < DEPTH; ++l) {
        const int s0 = NPRO + l * STEPS_PER_LAYER;
        if (IN(s0 + 0)) { PHASE_BEGIN();
            pg8::Gemm g{U, (const bf16*)(A->ws + WS_WIN) + (size_t)l * DIN * DM, MTOK, DIN, DM}; pg8::StaticOrder S; S.init(MTOK, DIN, C.G, (int)blockIdx.x);
            const pg8::RstdTab rt = pg8::rstd_table(C.lds, S, (const float*)(A->ws + WS_HSSQ), C.tid);
            pg8::EpiIn E{XIN, (float*)(A->ws + WS_SSQ), outw + OUT_V + (size_t)l * SEQ * DATT, (const float*)(A->ws + WS_HSSQ), (const float*)(A->ws + WS_SHWI) + (size_t)l * 3 * DIN, rt};
            pg8::gemm_phase<pg8::EpiIn, pg8::StaticOrder, false, true>(C.lds + RING_OFF, g, S, E, wave0);
            { const int rem = (MTOK / 256 * (DIN / 256)) % C.G; if (l + 1 < DEPTH && rem && (int)blockIdx.x >= rem) convert_layer(A, C, l + 1, 0, ((int)blockIdx.x - rem) * NWAVES + C.wave, (C.G - rem) * NWAVES); }
        } SEAM(s0 + 0);
        if (IN(s0 + 1)) { PHASE_BEGIN(); if ((int)blockIdx.x < C.G / 2) { if (l + 1 < DEPTH) reduce_shw(A, C, l + 1, 0); if (l >= 1) reduce_shw(A, C, l, 1); } m1_phase(A, C, l, outw); m2_phase(A, (LAS unsigned char*)lds_raw, wave0, l, outw); } SEAM(s0 + 1);
        if (IN(s0 + 2)) { PHASE_BEGIN();
            pg8::Gemm g{MIX, (const bf16*)(A->ws + WS_WOUT) + (size_t)l * DM * DM, MTOK, DM, DM}; pg8::StaticOrder S; S.init(MTOK, DM, C.G, (int)blockIdx.x);
            bf16* HB = (bf16*)(A->ws + WS_HB);
            pg8::EpiRes E{A->in[I_XP], A->in[I_XS], (l == 0) ? (const bf16*)nullptr : (const bf16*)HB, nullptr, HB, mod + (size_t)l * 3 * 12288 + 4096, (const float*)(A->ws + WS_GS) + ((size_t)l * 2 + 1) * 3 * DM, U, (float*)(A->ws + WS_HSSQ)};
            pg8::gemm_phase<pg8::EpiRes, pg8::StaticOrder, true, true>(C.lds + RING_OFF, g, S, E, wave0);
        } SEAM(s0 + 2);
        if (IN(s0 + 3)) { PHASE_BEGIN();
            pg8::Gemm g{U, (const bf16*)(A->ws + WS_WGU) + (size_t)l * 2 * DFF * DM, MTOK, 2 * DFF, DM}; pg8::StaticOrder S; S.init(MTOK, 2 * DFF, C.G, (int)blockIdx.x);
            const pg8::RstdTab rt = pg8::rstd_table(C.lds, S, (const float*)(A->ws + WS_HSSQ), C.tid);
            pg8::EpiSwiGLU E{ACT, (const float*)(A->ws + WS_HSSQ), (const float*)(A->ws + WS_SHWG) + (size_t)l * 3 * 2 * DFF, rt};
            pg8::gemm_phase<pg8::EpiSwiGLU, pg8::StaticOrder, false, true>(C.lds + RING_OFF, g, S, E, wave0);
            { const int rem = (MTOK / 256 * (2 * DFF / 256)) % C.G; if (l + 1 < DEPTH && rem && (int)blockIdx.x >= rem) convert_layer(A, C, l + 1, 1, ((int)blockIdx.x - rem) * NWAVES + C.wave, (C.G - rem) * NWAVES); }
        } SEAM(s0 + 3);
        if (IN(s0 + 4)) { PHASE_BEGIN();
            pg8::Gemm g{ACT, (const bf16*)(A->ws + WS_WDN) + (size_t)l * DM * DFF, MTOK, DM, DFF}; pg8::StaticOrder S; S.init(MTOK, DM, C.G, (int)blockIdx.x);
            bf16* HB = (bf16*)(A->ws + WS_HB); const bool last = (l + 1 == DEPTH);
            pg8::EpiRes E{nullptr, nullptr, HB, outw, last ? (bf16*)nullptr : HB, mod + (size_t)l * 3 * 12288 + 10240, last ? (const float*)nullptr : (const float*)(A->ws + WS_GS) + ((size_t)(l + 1) * 2 + 0) * 3 * DM, U, (float*)(A->ws + WS_HSSQ)};
            pg8::gemm_phase<pg8::EpiRes, pg8::StaticOrder, true, true>(C.lds + RING_OFF, g, S, E, wave0);
        } SEAM(s0 + 4);
    }
#undef IN
#undef SEAM
}

extern "C" void kernel_launch(void* const* d_in, const int* in_sizes, int n_in, void* d_out, int out_size, void* d_ws, size_t ws_size, hipStream_t stream) {
    static int grid = 0;
    if (grid == 0) {
        if (n_in != 27 || (size_t)out_size != OUT_END || ws_size < WS_END3) { fprintf(stderr, "kernel_launch: shape mismatch: n_in %d out %d ws %zu (need 27, %zu, >= %zu)\n", n_in, out_size, ws_size, (size_t)OUT_END, (size_t)WS_END3); grid = -1; return; }
        int dev = 0, cus = 0, per_cu = 0;
        if (hipGetDevice(&dev) != hipSuccess || hipDeviceGetAttribute(&cus, hipDeviceAttributeMultiprocessorCount, dev) != hipSuccess) { fprintf(stderr, "kernel_launch: device query failed\n"); grid = -1; return; }
        if (hipFuncSetAttribute((const void*)fwd, hipFuncAttributeMaxDynamicSharedMemorySize, LDS_BYTES) != hipSuccess) { fprintf(stderr, "kernel_launch: hipFuncSetAttribute failed\n"); grid = -1; return; }
        if (hipOccupancyMaxActiveBlocksPerMultiprocessor(&per_cu, (const void*)fwd, NWAVES * 64, LDS_BYTES) != hipSuccess || per_cu < 1) fprintf(stderr, "kernel_launch: note: occupancy query reports %d workgroups per CU\n", per_cu);
        (void)hipGetLastError();
        grid = cus;
    }
    if (grid < 0) return;
    if (hipMemsetAsync((char*)d_ws + WS_CTL, 0, CTL_ZERO_BYTES, stream) != hipSuccess) { fprintf(stderr, "kernel_launch: memset failed\n"); return; }
    Args a{};
    for (int i = 0; i < 27; ++i) a.in[i] = (const float*)d_in[i];
    a.out = (float*)d_out; a.ws = (unsigned char*)d_ws;
#if MK_MODE == 0
    a.ph_lo = 0; a.ph_hi = NSTEPS;
    hipLaunchKernelGGL(fwd, dim3(grid), dim3(NWAVES * 64), LDS_BYTES, stream, a);
#else
    for (int s = 0; s < NSTEPS; ++s) { a.ph_lo = s; a.ph_hi = s + 1; hipLaunchKernelGGL(fwd, dim3(grid), dim3(NWAVES * 64), LDS_BYTES, stream, a); }
#endif
    const hipError_t le = hipPeekAtLastError();
    if (le != hipSuccess) fprintf(stderr, "kernel_launch: launch failed: %s\n", hipGetErrorName(le));
}
```

```cpp
#include <hip/hip_runtime.h>
#include <cstdio>
#include <cstdint>
namespace pg8 {
#define PG8_LAS __attribute__((address_space(3)))
typedef unsigned short bf16_t;
typedef short bf16x8 __attribute__((ext_vector_type(8)));
typedef float f32x4 __attribute__((ext_vector_type(4)));
typedef unsigned u32x4 __attribute__((ext_vector_type(4)));
constexpr int BM = 256, BK = 64, HALF = 128, HTB = HALF * BK * 2  , STAGE_BYTES = 8 * HTB, NXCD = 8, WGM = 8;

__host__ __device__ __forceinline__ int lds_byte(int r, int c) { const int st = (r >> 4) * 2 + (c >> 5), rr = r & 15, cc = c & 31, ob = rr * 64 + cc * 2; return st * 1024 + (ob ^ (((ob >> 9) & 1) << 5)); }
__host__ __device__ __forceinline__ void stage_rc(int b, int& R, int& C) { const int st = b / 1024, sb = b % 1024, swz = sb ^ (((sb >> 9) & 1) << 5); R = (st >> 1) * 16 + swz / 64; C = (st & 1) * 32 + (swz % 64) / 2; }
__host__ __device__ __forceinline__ int perm32(int rho) { const int n = rho >> 4, i = rho & 15; return 8 * (i >> 2) + 4 * n + (i & 3); }

struct Unit { int pm, pn; };
struct Gemm { const bf16_t* A; const bf16_t* Bt; int M, N, K; };

struct StaticOrder {
    int nM, nN, nwg, G, c;
    __host__ __device__ void init(int M, int N, int G_, int c_) { nM = M / BM; nN = N / BM; nwg = nM * nN; G = G_; c = c_; }
    __host__ __device__ bool next(int i, Unit& u) const {
        const long L = (long)i * G + c; if (L >= nwg) return false;
        int wgid = (int)L; { const int q = nwg / NXCD, r = nwg % NXCD, xcd = wgid % NXCD, off = wgid / NXCD; wgid = (xcd < r ? xcd * (q + 1) : r * (q + 1) + (xcd - r) * q) + off; }
        const int nig = WGM * nN, gid = wgid / nig, fm = gid * WGM, gsz = (nM - fm) < WGM ? (nM - fm) : WGM;
        u.pm = fm + ((wgid % nig) % gsz); u.pn = (wgid % nig) / gsz; return true;
    }
    __device__ __forceinline__ void a_ready(const Unit&) const {}
    __device__ __forceinline__ void done(const Unit&) const {}
};

__device__ __forceinline__ void st16(void* p, u32x4 v) { *(u32x4*)p = v; }
__device__ __forceinline__ unsigned cvt_pk_bf16(float lo, float hi) { unsigned r; asm volatile("v_cvt_pk_bf16_f32 %0, %1, %2" : "=v"(r) : "v"(lo), "v"(hi)); return r; }

__device__ __forceinline__ float xl16_sum(float s) { s += __builtin_bit_cast(float, __builtin_amdgcn_ds_swizzle(__builtin_bit_cast(int, s), 0x401f)); float a_ = s, b_ = s; asm volatile("s_nop 1\n\tv_permlane32_swap_b32 %0, %1\n\ts_nop 1" : "+v"(a_), "+v"(b_)); return a_ + b_; }
__device__ __forceinline__ void row_rstd(const float* hssq, int row0, int fq, float (&rs)[2][4]) {
#pragma unroll
    for (int ai = 0; ai < 2; ++ai) { f32x4 p[4][2];
#pragma unroll
        for (int m = 0; m < 4; ++m) { const float* hp = hssq + (size_t)(row0 + ai * HALF + m * 16) * 32 + fq * 8; p[m][0] = *(const f32x4*)hp; p[m][1] = *(const f32x4*)(hp + 4); }
#pragma unroll
        for (int m = 0; m < 4; ++m) { const f32x4 q = p[m][0] + p[m][1]; const float t = xl16_sum((q[0] + q[1]) + (q[2] + q[3])); rs[ai][m] = 1.0f / sqrtf(t * (1.0f / 2048.0f) + 1e-6f); } }
}
constexpr int RTAB_OFF = STAGE_BYTES, RTAB_ROWS = 3840;
struct RstdTab { const PG8_LAS float* tab; int row_lo; bool ok; };
template <class Sched>
__device__ __forceinline__ RstdTab rstd_table(PG8_LAS unsigned char* lds, const Sched& S, const float* hssq, int tid) {
    int lo = 1 << 30, hi = -1; Unit u; for (int i = 0; S.next(i, u); ++i) { lo = u.pm < lo ? u.pm : lo; hi = u.pm > hi ? u.pm : hi; }
    RstdTab T; T.tab = (const PG8_LAS float*)(lds + RTAB_OFF); T.row_lo = lo * BM; T.ok = (hi >= lo) && ((hi - lo + 1) * BM <= RTAB_ROWS);
    if (T.ok) { PG8_LAS float* tw = (PG8_LAS float*)(lds + RTAB_OFF); const int nrows = (hi - lo + 1) * BM;
        for (int r = tid; r < nrows; r += 512) { const f32x4* hp = (const f32x4*)(hssq + (size_t)(T.row_lo + r) * 32); f32x4 q = hp[0];
#pragma unroll
            for (int j = 1; j < 8; ++j) q += hp[j];
            tw[r] = 1.0f / sqrtf(((q[0] + q[1]) + (q[2] + q[3])) * (1.0f / 2048.0f) + 1e-6f); } }
    __syncthreads();
    return T;
}
__device__ __forceinline__ void get_rstd(const RstdTab& T, const float* hssq, int row0, int fq, float (&rs)[2][4]) {
    if (T.ok) {
#pragma unroll
        for (int ai = 0; ai < 2; ++ai)
#pragma unroll
            for (int m = 0; m < 4; ++m) rs[ai][m] = T.tab[row0 + ai * HALF + m * 16 - T.row_lo];
    } else row_rstd(hssq, row0, fq, rs);
}
struct EpiIn {
    static constexpr bool PERM = true, AFTER_DRAIN = false;
    bf16_t* O; float* ssq; float* vout; const float* hssq; const float* shw; RstdTab rt;
    __device__ __forceinline__ void operator()(const f32x4 (&acc)[2][2][4][2], const Unit& u, int wr, int wc, int fr, int fq) const {
        const int row0 = u.pm * BM + wr * 64 + fr, col0 = u.pn * BM + wc * 32 + 8 * fq;
        const int cond = u.pm < 16 ? 0 : (u.pm < 24 ? 1 : 2);
        float rs[2][4]; get_rstd(rt, hssq, row0, fq, rs);
        f32x4 bv[2][2];
#pragma unroll
        for (int bj = 0; bj < 2; ++bj)
#pragma unroll
            for (int n = 0; n < 2; ++n) bv[bj][n] = *(const f32x4*)(shw + (size_t)cond * 5632 + col0 + bj * HALF + 4 * n);
#pragma unroll
        for (int ai = 0; ai < 2; ++ai)
#pragma unroll
            for (int m = 0; m < 4; ++m) { const int row = row0 + ai * HALF + m * 16; bf16_t* rowp = O + (size_t)row * 5632 + col0;
#pragma unroll
                for (int bj = 0; bj < 2; ++bj) { const f32x4 v0 = acc[ai][bj][m][0] * rs[ai][m] + bv[bj][0], v1 = acc[ai][bj][m][1] * rs[ai][m] + bv[bj][1];
                    u32x4 w; w.x = cvt_pk_bf16(v0[0], v0[1]); w.y = cvt_pk_bf16(v0[2], v0[3]); w.z = cvt_pk_bf16(v1[0], v1[1]); w.w = cvt_pk_bf16(v1[2], v1[3]);
                    st16(rowp + bj * HALF, w);
                    if (u.pn < 8) {
                        float s = (v0[0] * v0[0] + v0[1] * v0[1]) + (v0[2] * v0[2] + v0[3] * v0[3]) + (v1[0] * v1[0] + v1[1] * v1[1]) + (v1[2] * v1[2] + v1[3] * v1[3]);
                        s = xl16_sum(s);
                        if (fq == 0) ssq[((size_t)row * 16 + (2 * u.pn + bj)) * 4 + wc] = s;
                    } else if (u.pn < 12 && u.pm < 16) {
                        const int b = row >> 8, t = row & 255, col = col0 + bj * HALF - 2048;
                        float* p = vout + ((size_t)b * 1024 + t) * 1024 + col;
                        __builtin_nontemporal_store(v0, (f32x4*)p); __builtin_nontemporal_store(v1, (f32x4*)(p + 4));
                    } } }
    }
};
struct EpiRes {
    static constexpr bool PERM = true, AFTER_DRAIN = false;
    const float* x_lo; const float* x_hi; const bf16_t* hb_in;
    float* y; bf16_t* hb_out;
    const float* gate;
    const float* gsn; bf16_t* un; float* hssq;
    __device__ __forceinline__ void operator()(const f32x4 (&acc)[2][2][4][2], const Unit& u, int wr, int wc, int fr, int fq) const {
        const int row0 = u.pm * BM + wr * 64 + fr, col0 = u.pn * BM + wc * 32 + 8 * fq;
        const int cond = u.pm < 16 ? 0 : (u.pm < 24 ? 1 : 2);
        f32x4 gv[2][2], gs[2][2];
#pragma unroll
        for (int bj = 0; bj < 2; ++bj)
#pragma unroll
            for (int n = 0; n < 2; ++n) { gv[bj][n] = *(const f32x4*)(gate + (size_t)cond * 12288 + col0 + bj * HALF + 4 * n);
                gs[bj][n] = gsn ? *(const f32x4*)(gsn + (size_t)cond * 2048 + col0 + bj * HALF + 4 * n) : (f32x4){0.f, 0.f, 0.f, 0.f}; }
#pragma unroll
        for (int ai = 0; ai < 2; ++ai)
#pragma unroll
            for (int m = 0; m < 4; ++m) { const int row = row0 + ai * HALF + m * 16; const size_t off = (size_t)row * 2048 + col0;
                float s = 0.f;
#pragma unroll
                for (int bj = 0; bj < 2; ++bj) { f32x4 b0, b1;
                    if (hb_in) { const u32x4 w = *(const u32x4*)(hb_in + off + bj * HALF);
                        b0 = (f32x4){__builtin_bit_cast(float, w.x << 16), __builtin_bit_cast(float, w.x & 0xffff0000u), __builtin_bit_cast(float, w.y << 16), __builtin_bit_cast(float, w.y & 0xffff0000u)};
                        b1 = (f32x4){__builtin_bit_cast(float, w.z << 16), __builtin_bit_cast(float, w.z & 0xffff0000u), __builtin_bit_cast(float, w.w << 16), __builtin_bit_cast(float, w.w & 0xffff0000u)}; }
                    else { const float* bp = (u.pm < 16) ? x_lo + off : x_hi + (off - (size_t)4096 * 2048); b0 = *(const f32x4*)(bp + bj * HALF); b1 = *(const f32x4*)(bp + bj * HALF + 4); }
                    const f32x4 o0 = b0 + gv[bj][0] * acc[ai][bj][m][0], o1 = b1 + gv[bj][1] * acc[ai][bj][m][1];
                    if (hb_out) { u32x4 w; w.x = cvt_pk_bf16(o0[0], o0[1]); w.y = cvt_pk_bf16(o0[2], o0[3]); w.z = cvt_pk_bf16(o1[0], o1[1]); w.w = cvt_pk_bf16(o1[2], o1[3]); st16(hb_out + off + bj * HALF, w); }
                    else { __builtin_nontemporal_store(o0, (f32x4*)(y + off + bj * HALF)); __builtin_nontemporal_store(o1, (f32x4*)(y + off + bj * HALF + 4)); }
                    if (gsn) { s += ((o0[0] * o0[0] + o0[1] * o0[1]) + (o0[2] * o0[2] + o0[3] * o0[3])) + ((o1[0] * o1[0] + o1[1] * o1[1]) + (o1[2] * o1[2] + o1[3] * o1[3]));
                        const f32x4 a0 = o0 * gs[bj][0], a1 = o1 * gs[bj][1];
                        u32x4 w; w.x = cvt_pk_bf16(a0[0], a0[1]); w.y = cvt_pk_bf16(a0[2], a0[3]); w.z = cvt_pk_bf16(a1[0], a1[1]); w.w = cvt_pk_bf16(a1[2], a1[3]); st16(un + off + bj * HALF, w); } }
                if (gsn) { s = xl16_sum(s); if (fq == 0) hssq[(size_t)row * 32 + u.pn * 4 + wc] = s; } }
    }
};
__device__ __forceinline__ float silu_f(float g) { return g * __builtin_amdgcn_rcpf(1.0f + __builtin_amdgcn_exp2f(-1.4426950408889634f * g)); }
struct EpiSwiGLU {
    static constexpr bool PERM = true, AFTER_DRAIN = false;
    bf16_t* O; const float* hssq; const float* shw; RstdTab rt;
    __device__ __forceinline__ void operator()(const f32x4 (&acc)[2][2][4][2], const Unit& u, int wr, int wc, int fr, int fq) const {
        const int row0 = u.pm * BM + wr * 64 + fr, col0 = u.pn * HALF + wc * 32 + 8 * fq, bcol0 = u.pn * BM + wc * 32 + 8 * fq;
        const int cond = u.pm < 16 ? 0 : (u.pm < 24 ? 1 : 2);
        float rs[2][4]; get_rstd(rt, hssq, row0, fq, rs);
        f32x4 bv[2][2];
#pragma unroll
        for (int bj = 0; bj < 2; ++bj)
#pragma unroll
            for (int n = 0; n < 2; ++n) bv[bj][n] = *(const f32x4*)(shw + (size_t)cond * 11264 + bcol0 + bj * HALF + 4 * n);
#pragma unroll
        for (int ai = 0; ai < 2; ++ai)
#pragma unroll
            for (int m = 0; m < 4; ++m) { const float r = rs[ai][m];
                const f32x4 g0 = acc[ai][0][m][0] * r + bv[0][0], g1 = acc[ai][0][m][1] * r + bv[0][1], u0 = acc[ai][1][m][0] * r + bv[1][0], u1 = acc[ai][1][m][1] * r + bv[1][1];
                u32x4 w; w.x = cvt_pk_bf16(silu_f(g0[0]) * u0[0], silu_f(g0[1]) * u0[1]); w.y = cvt_pk_bf16(silu_f(g0[2]) * u0[2], silu_f(g0[3]) * u0[3]);
                w.z = cvt_pk_bf16(silu_f(g1[0]) * u1[0], silu_f(g1[1]) * u1[1]); w.w = cvt_pk_bf16(silu_f(g1[2]) * u1[2], silu_f(g1[3]) * u1[3]);
                st16(O + (size_t)(row0 + ai * HALF + m * 16) * 5632 + col0, w); }
    }
};

template <class Epi, class Sched, bool ALIGN_EPI = false, bool SP2 = false>
__device__ __forceinline__ void gemm_phase(PG8_LAS unsigned char* lds, const Gemm g, const Sched& S, const Epi& E, const int wave_id  ) {
    int wv_ = wave_id; asm volatile("" : "+s"(wv_));
    int tid_ = wv_ * 64 + (int)__builtin_amdgcn_mbcnt_hi(~0u, __builtin_amdgcn_mbcnt_lo(~0u, 0u)); asm volatile("" : "+v"(tid_));
    const int tid = tid_, wid = wv_, lane = tid & 63, wr = wid >> 2, wc = wid & 3, fr = lane & 15, fq = lane >> 4;
    const int K = g.K, nt = K / BK;
    unsigned voffA[2], voffB[2];
#pragma unroll
    for (int i = 0; i < 2; ++i) { int R, C; stage_rc(tid * 16 + i * 8192, R, C); const int Rb = Epi::PERM ? ((R & ~31) + perm32(R & 31)) : R;
        voffA[i] = (unsigned)(R * K + C) * 2u; voffB[i] = (unsigned)(Rb * K + C) * 2u; }
    const size_t kstep = (size_t)(BK * 2);
    const size_t hstep = (size_t)HALF * K * 2;
    const size_t tstep = 2 * hstep;
    const unsigned ldsw = (unsigned)wid * 1024u;
    const int aoff = lds_byte(wr * 64 + fr, fq * 8), boff = lds_byte(wc * 32 + fr, fq * 8);
#define PG8_SA(b, h) (((b) * 2 + (h)) * HTB)
#define PG8_SB(b, h) ((4 + (b) * 2 + (h)) * HTB)
#define PG8_STAGE(bufoff, gbase, voff) do { _Pragma("unroll") for (int _i = 0; _i < 2; ++_i) \
        __builtin_amdgcn_global_load_lds((const unsigned*)((const char*)(gbase) + (voff)[_i]), (PG8_LAS unsigned*)(lds + (bufoff) + ldsw + _i * 8192), 16, 0, 0); } while (0)
#define PG8_LDA(dst, b, h) do { _Pragma("unroll") for (int m = 0; m < 4; ++m) _Pragma("unroll") for (int k = 0; k < 2; ++k) dst[m][k] = *(const PG8_LAS bf16x8*)(lds + PG8_SA(b, h) + aoff + m * 2048 + k * 1024); } while (0)
#define PG8_LDB(dst, b, h) do { _Pragma("unroll") for (int n = 0; n < 2; ++n) _Pragma("unroll") for (int k = 0; k < 2; ++k) dst[n][k] = *(const PG8_LAS bf16x8*)(lds + PG8_SB(b, h) + boff + n * 2048 + k * 1024); } while (0)
#define PG8_MMA(ai, bj, At, Bt) do { __builtin_amdgcn_s_setprio(1); _Pragma("unroll") for (int m = 0; m < 4; ++m) _Pragma("unroll") for (int n = 0; n < 2; ++n) _Pragma("unroll") for (int k = 0; k < 2; ++k) \
        acc[ai][bj][m][n] = __builtin_amdgcn_mfma_f32_16x16x32_bf16(Bt[n][k], At[m][k], acc[ai][bj][m][n], 0, 0, 0); __builtin_amdgcn_s_setprio(0); } while (0)
#define PG8_WAIT_V(n) asm volatile("s_waitcnt vmcnt(" #n ")" ::: "memory")
#define PG8_WAIT_L(n) asm volatile("s_waitcnt lgkmcnt(" #n ")" ::: "memory")
#define PG8_BAR __builtin_amdgcn_s_barrier()
#define PG8_SCHED __builtin_amdgcn_sched_barrier(0)
    Unit cur, nxt; int ui = 0;
    if (!S.next(0, cur)) return;
    f32x4 acc[2][2][4][2];
#pragma unroll
    for (int a = 0; a < 2; ++a)
#pragma unroll
        for (int b = 0; b < 2; ++b)
#pragma unroll
            for (int m = 0; m < 4; ++m)
#pragma unroll
                for (int n = 0; n < 2; ++n) acc[a][b][m][n] = (f32x4){0.f, 0.f, 0.f, 0.f};
    bf16x8 At[4][2], B0[2][2], B1[2][2];
    const char* cA = (const char*)g.A + (size_t)cur.pm * tstep; const char* cB = (const char*)g.Bt + (size_t)cur.pn * tstep;
    S.a_ready(cur);
    if constexpr (SP2) {
        PG8_STAGE(PG8_SB(0, 0), cB, voffB); PG8_STAGE(PG8_SB(0, 1), cB + hstep, voffB); PG8_STAGE(PG8_SA(0, 0), cA, voffA); PG8_STAGE(PG8_SA(0, 1), cA + hstep, voffA);
        if (wr == 1) PG8_BAR;
        PG8_WAIT_V(2); PG8_BAR;
        PG8_STAGE(PG8_SB(1, 0), cB + kstep, voffB); PG8_STAGE(PG8_SA(1, 0), cA + kstep, voffA); PG8_STAGE(PG8_SB(1, 1), cB + hstep + kstep, voffB);
        PG8_WAIT_V(6); PG8_BAR;
    } else {
        PG8_STAGE(PG8_SB(0, 0), cB, voffB); PG8_STAGE(PG8_SA(0, 0), cA, voffA); PG8_STAGE(PG8_SB(0, 1), cB + hstep, voffB); PG8_STAGE(PG8_SA(0, 1), cA + hstep, voffA);
        if (wr == 1) PG8_BAR;
        PG8_WAIT_V(4); PG8_BAR;
        PG8_STAGE(PG8_SB(1, 0), cB + kstep, voffB); PG8_STAGE(PG8_SA(1, 0), cA + kstep, voffA); PG8_STAGE(PG8_SB(1, 1), cB + hstep + kstep, voffB);
        PG8_WAIT_V(6); PG8_BAR;
    }
    for (;;) {
        const bool has_next = S.next(ui + 1, nxt);
        const char* nA = has_next ? (const char*)g.A + (size_t)nxt.pm * tstep : cA; const char* nB = has_next ? (const char*)g.Bt + (size_t)nxt.pn * tstep : cB;
        for (int t = 0; t < nt; t += 2) {
            const bool last = (t == nt - 2);
            const char* a1 = cA + (size_t)(t + 1) * kstep;
            const char* a2 = last ? nA : cA + (size_t)(t + 2) * kstep; const char* b2 = last ? nB : cB + (size_t)(t + 2) * kstep;
            const char* a3 = a2 + kstep; const char* b3 = b2 + kstep;
            if (last && has_next) S.a_ready(nxt);
            if constexpr (SP2) {
            PG8_LDB(B0, 0, 0); PG8_LDB(B1, 0, 1); PG8_SCHED; PG8_LDA(At, 0, 0); PG8_STAGE(PG8_SA(1, 1), a1 + hstep, voffA);
            PG8_WAIT_V(8); PG8_WAIT_L(0); PG8_BAR; PG8_MMA(0, 0, At, B0); PG8_MMA(0, 1, At, B1); PG8_BAR; PG8_SCHED;
            PG8_LDA(At, 0, 1); PG8_STAGE(PG8_SB(0, 0), b2, voffB); PG8_STAGE(PG8_SB(0, 1), b2 + hstep, voffB); PG8_STAGE(PG8_SA(0, 0), a2, voffA);
            PG8_WAIT_V(8); PG8_WAIT_L(0); PG8_BAR; PG8_MMA(1, 0, At, B0); PG8_MMA(1, 1, At, B1); PG8_BAR; PG8_SCHED;
            PG8_LDB(B0, 1, 0); PG8_LDB(B1, 1, 1); PG8_SCHED; PG8_LDA(At, 1, 0); PG8_STAGE(PG8_SA(0, 1), a2 + hstep, voffA);
            PG8_WAIT_V(8); PG8_WAIT_L(0); PG8_BAR; PG8_MMA(0, 0, At, B0); PG8_MMA(0, 1, At, B1); PG8_BAR; PG8_SCHED;
            PG8_LDA(At, 1, 1); PG8_STAGE(PG8_SB(1, 0), b3, voffB); PG8_STAGE(PG8_SB(1, 1), b3 + hstep, voffB); PG8_STAGE(PG8_SA(1, 0), a3, voffA);
            PG8_WAIT_V(8); PG8_WAIT_L(0); PG8_BAR; PG8_MMA(1, 0, At, B0); PG8_MMA(1, 1, At, B1); PG8_BAR; PG8_SCHED;
            } else {
            PG8_LDB(B0, 0, 0); PG8_SCHED; PG8_LDA(At, 0, 0); PG8_STAGE(PG8_SA(1, 1), a1 + hstep, voffA);
            PG8_WAIT_L(8); PG8_BAR; PG8_WAIT_L(0); PG8_MMA(0, 0, At, B0); PG8_BAR; PG8_SCHED;
            PG8_LDB(B1, 0, 1); PG8_STAGE(PG8_SB(0, 0), b2, voffB);
            PG8_BAR; PG8_WAIT_L(0); PG8_MMA(0, 1, At, B1); PG8_BAR;
            PG8_LDA(At, 0, 1); PG8_STAGE(PG8_SA(0, 0), a2, voffA);
            PG8_BAR; PG8_WAIT_L(0); PG8_MMA(1, 0, At, B0); PG8_BAR; PG8_SCHED;
            PG8_STAGE(PG8_SB(0, 1), b2 + hstep, voffB);
            PG8_WAIT_V(6); PG8_BAR; PG8_MMA(1, 1, At, B1); PG8_BAR;
            PG8_LDB(B0, 1, 0); PG8_SCHED; PG8_LDA(At, 1, 0); PG8_STAGE(PG8_SA(0, 1), a2 + hstep, voffA);
            PG8_WAIT_L(8); PG8_BAR; PG8_WAIT_L(0); PG8_MMA(0, 0, At, B0); PG8_BAR; PG8_SCHED;
            PG8_LDB(B1, 1, 1); PG8_STAGE(PG8_SB(1, 0), b3, voffB);
            PG8_BAR; PG8_WAIT_L(0); PG8_MMA(0, 1, At, B1); PG8_BAR;
            PG8_LDA(At, 1, 1); PG8_STAGE(PG8_SA(1, 0), a3, voffA);
            PG8_BAR; PG8_WAIT_L(0); PG8_MMA(1, 0, At, B0); PG8_BAR; PG8_SCHED;
            PG8_STAGE(PG8_SB(1, 1), b3 + hstep, voffB);
            PG8_WAIT_V(6); PG8_BAR; PG8_MMA(1, 1, At, B1); PG8_BAR;
            }
        }
        if constexpr (ALIGN_EPI) { if (wr == 0) PG8_BAR; }
        if constexpr (!Epi::AFTER_DRAIN) { E(acc, cur, wr, wc, fr, fq); S.done(cur); }
        if (!has_next) break;
#pragma unroll
        for (int a = 0; a < 2; ++a)
#pragma unroll
            for (int b = 0; b < 2; ++b)
#pragma unroll
                for (int m = 0; m < 4; ++m)
#pragma unroll
                    for (int n = 0; n < 2; ++n) acc[a][b][m][n] = (f32x4){0.f, 0.f, 0.f, 0.f};
        cur = nxt; cA = nA; cB = nB; ++ui;
        if constexpr (ALIGN_EPI) { if (wr == 1) PG8_BAR; }
    }
    PG8_WAIT_V(0);
    if constexpr (!ALIGN_EPI) { if (wr == 0) PG8_BAR; }
    PG8_BAR;
    if constexpr (Epi::AFTER_DRAIN) { E.fused(acc, cur, wr, wc, fr, fq, lds, wid, lane); S.done(cur); }
#undef PG8_SA
#undef PG8_SB
#undef PG8_STAGE
#undef PG8_LDA
#undef PG8_LDB
#undef PG8_MMA
#undef PG8_WAIT_V
#undef PG8_WAIT_L
#undef PG8_BAR
#undef PG8_SCHED
}
}

constexpr int DM = 2048, NCTX = 4096, NLAT = 4096, MTOK = 8192, DEPTH = 4, SEQ = 256, DSEQ = 2048, NB = 16, DB = 2;
constexpr int DIN = 5632, DFF = 5632, DATT = 1024, DLRU = 512, DSC = 512, NH = 8, HD = 128, GW = 64;
constexpr int C_Q = 0, C_K = 1024, C_V = 2048, C_LX = 3072, C_LY = 3584, C_SB = 4096, C_SCG = 4608, C_SX = 5120;
constexpr float EPS = 1e-6f;
constexpr int NWAVES = 8;
#ifndef MK_MODE
#define MK_MODE 0
#endif
constexpr int STEPS_PER_LAYER = 5, NPRO = 4, NSTEPS = NPRO + DEPTH * STEPS_PER_LAYER;

constexpr size_t OUT_Y = 0, OUT_K = (size_t)MTOK * DM, OUT_V = OUT_K + (size_t)NB * DEPTH * SEQ * DATT, OUT_S = OUT_V + (size_t)NB * DEPTH * SEQ * DATT, OUT_END = OUT_S + (size_t)NB * DEPTH * 2 * DLRU;

constexpr size_t MiB = 1u << 20;
constexpr size_t WS_CTL = 0, CTL_ZERO_BYTES = 1 * MiB;
constexpr size_t WS_MOD  = 1 * MiB;
constexpr size_t WS_MODP = 2 * MiB;
constexpr size_t WS_WIN  = 24 * MiB;
constexpr size_t WS_WOUT = WS_WIN + (size_t)DEPTH * DIN * DM * 2;
constexpr size_t WS_WGU  = WS_WOUT + (size_t)DEPTH * DM * DM * 2;
constexpr size_t WS_WDN  = WS_WGU + (size_t)DEPTH * 2 * DFF * DM * 2;
constexpr size_t WS_U    = WS_WDN + (size_t)DEPTH * DM * DFF * 2;
constexpr size_t WS_XIN  = WS_U + (size_t)MTOK * DM * 2;
constexpr size_t WS_ACT  = WS_XIN;
constexpr size_t WS_MIX  = WS_XIN + (size_t)MTOK * DIN * 2;
constexpr size_t WS_SSQ  = WS_MIX + (size_t)MTOK * DM * 2;
constexpr size_t WS_END  = WS_SSQ + (size_t)MTOK * 64 * 4;
constexpr int CW_BAR = 4096;

constexpr int RING_OFF = 0, RING_BYTES = 131072, LDS_BYTES = 147456, LDSCTL_OFF = LDS_BYTES - 512  , MISC_OFF = LDSCTL_OFF + 320;

#define GAS __attribute__((address_space(1)))
#define LAS __attribute__((address_space(3)))
typedef unsigned short bf16;
typedef unsigned v4u __attribute__((ext_vector_type(4)));
typedef float f32x4 __attribute__((ext_vector_type(4)));
typedef GAS unsigned gu32;
#define RLX_AGENT __ATOMIC_RELAXED, __HIP_MEMORY_SCOPE_AGENT
#define LDS_WAIT() asm volatile("s_waitcnt lgkmcnt(0)" ::: "memory")
#define VM_WAIT() asm volatile("s_waitcnt vmcnt(0)" ::: "memory")
__device__ __forceinline__ unsigned f2bf(float f) { unsigned u = __builtin_bit_cast(unsigned, f); return (u + 0x7fffu + ((u >> 16) & 1u)) >> 16; }
__device__ __forceinline__ unsigned pk2(float lo, float hi) { return f2bf(lo) | (f2bf(hi) << 16); }
__device__ __forceinline__ float bflo(unsigned w) { return __builtin_bit_cast(float, w << 16); }
__device__ __forceinline__ float bfhi(unsigned w) { return __builtin_bit_cast(float, w & 0xffff0000u); }
__device__ __forceinline__ float bf2f(bf16 b) { return __builtin_bit_cast(float, ((unsigned)b) << 16); }

#define XB_TMO      128
#define XB_XCNT(j)  (256  + 64 * (j))
#define XB_XSUB(j)  (1280 + 64 * (j))
#define XB_XGEN(j)  (2304 + 64 * (j))
#define XB_TOP      3328
#define XB_TOPGEN   3392
#define XCD_BAR_WORDS 3456
#define XB_SPIN_CAP (1u << 18)

__device__ __forceinline__ unsigned xb_ld(unsigned* p)              { return __hip_atomic_load(p, __ATOMIC_RELAXED, __HIP_MEMORY_SCOPE_AGENT); }
__device__ __forceinline__ unsigned xb_add(unsigned* p, unsigned v) { return __hip_atomic_fetch_add(p, v, __ATOMIC_RELAXED, __HIP_MEMORY_SCOPE_AGENT); }
__device__ __forceinline__ unsigned xb_xcc_id() { return (unsigned)__builtin_amdgcn_s_getreg((3 << 11) | 20) & 0xFu; }
#define XB_SPIN(cond, bar) do { unsigned _sp = 0; while (cond) { __builtin_amdgcn_s_sleep(1); \
    if ((++_sp & 255u) == 0u) { if (xb_ld(&(bar)[XB_TMO])) break; if (_sp > XB_SPIN_CAP) { atomicAdd(&(bar)[XB_TMO], 1u); break; } } } } while (0)

struct XcdBarrier {
    unsigned* bar; unsigned x;
    volatile LAS unsigned* st;
};

__device__ __forceinline__ XcdBarrier xcd_barrier_post(unsigned* bar, volatile LAS unsigned* st) {
    XcdBarrier b; b.bar = bar; b.x = xb_xcc_id(); b.st = st;
    if (threadIdx.x == 0) (void)xb_add(&bar[XB_XCNT(b.x)], 1u);
    return b;
}
__device__ __forceinline__ void xcd_barrier_complete(unsigned* bar, unsigned x, unsigned& nloc, unsigned& nx) {
    const unsigned G = gridDim.x * gridDim.y * gridDim.z;
    unsigned sum, cnt, mine, sp = 0u;
    for (;;) {
        sum = 0u; cnt = 0u; mine = 0u;
#pragma unroll
        for (unsigned j = 0; j < 16; ++j) { const unsigned c = xb_ld(&bar[XB_XCNT(j)]); sum += c; cnt += (c > 0u) ? 1u : 0u; mine = (j == x) ? c : mine; }
        if (sum == G) break;
        __builtin_amdgcn_s_sleep(1);
        if ((++sp & 255u) == 0u) { if (xb_ld(&bar[XB_TMO])) break; if (sp > XB_SPIN_CAP) { atomicAdd(&bar[XB_TMO], 1u); break; } }
    }
    nloc = mine > 0u ? mine : 1u; nx = cnt > 0u ? cnt : 1u;
}

__device__ __forceinline__ void xcd_barrier(const XcdBarrier& b) {
    asm volatile("s_waitcnt vmcnt(0)" ::: "memory");
    __syncthreads();
    if (threadIdx.x == 0) {
        unsigned* bar = b.bar;
        __builtin_amdgcn_s_waitcnt(0);
        unsigned nloc = b.st[0], nx = b.st[1];
        if (nloc == 0u) { xcd_barrier_complete(bar, b.x, nloc, nx); b.st[0] = nloc; b.st[1] = nx; }
        const unsigned old = xb_add(&bar[XB_XSUB(b.x)], 1u);
        const unsigned gen = old / nloc;
        if (old + 1u == (gen + 1u) * nloc) {
            __builtin_amdgcn_fence(__ATOMIC_RELEASE, "agent");
            asm volatile("s_waitcnt vmcnt(0)" ::: "memory");
            const unsigned og = xb_add(&bar[XB_TOP], 1u);
            const unsigned tg = og / nx;
            if (og + 1u == (tg + 1u) * nx) xb_add(&bar[XB_TOPGEN], 1u);
            else XB_SPIN(xb_ld(&bar[XB_TOPGEN]) == tg, bar);
            __builtin_amdgcn_fence(__ATOMIC_ACQUIRE, "agent");
            xb_add(&bar[XB_XGEN(b.x)], 1u);
            asm volatile("s_waitcnt vmcnt(0)" ::: "memory");
        } else {
            XB_SPIN(xb_ld(&bar[XB_XGEN(b.x)]) == gen, bar);
            __builtin_amdgcn_fence(__ATOMIC_ACQUIRE, "agent");
            asm volatile("s_waitcnt vmcnt(0)" ::: "memory");
        }
    }
    __syncthreads();
}

struct Args { const float* in[27]; float* out; unsigned char* ws; int ph_lo, ph_hi; };
typedef const __attribute__((address_space(4))) Args* ArgsP;
struct Ctx { LAS unsigned char* lds; int tid, lane, wave, G, gw, ngw, gt, ngt; };
enum { I_XP = 0, I_XS, I_CK, I_CV, I_ST, I_C, I_CCTX, I_WMOD, I_BMOD, I_GMIX, I_GFFN, I_WIN, I_QG, I_KG, I_NAB, I_LCW, I_LCB, I_LWA, I_LBA, I_LWI, I_LBI, I_LAM, I_SCW, I_WOUT, I_WG, I_WU, I_WD };

template <int XM> __device__ __forceinline__ float swz_xor(float v) { return __builtin_bit_cast(float, __builtin_amdgcn_ds_swizzle(__builtin_bit_cast(int, v), 0x1f | (XM << 10))); }
__device__ __forceinline__ void swap32(float v, float& own, float& other) { own = v; other = v; asm volatile("s_nop 1\n\tv_permlane32_swap_b32 %0, %1\n\ts_nop 1" : "+v"(own), "+v"(other)); }
__device__ __forceinline__ float xor32_sum(float v) { float a, b; swap32(v, a, b); return a + b; }
__device__ __forceinline__ float xor32_max(float v) { float a, b; swap32(v, a, b); return fmaxf(a, b); }
__device__ __forceinline__ float wave_sum(float v) { v += swz_xor<1>(v); v += swz_xor<2>(v); v += swz_xor<4>(v); v += swz_xor<8>(v); v += swz_xor<16>(v); return xor32_sum(v); }
__device__ __forceinline__ float bperm(float v, int byte_idx) { return __builtin_bit_cast(float, __builtin_amdgcn_ds_bpermute(byte_idx, __builtin_bit_cast(int, v))); }

struct ConvItem { const float* W; bf16* WT; const LAS float* sh; float* shwp; int K, N, k0, n0, drow0, ntot; };
__device__ __forceinline__ void conv_load(const ConvItem& d, int lane, float (&v)[32]) {
    const float* wp = d.W + (size_t)(d.k0 + (lane >> 3)) * d.N + d.n0 + 4 * (lane & 7);
#pragma unroll
    for (int i = 0; i < 8; ++i) { const f32x4 t = __builtin_nontemporal_load((const f32x4*)(wp + (size_t)(8 * i) * d.N)); v[4 * i] = t.x; v[4 * i + 1] = t.y; v[4 * i + 2] = t.z; v[4 * i + 3] = t.w; }
}
__device__ __forceinline__ void conv_process(const ConvItem& d, int lane, const float (&v)[32], LAS float* scr) {
#pragma unroll
    for (int i = 0; i < 8; ++i)
#pragma unroll
        for (int j = 0; j < 4; ++j) scr[((lane >> 3) + 8 * i) * 33 + 4 * (lane & 7) + j] = v[4 * i + j];
    LDS_WAIT(); asm volatile("" ::: "memory");
    const int c = lane & 7;
#pragma unroll
    for (int j = 0; j < 4; ++j) { const int n = (lane >> 3) + 8 * j; const LAS float* s = scr + (8 * c) * 33 + n;
        v4u o; o.x = pk2(s[0 * 33], s[1 * 33]); o.y = pk2(s[2 * 33], s[3 * 33]); o.z = pk2(s[4 * 33], s[5 * 33]); o.w = pk2(s[6 * 33], s[7 * 33]);
        __builtin_nontemporal_store(o, (v4u*)(d.WT + (size_t)(d.drow0 + n) * d.K + d.k0 + 8 * c)); }
    if (d.sh) {
        const int n = lane & 31, hf = lane >> 5; float a0 = 0.f, a1 = 0.f, a2 = 0.f;
#pragma unroll
        for (int q = 0; q < 8; ++q) { const int kk = hf * 32 + q * 4; const LAS float* sp = d.sh + d.k0 + kk;
            const f32x4 s0 = *(const LAS f32x4*)sp, s1 = *(const LAS f32x4*)(sp + 2048), s2 = *(const LAS f32x4*)(sp + 4096);
#pragma unroll
            for (int j = 0; j < 4; ++j) { const float w = scr[(kk + j) * 33 + n]; a0 += s0[j] * w; a1 += s1[j] * w; a2 += s2[j] * w; } }
        a0 = xor32_sum(a0); a1 = xor32_sum(a1); a2 = xor32_sum(a2);
        if (lane < 32) { d.shwp[d.drow0 + n] = a0; d.shwp[(size_t)d.ntot + d.drow0 + n] = a1; d.shwp[2 * (size_t)d.ntot + d.drow0 + n] = a2; }
    }
    LDS_WAIT(); asm volatile("" ::: "memory");
}
typedef short bf16x8_t __attribute__((ext_vector_type(8)));
constexpr int XC_STRIDE = 272;
__device__ __forceinline__ int xaddr(int row, int colb) { return row * XC_STRIDE + (colb ^ (((row >> 4) & 3) << 6)); }
constexpr size_t WS_WFRAG = WS_END;
constexpr size_t WS_CKB   = WS_WFRAG + (size_t)DEPTH * 2 * 4 * 2 * 8 * 4 * 64 * 16;
constexpr size_t WS_CVB   = WS_CKB + (size_t)DB * DEPTH * 256 * 1024 * 2;
constexpr size_t WS_END2  = WS_CVB + (size_t)DB * DEPTH * 256 * 1024 * 2;
constexpr size_t WS_HSSQ  = WS_END2;
constexpr size_t WS_GS    = WS_HSSQ + (size_t)MTOK * 32 * 4;
constexpr size_t WS_SHWI  = WS_GS + (size_t)DEPTH * 2 * 3 * DM * 4;
constexpr size_t WS_SHWG  = WS_SHWI + (size_t)DEPTH * 3 * DIN * 4;
constexpr size_t WS_SHPI  = WS_SHWG + (size_t)DEPTH * 3 * 2 * DFF * 4;
constexpr size_t WS_SHPG  = WS_SHPI + (size_t)DEPTH * 32 * 3 * DIN * 4;
constexpr size_t WS_HB    = WS_SHPG + (size_t)DEPTH * 32 * 3 * 2 * DFF * 4;
constexpr size_t WS_END2B = WS_HB + (size_t)MTOK * DM * 2;
constexpr size_t WS_END3  = WS_END2B;

constexpr size_t CTL_GRAN = 262144;
typedef __attribute__((address_space(1))) unsigned long long gu64_t;
__device__ __forceinline__ void gran_store(gu64_t* g, unsigned tag, float v) { __hip_atomic_store(g, ((unsigned long long)tag << 32) | __builtin_bit_cast(unsigned, v), __ATOMIC_RELAXED, __HIP_MEMORY_SCOPE_AGENT); }
struct Aff { float a, b; };
__device__ __forceinline__ Aff aff_then(const Aff first, const Aff second) { Aff r; r.a = second.a * first.a; r.b = second.a * first.b + second.b; return r; }

__device__ __forceinline__ void lru_gate(float pa, float pi, float x, float sp8l, float& a, float& u) {
    const float r = __builtin_amdgcn_rcpf(1.0f + __builtin_amdgcn_exp2f(pa)), ig = __builtin_amdgcn_rcpf(1.0f + __builtin_amdgcn_exp2f(pi));
    a = __builtin_amdgcn_exp2f(sp8l * r);
    const float em = fmaf(-a, a, 1.0f);
    u = __builtin_amdgcn_sqrtf(em) * (ig * x);
}
constexpr int S_OFF = 256 * XC_STRIDE, S_STRIDE = 68;
static_assert(S_OFF + 256 * S_STRIDE * 4 <= LDSCTL_OFF, "LRU LDS tiles below the control words");
__device__ __forceinline__ float gelu_fast(float x) { const float z = 0.7978845608028654f * (x + 0.044715f * x * x * x); return x * __builtin_amdgcn_rcpf(1.0f + __builtin_amdgcn_exp2f(-2.8853900817779268f * z)); }
template <bool FULL>
__device__ __forceinline__ void lru_unit(ArgsP A, const Ctx& C, int l, int sq  , int chunk, int n, int hh, float* outw) {
    const bf16* XIN = (const bf16*)(A->ws + WS_XIN); bf16* MIX = (bf16*)(A->ws + WS_MIX);
    const int T = sq < NB ? SEQ : DSEQ, tlo = chunk * 256, row0 = (sq < NB ? sq * SEQ : NCTX + (sq - NB) * DSEQ) + tlo;
    LAS unsigned char* xl = C.lds;
    LAS float* S = (LAS float*)(C.lds + S_OFF);
    const int tid = C.tid, lane = C.lane, w = C.wave, fr = lane & 15, fq = lane >> 4;
    v4u lyv[4];
    if (FULL) {
#pragma unroll
        for (int k = 0; k < 4; ++k) { const int it = tid + 512 * k, tok = it >> 3, c8 = (it & 7) * 8; lyv[k] = *(const v4u*)(XIN + (size_t)(row0 + tok) * DIN + C_LY + n * 128 + hh * 64 + c8); }
    }
    {
        const int c8 = (tid & 15) * 8, chb = n * 128 + c8; float wt[4][8], bb[8];
#pragma unroll
        for (int i = 0; i < 8; ++i) bb[i] = A->in[I_LCB][l * DLRU + chb + i];
#pragma unroll
        for (int dk = 0; dk < 4; ++dk)
#pragma unroll
            for (int i = 0; i < 8; ++i) wt[dk][i] = A->in[I_LCW][(l * 4 + dk) * DLRU + chb + i];
#pragma unroll
        for (int q = 0; q < 2; ++q) {
            const int tb = 4 * (tid >> 4) + 128 * q;
            v4u xr[7];
#pragma unroll
            for (int j = 0; j < 7; ++j) { const int tt = tlo + tb + j - 2; xr[j] = (v4u){0u, 0u, 0u, 0u}; if (tt >= 0 && tt < T) xr[j] = *(const v4u*)(XIN + (size_t)(row0 + tb + j - 2) * DIN + C_LX + chb); }
#pragma unroll
            for (int t4 = 0; t4 < 4; ++t4) { float xc[8];
#pragma unroll
                for (int i = 0; i < 8; ++i) xc[i] = bb[i];
#pragma unroll
                for (int dk = 0; dk < 4; ++dk) { const v4u x = xr[t4 + dk];
                    xc[0] += wt[dk][0] * bflo(x.x); xc[1] += wt[dk][1] * bfhi(x.x); xc[2] += wt[dk][2] * bflo(x.y); xc[3] += wt[dk][3] * bfhi(x.y);
                    xc[4] += wt[dk][4] * bflo(x.z); xc[5] += wt[dk][5] * bfhi(x.z); xc[6] += wt[dk][6] * bflo(x.w); xc[7] += wt[dk][7] * bfhi(x.w); }
                v4u o; o.x = pk2(xc[0], xc[1]); o.y = pk2(xc[2], xc[3]); o.z = pk2(xc[4], xc[5]); o.w = pk2(xc[6], xc[7]);
                *(LAS v4u*)(xl + xaddr(tb + t4, c8 * 2)) = o; }
        }
    }
    __syncthreads();
    const int d = w >> 2, cg = w & 3, wq = 4 * hh + cg, ch = n * 128 + wq * 16 + fr;
    const bf16x8_t* wfrag = (const bf16x8_t*)(A->ws + WS_WFRAG); gu64_t* gran = (gu64_t*)(A->ws + WS_CTL + CTL_GRAN); const unsigned tag = (unsigned)l + 1u;
    bf16x8_t bfr[2][4];
#pragma unroll
    for (int g = 0; g < 2; ++g)
#pragma unroll
        for (int ks = 0; ks < 4; ++ks) bfr[g][ks] = wfrag[((((((size_t)l * 2 + d) * 4 + n) * 2 + g) * 8 + wq) * 4 + ks) * 64 + lane];
    const float ba = -1.4426950408889634f * A->in[I_LBA][(l * 2 + d) * DLRU + ch], bi = -1.4426950408889634f * A->in[I_LBI][(l * 2 + d) * DLRU + ch];
    const float sp8 = -8.0f * 1.4426950408889634f * log1pf(expf(-A->in[I_LAM][(l * 2 + d) * DLRU + ch]));
    float hrun = 0.f; Aff run; run.a = 1.f; run.b = 0.f;
    if (FULL && sq >= NB) {
        const int b = sq - NB; float h = A->in[I_ST][((b * DEPTH + l) * 2 + d) * DLRU + ch];
        float ga[8], gb[8];
        for (unsigned spins = 0; spins < (1u << 20); ++spins) { bool ok = true;
#pragma unroll
            for (int c2 = 0; c2 < 8; ++c2) { const bool need = (d == 0) ? (c2 < chunk) : (c2 > chunk); ga[c2] = 1.f; gb[c2] = 0.f;
                if (need) { gu64_t* sp = gran + ((((size_t)b * 8 + c2) * 2 + d) * DLRU + ch) * 2;
                    const unsigned long long x0 = __hip_atomic_load(sp, __ATOMIC_RELAXED, __HIP_MEMORY_SCOPE_AGENT), x1 = __hip_atomic_load(sp + 1, __ATOMIC_RELAXED, __HIP_MEMORY_SCOPE_AGENT);
                    ok = ok && ((unsigned)(x0 >> 32) == tag) && ((unsigned)(x1 >> 32) == tag); ga[c2] = __builtin_bit_cast(float, (unsigned)x0); gb[c2] = __builtin_bit_cast(float, (unsigned)x1); } }
            if (__all(ok)) break;
            __builtin_amdgcn_s_sleep(2); }
#pragma unroll
        for (int k = 0; k < 8; ++k) { const int c2 = (d == 0) ? k : 7 - k; h = ga[c2] * h + gb[c2]; }
        hrun = h;
    }
    const int up16 = ((lane - 16) & 63) * 4, up32 = ((lane - 32) & 63) * 4, last = (48 + fr) * 4;
    const int taur = 16 * (fr >> 2) + (fr & 3);
#pragma unroll 1
    for (int half = 0; half < 2; ++half) {
#pragma unroll 1
        for (int k = 0; k < 2; ++k) {
            const int si = half * 2 + k, st = d ? 3 - si : si;
            f32x4 accA[4], accI[4];
#pragma unroll
            for (int j = 0; j < 4; ++j) { accA[j] = (f32x4){ba, ba, ba, ba}; accI[j] = (f32x4){bi, bi, bi, bi};
                const int trow = d ? 64 * st + 63 - (taur + 4 * j) : 64 * st + taur + 4 * j;
#pragma unroll
                for (int ks = 0; ks < 4; ++ks) { const bf16x8_t af = *(const LAS bf16x8_t*)(xl + xaddr(trow, (32 * ks + 8 * fq) * 2));
                    accA[j] = __builtin_amdgcn_mfma_f32_16x16x32_bf16(af, bfr[0][ks], accA[j], 0, 0, 0); accI[j] = __builtin_amdgcn_mfma_f32_16x16x32_bf16(af, bfr[1][ks], accI[j], 0, 0, 0); } }
            const int tokb = d ? 64 * st + 48 - 16 * fq : 64 * st + 16 * fq;
            float a[16], u[16];
            { const LAS unsigned char* xp = xl + xaddr(tokb, (wq * 16 + fr) * 2); float xs[16];
#pragma unroll
              for (int k = 0; k < 16; ++k) xs[k] = bf2f(*(const LAS bf16*)(xp + k * XC_STRIDE));
#pragma unroll
              for (int j = 0; j < 4; ++j)
#pragma unroll
                for (int i = 0; i < 4; ++i) { const int n2 = 4 * j + i; const float x = d ? xs[15 - n2] : xs[n2]; lru_gate(accA[j][i], accI[j][i], x, sp8, a[n2], u[n2]); } }
            Aff L; L.a = 1.f; L.b = 0.f;
#pragma unroll
            for (int n2 = 0; n2 < 16; ++n2) { L.b = a[n2] * L.b + u[n2]; L.a = a[n2] * L.a; }
            Aff I = L;
            { Aff Q; Q.a = bperm(I.a, up16); Q.b = bperm(I.b, up16); const Aff J = aff_then(Q, I); const bool has = fq >= 1; I.a = has ? J.a : I.a; I.b = has ? J.b : I.b; }
            { Aff Q; Q.a = bperm(I.a, up32); Q.b = bperm(I.b, up32); const Aff J = aff_then(Q, I); const bool has = fq >= 2; I.a = has ? J.a : I.a; I.b = has ? J.b : I.b; }
            Aff E; E.a = bperm(I.a, up16); E.b = bperm(I.b, up16); if (fq == 0) { E.a = 1.f; E.b = 0.f; }
            Aff Tt; Tt.a = bperm(I.a, last); Tt.b = bperm(I.b, last);
            if (FULL) {
                float h = E.a * hrun + E.b;
#pragma unroll
                for (int n2 = 0; n2 < 16; ++n2) { h = a[n2] * h + u[n2]; u[n2] = h; }
                LAS float* sp = S + tokb * S_STRIDE + cg * 16 + fr;
                if (half == 0) {
#pragma unroll
                    for (int k = 0; k < 16; ++k) sp[k * S_STRIDE] = d ? u[15 - k] : u[k];
                } else {
#pragma unroll
                    for (int k = 0; k < 16; ++k) sp[k * S_STRIDE] += d ? u[15 - k] : u[k];
                }
                hrun = Tt.a * hrun + Tt.b;
            } else { run = aff_then(run, Tt); }
        }
        if (FULL) __syncthreads();
    }
    if (FULL) {
        if (sq < NB && lane < 16) outw[OUT_S + ((size_t)(sq * DEPTH + l) * 2 + d) * DLRU + ch] = hrun;
#pragma unroll
        for (int k = 0; k < 4; ++k) { const int it = tid + 512 * k, tok = it >> 3, c8 = (it & 7) * 8; const size_t row = (size_t)(row0 + tok);
            const f32x4 s0 = *(const LAS f32x4*)(S + tok * S_STRIDE + c8), s1 = *(const LAS f32x4*)(S + tok * S_STRIDE + c8 + 4);
            const v4u ly = lyv[k]; v4u o;
            o.x = pk2(s0.x * gelu_fast(bflo(ly.x)), s0.y * gelu_fast(bfhi(ly.x))); o.y = pk2(s0.z * gelu_fast(bflo(ly.y)), s0.w * gelu_fast(bfhi(ly.y)));
            o.z = pk2(s1.x * gelu_fast(bflo(ly.z)), s1.y * gelu_fast(bfhi(ly.z))); o.w = pk2(s1.z * gelu_fast(bflo(ly.w)), s1.w * gelu_fast(bfhi(ly.w)));
            *(v4u*)(MIX + row * DM + 1024 + n * 128 + hh * 64 + c8) = o; }
    } else if (lane < 16) { gu64_t* sp = gran + ((((size_t)(sq - NB) * 8 + chunk) * 2 + d) * DLRU + ch) * 2; gran_store(sp, tag, run.a); gran_store(sp + 1, tag, run.b); }
    __syncthreads();
}
__device__ __forceinline__ void lru_prep_wfrag(ArgsP A, const Ctx& C) {
    v4u* wf = (v4u*)(A->ws + WS_WFRAG);
    for (int it = C.gt; it < DEPTH * 2 * 4 * 2 * 8 * 4 * 64; it += C.ngt) {
        const int lane = it & 63, ks = (it >> 6) & 3, w = (it >> 8) & 7, g = (it >> 11) & 1, ldn = it >> 12;
        const float* W = (g == 0 ? A->in[I_LWA] : A->in[I_LWI]) + (size_t)ldn * 128 * 128;
        const int k0 = 32 * ks + 8 * (lane >> 4), j = 16 * w + (lane & 15);
        const float sc = -1.4426950408889634f;
        v4u o; o.x = pk2(sc * W[(k0 + 0) * 128 + j], sc * W[(k0 + 1) * 128 + j]); o.y = pk2(sc * W[(k0 + 2) * 128 + j], sc * W[(k0 + 3) * 128 + j]);
        o.z = pk2(sc * W[(k0 + 4) * 128 + j], sc * W[(k0 + 5) * 128 + j]); o.w = pk2(sc * W[(k0 + 6) * 128 + j], sc * W[(k0 + 7) * 128 + j]);
        wf[it] = o;
    }
}
namespace att {
using bf16x8 = __attribute__((ext_vector_type(8))) short;
using s16x4  = __attribute__((ext_vector_type(4))) short;
using f32x16 = __attribute__((ext_vector_type(16))) float;
using u32x4  = __attribute__((ext_vector_type(4))) unsigned;
constexpr float SCALE = 0.088388347648318440f, THR = 8.f;
constexpr int SHM_V = 16384, SHM_K = 16384, OFF_V = 0, OFF_K = 2 * SHM_V, OFF_WS = 2 * SHM_V + 2 * SHM_K, OFF_BT = OFF_WS + 8 * 256, BT_PITCH = 36, OFF_OT = OFF_BT + 4 * 15 * BT_PITCH * 4 + 64, LDS_ATT = OFF_OT + 8 * 32 * 272;
static_assert(LDS_ATT <= LDSCTL_OFF, "attention LDS tiles below the control words");
#define KSWZ(row, colB) ((row) * 256 + ((colB) ^ (((row) & 7) << 4)))
#define SBAR() __builtin_amdgcn_sched_barrier(0)
__device__ __forceinline__ int crow(int r, int hi) { return (r & 3) + 8 * (r >> 2) + 4 * hi; }
__device__ __forceinline__ unsigned cvtpk(float lo, float hi) { unsigned r; asm volatile("v_cvt_pk_bf16_f32 %0, %1, %2" : "=v"(r) : "v"(lo), "v"(hi)); return r; }
__device__ __forceinline__ void partialSM(f32x16& p0, f32x16& p1, float& m_reg, float& mn, float& alpha) {
  constexpr float C = SCALE * 1.4426950408889634f;
  float pmax = p0[0];
#pragma unroll
  for (int r = 1; r < 16; ++r) pmax = fmaxf(pmax, p0[r]);
#pragma unroll
  for (int r = 0; r < 16; ++r) pmax = fmaxf(pmax, p1[r]);
  pmax = xor32_max(pmax);
  if (__builtin_expect(__all(pmax - m_reg <= THR / SCALE), 1)) { mn = m_reg; alpha = 1.f; }
  else { mn = fmaxf(m_reg, pmax); alpha = __builtin_amdgcn_exp2f((m_reg - mn) * C); m_reg = mn; }
  float mnC = -mn * C;
#pragma unroll
  for (int r = 0; r < 16; ++r) p0[r] = fmaf(p0[r], C, mnC);
#pragma unroll
  for (int r = 0; r < 16; ++r) p1[r] = fmaf(p1[r], C, mnC);
#pragma unroll
  for (int r = 0; r < 16; ++r) p0[r] = __builtin_amdgcn_exp2f(p0[r]);
}
__device__ __forceinline__ void finishSM(f32x16& p0, f32x16& p1, float alpha, float& l_reg, bf16x8& pa0, bf16x8& pa1, bf16x8& pa2, bf16x8& pa3) {
#pragma unroll
  for (int r = 0; r < 16; ++r) p1[r] = __builtin_amdgcn_exp2f(p1[r]);
  float ps = 0;
#pragma unroll
  for (int r = 0; r < 16; ++r) ps += p0[r];
#pragma unroll
  for (int r = 0; r < 16; ++r) ps += p1[r];
  ps = xor32_sum(ps);
  l_reg = l_reg * alpha + ps;
#define PK4(P, BASE, OUT) do { unsigned a0 = cvtpk(P[BASE + 0], P[BASE + 1]), a1 = cvtpk(P[BASE + 2], P[BASE + 3]);   \
    unsigned b0 = cvtpk(P[BASE + 4], P[BASE + 5]), b1 = cvtpk(P[BASE + 6], P[BASE + 7]);                              \
    auto r0 = __builtin_amdgcn_permlane32_swap(a0, b0, false, false); auto r1 = __builtin_amdgcn_permlane32_swap(a1, b1, false, false); \
    u32x4 w = {r0[0], r1[0], r0[1], r1[1]}; OUT = *reinterpret_cast<bf16x8*>(&w); } while (0)
  PK4(p0, 0, pa0); PK4(p0, 8, pa1); PK4(p1, 0, pa2); PK4(p1, 8, pa3);
#undef PK4
}
__device__ __forceinline__ void qkt(f32x16& p0, f32x16& p1, const LAS unsigned char* Ks, const bf16x8* qr, int r32, int hi) {
  p0 = f32x16{}; p1 = f32x16{};
#pragma unroll
  for (int d0 = 0; d0 < 8; ++d0) { int cb = (d0 * 16 + hi * 8) * 2;
    bf16x8 b0 = *reinterpret_cast<const LAS bf16x8*>(Ks + KSWZ(r32, cb));
    bf16x8 b1 = *reinterpret_cast<const LAS bf16x8*>(Ks + KSWZ(32 + r32, cb));
    p0 = __builtin_amdgcn_mfma_f32_32x32x16_bf16(b0, qr[d0], p0, 0, 0, 0);
    p1 = __builtin_amdgcn_mfma_f32_32x32x16_bf16(b1, qr[d0], p1, 0, 0, 0); }
}
__device__ __forceinline__ int v_st(int k, int c) { const int kk = (k & ~0xC) | ((k & 4) << 1) | ((k & 8) >> 1); return ((kk >> 3) * 4 + (c >> 5)) * 512 + ((kk & 7) * 32 + (c & 31)) * 2; }
__device__ __forceinline__ int v_rd_base(int lane) { return ((lane & 3) << 3) | (((lane >> 2) & 3) << 6) | (((lane >> 4) & 1) << 5) | (((lane >> 5) & 1) << 8); }
constexpr int v_rd_off(int d0, int ks, int half) { return d0 * 512 + ks * 4096 + half * 2048; }
template <int OFF> __device__ __forceinline__ s16x4 tr_read(int vb) {
  s16x4 r; asm volatile("ds_read_b64_tr_b16 %0, %1 offset:%2" : "=&v"(r) : "v"(vb), "i"(OFF) : "memory"); return r;
}
template <int D0> __device__ __forceinline__ void pv_one(f32x16& od, int vb, bf16x8 pa0, bf16x8 pa1, bf16x8 pa2, bf16x8 pa3) {
  const s16x4 l0 = tr_read<v_rd_off(D0, 0, 0)>(vb), h0 = tr_read<v_rd_off(D0, 0, 1)>(vb), l1 = tr_read<v_rd_off(D0, 1, 0)>(vb), h1 = tr_read<v_rd_off(D0, 1, 1)>(vb);
  const s16x4 l2 = tr_read<v_rd_off(D0, 2, 0)>(vb), h2 = tr_read<v_rd_off(D0, 2, 1)>(vb), l3 = tr_read<v_rd_off(D0, 3, 0)>(vb), h3 = tr_read<v_rd_off(D0, 3, 1)>(vb);
  asm volatile("s_waitcnt lgkmcnt(0)" ::: "memory"); SBAR();
#define PK(L, H) (bf16x8){L[0], L[1], L[2], L[3], H[0], H[1], H[2], H[3]}
  od = __builtin_amdgcn_mfma_f32_32x32x16_bf16(pa0, PK(l0, h0), od, 0, 0, 0);
  od = __builtin_amdgcn_mfma_f32_32x32x16_bf16(pa1, PK(l1, h1), od, 0, 0, 0);
  od = __builtin_amdgcn_mfma_f32_32x32x16_bf16(pa2, PK(l2, h2), od, 0, 0, 0);
  od = __builtin_amdgcn_mfma_f32_32x32x16_bf16(pa3, PK(l3, h3), od, 0, 0, 0);
#undef PK
}
__device__ __forceinline__ void pv_d0(f32x16* o, int vb, bf16x8 pa0, bf16x8 pa1, bf16x8 pa2, bf16x8 pa3) {
  pv_one<0>(o[0], vb, pa0, pa1, pa2, pa3); pv_one<1>(o[1], vb, pa0, pa1, pa2, pa3); pv_one<2>(o[2], vb, pa0, pa1, pa2, pa3); pv_one<3>(o[3], vb, pa0, pa1, pa2, pa3);
}
}

template <bool LATENT>
__device__ __forceinline__ void attn_unit(ArgsP A, const Ctx& C, int l, int uidx, float* outw) {
  using namespace att;
  const bf16* XIN = (const bf16*)(A->ws + WS_XIN); bf16* MIX = (bf16*)(A->ws + WS_MIX);
  int tid_ = C.tid, wid_ = C.wave; asm volatile("" : "+v"(tid_)); asm volatile("" : "+s"(wid_));
  const int tid = tid_, wid = wid_, lane = tid & 63, r32 = lane & 31, hi = lane >> 5;
  const int h = uidx & 7, b = LATENT ? (uidx >> 6) : (uidx >> 3), rg = (uidx >> 3) & 7;
  const int q0 = LATENT ? NCTX + b * DSEQ + rg * 256 : b * SEQ;
  const int R0 = (rg == 7) ? 24 : max(4 * rg - 4, 0);
  const int NT = LATENT ? ((rg == 0 || rg == 7) ? 12 : 15) : 4;
  LAS unsigned char* lds = C.lds;
  LAS float* wsf = (LAS float*)(lds + OFF_WS) + wid * 64; LAS float* li_l = wsf; LAS float* al_l = wsf + 32;
  LAS float* btab = (LAS float*)(lds + OFF_BT);
  const float* ssq = (const float*)(A->ws + WS_SSQ);
  const float* gkb = A->in[I_KG] + l * HD;
  const int sr = tid >> 4, sc = (tid & 15) * 8, vst0 = v_st(sr, sc), vst1 = v_st(32 + sr, sc);
  const int vb0 = (int)(uintptr_t)(lds + OFF_V) + v_rd_base(lane);
  bf16x8 sv0, sv1, sk0, sk1; f32x4 sq0 = {0.f, 0.f, 0.f, 0.f}, sq1 = sq0; int skrow = 0;
#define SLOAD(j) do { const bf16* kp; const bf16* vp; int ld; \
    if (!LATENT) { skrow = b * SEQ + 64 * (j) + sr; const size_t ro = (size_t)(b * SEQ + 64 * (j)) * DIN + h * HD; kp = XIN + ro + C_K; vp = XIN + ro + C_V; ld = DIN; } \
    else if ((j) < 4) { const size_t ro = (((size_t)b * DEPTH + l) * 256 + 64 * (j)) * 1024 + h * HD; kp = (const bf16*)(A->ws + WS_CKB) + ro; vp = (const bf16*)(A->ws + WS_CVB) + ro; ld = 1024; } \
    else { skrow = NCTX + b * DSEQ + (R0 + (j) - 4) * GW + sr; const size_t ro = (size_t)(NCTX + b * DSEQ + (R0 + (j) - 4) * GW) * DIN + h * HD; kp = XIN + ro + C_K; vp = XIN + ro + C_V; ld = DIN; } \
    if (!LATENT || (j) >= 4) { sq0 = *(const f32x4*)(ssq + ((size_t)skrow * 16 + 8 + h) * 4); sq1 = *(const f32x4*)(ssq + ((size_t)(skrow + 32) * 16 + 8 + h) * 4); } \
    sv0 = *reinterpret_cast<const bf16x8*>(vp + (size_t)sr * ld + sc); sv1 = *reinterpret_cast<const bf16x8*>(vp + (size_t)(32 + sr) * ld + sc); \
    sk0 = *reinterpret_cast<const bf16x8*>(kp + (size_t)sr * ld + sc); sk1 = *reinterpret_cast<const bf16x8*>(kp + (size_t)(32 + sr) * ld + sc); } while (0)
#define KNORM(skx, sqx, rowx) do { const float rk = __builtin_amdgcn_rsqf(((sqx.x + sqx.y) + (sqx.z + sqx.w)) * (1.0f / HD) + EPS); const u32x4 w = *reinterpret_cast<const u32x4*>(&skx); \
    const f32x4 y0 = {bflo(w.x) * rk * gk0.x, bfhi(w.x) * rk * gk0.y, bflo(w.y) * rk * gk0.z, bfhi(w.y) * rk * gk0.w}, y1 = {bflo(w.z) * rk * gk1.x, bfhi(w.z) * rk * gk1.y, bflo(w.w) * rk * gk1.z, bfhi(w.w) * rk * gk1.w}; \
    u32x4 o; o.x = cvtpk(y0.x, y0.y); o.y = cvtpk(y0.z, y0.w); o.z = cvtpk(y1.x, y1.y); o.w = cvtpk(y1.z, y1.w); skx = *reinterpret_cast<bf16x8*>(&o); \
    if (!LATENT) { float* op = outw + OUT_K + (((size_t)b * DEPTH + l) * SEQ + ((rowx) & 255)) * DATT + h * HD + sc; __builtin_nontemporal_store(y0, (f32x4*)op); __builtin_nontemporal_store(y1, (f32x4*)(op + 4)); } } while (0)
#define SWRITE(bu, jn) do { if (!LATENT || (jn) >= 4) { int sc_ = sc; asm volatile("" : "+v"(sc_)); const f32x4 gk0 = *(const f32x4*)(gkb + sc_), gk1 = *(const f32x4*)(gkb + sc_ + 4); KNORM(sk0, sq0, skrow); KNORM(sk1, sq1, skrow + 32); } \
    *(LAS bf16x8*)(lds + OFF_V + (bu) * SHM_V + vst0) = sv0; *(LAS bf16x8*)(lds + OFF_V + (bu) * SHM_V + vst1) = sv1; const int kc = sc * 2; \
    *(LAS bf16x8*)(lds + OFF_K + (bu) * SHM_K + KSWZ(sr, kc)) = sk0; *(LAS bf16x8*)(lds + OFF_K + (bu) * SHM_K + KSWZ(32 + sr, kc)) = sk1; } while (0)
  float m_reg = -1e30f, l_reg = 0.f; f32x16 o[4] = {};
  const int qrow = 4 * rg + (wid >> 1), qcol = 32 * (wid & 1) + r32, rs = min(max(qrow - 4, 0), 24), cs = min(max(qcol - 8, 0), 48);
  const int wsh = cs - 4 * hi;
  const unsigned long long wmask = wsh >= 0 ? (0xFFFFull << wsh) : (0xFFFFull >> (-wsh));
  const unsigned wlo = (unsigned)wmask, whi = (unsigned)(wmask >> 32);
  SLOAD(0);
  bf16x8 qr[8];
  { const int qrow_ = q0 + wid * 32 + r32; const bf16* Qw = XIN + (size_t)qrow_ * DIN + C_Q + h * HD + hi * 8;
    const f32x4 pq = *(const f32x4*)(ssq + ((size_t)qrow_ * 16 + h) * 4); const float rq = __builtin_amdgcn_rsqf(((pq.x + pq.y) + (pq.z + pq.w)) * (1.0f / HD) + EPS);
    const float* gq = A->in[I_QG] + l * HD + hi * 8;
#pragma unroll
    for (int d0 = 0; d0 < 8; ++d0) { const u32x4 w = *reinterpret_cast<const u32x4*>(Qw + d0 * 16); const f32x4 g0 = *(const f32x4*)(gq + d0 * 16), g1 = *(const f32x4*)(gq + d0 * 16 + 4);
      u32x4 o; o.x = cvtpk(bflo(w.x) * rq * g0.x, bfhi(w.x) * rq * g0.y); o.y = cvtpk(bflo(w.y) * rq * g0.z, bfhi(w.y) * rq * g0.w);
      o.z = cvtpk(bflo(w.z) * rq * g1.x, bfhi(w.z) * rq * g1.y); o.w = cvtpk(bflo(w.w) * rq * g1.z, bfhi(w.w) * rq * g1.w); qr[d0] = *reinterpret_cast<bf16x8*>(&o); } }
  if (LATENT) { for (int i = tid; i < 4 * 15 * 31; i += 512) { const int sft = i / 465, q = i % 465, dr = q / 31, dc = q % 31; btab[(sft * 15 + dr) * BT_PITCH + dc + sft] = A->in[I_NAB][((l * NH + h) * 15 + dr) * 31 + dc] * (1.0f / SCALE); } }
  asm volatile("s_waitcnt vmcnt(0)" ::: "memory"); SWRITE(0, 0); __syncthreads();
#pragma unroll 1
  for (int j = 0; j < NT; ++j) {
    const int bu = j & 1;
    if (j + 1 < NT) SLOAD(j + 1);
    bool act = true; int kr = 0;
    if (LATENT && j >= 4) { kr = R0 + j - 4; act = (kr >= rs) && (kr < rs + 8); }
    if (act) {
      f32x16 p0, p1; float mn, alpha; bf16x8 pa0, pa1, pa2, pa3;
      qkt(p0, p1, lds + OFF_K + bu * SHM_K, qr, r32, hi);
      if (LATENT && j >= 4) {
        const LAS f32x4* brow = (const LAS f32x4*)(btab + (((qcol + 1) & 3) * 15 + (kr - qrow + 7)) * BT_PITCH + (15 - qcol) + ((qcol + 1) & 3) + 4 * hi);
        unsigned wl = wlo, wh = whi; asm volatile("" : "+v"(wl), "+v"(wh));
#define MSK1(V, B, X, W) do { const int m_ = ((int)((W) << (31 - (X)))) >> 31; const unsigned t_ = __builtin_bit_cast(unsigned, (V) + (B)); V = __builtin_bit_cast(float, (t_ & (unsigned)m_) | (0xff800000u & ~(unsigned)m_)); } while (0)
#pragma unroll
        for (int g = 0; g < 4; ++g) { const f32x4 b0 = brow[2 * g], b1 = brow[2 * g + 8];
          MSK1(p0[4 * g + 0], b0.x, 8 * g + 0, wl); MSK1(p0[4 * g + 1], b0.y, 8 * g + 1, wl); MSK1(p0[4 * g + 2], b0.z, 8 * g + 2, wl); MSK1(p0[4 * g + 3], b0.w, 8 * g + 3, wl);
          MSK1(p1[4 * g + 0], b1.x, 8 * g + 0, wh); MSK1(p1[4 * g + 1], b1.y, 8 * g + 1, wh); MSK1(p1[4 * g + 2], b1.z, 8 * g + 2, wh); MSK1(p1[4 * g + 3], b1.w, 8 * g + 3, wh); }
#undef MSK1
      }
      partialSM(p0, p1, m_reg, mn, alpha);
      if (__any(alpha < 1.f)) { if (hi == 0) al_l[r32] = alpha; asm volatile("s_waitcnt lgkmcnt(0)" ::: "memory");
#pragma unroll
        for (int d = 0; d < 4; ++d)
#pragma unroll
          for (int r = 0; r < 16; ++r) o[d][r] *= al_l[crow(r, hi)];
        asm volatile("s_waitcnt lgkmcnt(0)" ::: "memory"); }
      finishSM(p0, p1, alpha, l_reg, pa0, pa1, pa2, pa3); SBAR();
      pv_d0(o, vb0 + bu * SHM_V, pa0, pa1, pa2, pa3);
    }
    if (j + 1 < NT) { asm volatile("s_waitcnt vmcnt(0)" ::: "memory"); SWRITE(bu ^ 1, j + 1); }
    __syncthreads();
  }
  int ln2 = lane; asm volatile("" : "+v"(ln2)); const int r32e = ln2 & 31, hie = ln2 >> 5;
  if (hie == 0) li_l[r32e] = l_reg; asm volatile("s_waitcnt lgkmcnt(0)" ::: "memory");
  float rli[16];
#pragma unroll
  for (int r = 0; r < 16; ++r) rli[r] = __builtin_amdgcn_rcpf(li_l[crow(r, hie)]);
  LAS unsigned char* ot = lds + OFF_OT + wid * (32 * 272);
#pragma unroll
  for (int r = 0; r < 16; ++r) { const int orow = crow(r, hie);
#pragma unroll
    for (int d0 = 0; d0 < 4; ++d0) *(LAS bf16*)(ot + orow * 272 + (d0 * 32 + r32e) * 2) = (bf16)f2bf(o[d0][r] * rli[r]); }
  asm volatile("s_waitcnt lgkmcnt(0)" ::: "memory");
  bf16* Ow = MIX + (size_t)(q0 + wid * 32) * DM + h * HD;
#pragma unroll
  for (int i = 0; i < 8; ++i) { const int orow = 4 * i + (ln2 >> 4), oc = (ln2 & 15) * 8; *(u32x4*)(Ow + (size_t)orow * DM + oc) = *(const LAS u32x4*)(ot + orow * 272 + oc * 2); }
  __syncthreads();
#undef SLOAD
#undef SWRITE
#undef KNORM
}
#undef KSWZ
#undef SBAR
__device__ __forceinline__ ConvItem conv_desc(ArgsP A, int l, int set, int r, const LAS float* sht) {
    ConvItem d;
    if (set == 0) {
        if (r < 5632) { const int kb = r / 176, nb = r % 176, n0 = 32 * nb; d.W = A->in[I_WIN] + (size_t)l * DM * DIN; d.WT = (bf16*)(A->ws + WS_WIN) + (size_t)l * DIN * DM; d.K = DM; d.N = DIN; d.k0 = 64 * kb; d.n0 = n0; d.drow0 = n0;
            d.sh = sht; d.shwp = (float*)(A->ws + WS_SHPI) + ((size_t)l * 32 + kb) * 3 * DIN; d.ntot = DIN; }
        else { const int q = r - 5632, kb = q / 64, nb = q % 64; d.W = A->in[I_WOUT] + (size_t)l * DM * DM; d.WT = (bf16*)(A->ws + WS_WOUT) + (size_t)l * DM * DM; d.K = DM; d.N = DM; d.k0 = 64 * kb; d.n0 = 32 * nb; d.drow0 = 32 * nb; d.sh = nullptr; d.shwp = nullptr; d.ntot = 0; }
    } else { const int m = r / 5632, q = r % 5632;
        if (m < 2) { const int kb = q / 176, nb = q % 176, n0 = 32 * nb; d.W = (m ? A->in[I_WU] : A->in[I_WG]) + (size_t)l * DM * DFF; d.WT = (bf16*)(A->ws + WS_WGU) + (size_t)l * 2 * DFF * DM; d.K = DM; d.N = DFF; d.k0 = 64 * kb; d.n0 = n0;
            d.drow0 = 256 * (n0 >> 7) + 128 * m + (n0 & 127); d.sh = sht; d.shwp = (float*)(A->ws + WS_SHPG) + ((size_t)l * 32 + kb) * 3 * 2 * DFF; d.ntot = 2 * DFF; }
        else { const int kb = q / 64, nb = q % 64; d.W = A->in[I_WD] + (size_t)l * DFF * DM; d.WT = (bf16*)(A->ws + WS_WDN) + (size_t)l * DM * DFF; d.K = DFF; d.N = DM; d.k0 = 64 * kb; d.n0 = 32 * nb; d.drow0 = 32 * nb; d.sh = nullptr; d.shwp = nullptr; d.ntot = 0; }
    }
    return d;
}
__device__ __forceinline__ void convert_layer(ArgsP A, const Ctx& C, int l, int set, int jw, int nw) {
    LAS float* scr = (LAS float*)(C.lds + C.wave * 8448);
    LAS float* sht = (LAS float*)(C.lds + 69632);
    const float* mod = (const float*)(A->ws + WS_MOD);
    __syncthreads();
    for (int i = C.tid; i < 3 * DM; i += 512) { const int c = i / DM, k = i % DM; sht[i] = mod[((size_t)l * 3 + c) * 12288 + (set ? 6144 : 0) + k]; }
    __syncthreads();
    const int nitems = set ? 3 * 5632 : 5632 + 2048;
    if (jw < nitems) {
        ConvItem c0 = conv_desc(A, l, set, jw, sht), c1, c2; float v0[32], v1[32], v2[32]; conv_load(c0, C.lane, v0);
        c1 = conv_desc(A, l, set, jw + nw < nitems ? jw + nw : 0, sht); conv_load(c1, C.lane, v1);
        int r = jw;
#define CONV_STEP(VA, CA, VC, CC) { CC = conv_desc(A, l, set, r + 2 * nw < nitems ? r + 2 * nw : 0, sht); conv_load(CC, C.lane, VC); conv_process(CA, C.lane, VA, scr); r += nw; if (r >= nitems) break; }
        for (;;) { CONV_STEP(v0, c0, v2, c2) CONV_STEP(v1, c1, v0, c0) CONV_STEP(v2, c2, v1, c1) }
#undef CONV_STEP
    }
    __syncthreads();
}
__device__ __forceinline__ void reduce_shw(ArgsP A, const Ctx& C, int l, int which, bool half_grid = true) {
    const int t0 = (int)blockIdx.x * (NWAVES * 64) + C.tid, nt = (half_grid ? C.G / 2 : C.G) * NWAVES * 64;
    if (which == 0) { const float* shpi = (const float*)(A->ws + WS_SHPI); float* shwi = (float*)(A->ws + WS_SHWI);
        for (int r = t0; r < 3 * DIN; r += nt) { float s = 0.f; for (int kb = 0; kb < 32; ++kb) s += shpi[((size_t)l * 32 + kb) * 3 * DIN + r]; shwi[(size_t)l * 3 * DIN + r] = s; } }
    else { const float* shpg = (const float*)(A->ws + WS_SHPG); float* shwg = (float*)(A->ws + WS_SHWG);
        for (int r = t0; r < 3 * 2 * DFF; r += nt) { float s = 0.f; for (int kb = 0; kb < 32; ++kb) s += shpg[((size_t)l * 32 + kb) * 3 * 2 * DFF + r]; shwg[(size_t)l * 3 * 2 * DFF + r] = s; } }
}
__device__ __forceinline__ void p0a(ArgsP A, const Ctx& C) {
    LAS float* st = (LAS float*)(C.lds + 98304);
    for (int i = C.tid; i < 3 * DM; i += 512) { const int c = i / DM, k = i % DM; const float x = (c == 0) ? A->in[I_CCTX][k] : A->in[I_C][(c - 1) * DM + k]; st[i] = x / (1.0f + expf(-x)); }
    __syncthreads();
    float* modp = (float*)(A->ws + WS_MODP);
    for (int it = C.gw; it < DEPTH * 32 * 48; it += C.ngw) {
        const int nb = it % 48, ks = (it / 48) % 32, l = it / (48 * 32), n = nb * 256 + C.lane * 4;
        const float* w = A->in[I_WMOD] + ((size_t)l * DM + ks * 64) * 12288 + n;
        f32x4 a0 = {0.f, 0.f, 0.f, 0.f}, a1 = a0, a2 = a0;
#pragma unroll 8
        for (int kk = 0; kk < 64; ++kk) { const f32x4 wv = __builtin_nontemporal_load((const f32x4*)(w + (size_t)kk * 12288)); const int k = ks * 64 + kk; a0 += st[k] * wv; a1 += st[DM + k] * wv; a2 += st[2 * DM + k] * wv; }
        float* o = modp + (((size_t)l * 32 + ks) * 3) * 12288 + n;
        *(f32x4*)o = a0; *(f32x4*)(o + 12288) = a1; *(f32x4*)(o + 2 * 12288) = a2;
    }
    lru_prep_wfrag(A, C);
    for (int i = C.gt; i < 2 * DB * DEPTH * 256 * 1024 / 8; i += C.ngt) {
        const int half = DB * DEPTH * 256 * 1024 / 8; const bool isk = i < half; const int j = isk ? i : i - half;
        const float* src = (isk ? A->in[I_CK] : A->in[I_CV]) + (size_t)j * 8; const f32x4 x0 = __builtin_nontemporal_load((const f32x4*)src), x1 = __builtin_nontemporal_load((const f32x4*)(src + 4));
        v4u o; o.x = pk2(x0.x, x0.y); o.y = pk2(x0.z, x0.w); o.z = pk2(x1.x, x1.y); o.w = pk2(x1.z, x1.w);
        *(v4u*)(A->ws + (isk ? WS_CKB : WS_CVB) + (size_t)j * 16) = o; }
}
__device__ __forceinline__ void p0b(ArgsP A, const Ctx& C) {
    const float* modp = (const float*)(A->ws + WS_MODP); float* mod = (float*)(A->ws + WS_MOD); float* gs = (float*)(A->ws + WS_GS);
    for (int i = C.gt; i < DEPTH * 3 * 12288; i += C.ngt) { const int n = i % 12288, c = (i / 12288) % 3, l = i / (3 * 12288);
        float s = A->in[I_BMOD][l * 12288 + n];
        for (int ks = 0; ks < 32; ++ks) s += modp[(((size_t)l * 32 + ks) * 3 + c) * 12288 + n];
        mod[i] = s;
        if (n >= 2048 && n < 4096) gs[(((size_t)l * 2 + 0) * 3 + c) * DM + (n - 2048)] = A->in[I_GMIX][l * DM + n - 2048] * (1.0f + s);
        if (n >= 8192 && n < 10240) gs[(((size_t)l * 2 + 1) * 3 + c) * DM + (n - 8192)] = A->in[I_GFFN][l * DM + n - 8192] * (1.0f + s); }
}
__device__ __forceinline__ void p0c(ArgsP A, const Ctx& C) {
    convert_layer(A, C, 0, 0, C.gw, C.ngw); convert_layer(A, C, 0, 1, C.gw, C.ngw);
    bf16* U = (bf16*)(A->ws + WS_U); float* hssq = (float*)(A->ws + WS_HSSQ); const float* gs0 = (const float*)(A->ws + WS_GS);
    for (int row = C.gw; row < MTOK; row += C.ngw) {
        const int cond = row < NCTX ? 0 : 1 + ((row - NCTX) >> 11);
        const float* hr = row < NCTX ? A->in[I_XP] + (size_t)row * DM : A->in[I_XS] + (size_t)(row - NCTX) * DM;
        const f32x4* xr = (const f32x4*)hr + C.lane; f32x4 v[8]; float s = 0.f;
#pragma unroll
        for (int j = 0; j < 8; ++j) { v[j] = __builtin_nontemporal_load(xr + 64 * j); s += (v[j].x * v[j].x + v[j].y * v[j].y) + (v[j].z * v[j].z + v[j].w * v[j].w); }
        s = wave_sum(s);
        if (C.lane < 32) hssq[(size_t)row * 32 + C.lane] = (C.lane == 0) ? s : 0.f;
#pragma unroll
        for (int j = 0; j < 8; ++j) { const int col = 4 * C.lane + 256 * j; const f32x4 y = v[j] * *(const f32x4*)(gs0 + (size_t)cond * DM + col);
            *(unsigned long long*)(U + (size_t)row * DM + col) = (unsigned long long)pk2(y.x, y.y) | ((unsigned long long)pk2(y.z, y.w) << 32); }
    }
}
__device__ __forceinline__ void p0d(ArgsP A, const Ctx& C) { reduce_shw(A, C, 0, 0, false); reduce_shw(A, C, 0, 1, false); }
__device__ __forceinline__ void mkctx(Ctx& C, LAS unsigned char* lds, const int wave) {
    int wv = wave; asm volatile("" : "+s"(wv));
    int t = wv * 64 + (int)__builtin_amdgcn_mbcnt_hi(~0u, __builtin_amdgcn_mbcnt_lo(~0u, 0u)); asm volatile("" : "+v"(t));
    C.lds = lds; C.tid = t; C.lane = t & 63; C.wave = wv;
    C.G = gridDim.x; C.gw = blockIdx.x * NWAVES + C.wave; C.ngw = C.G * NWAVES; C.gt = blockIdx.x * (NWAVES * 64) + t; C.ngt = C.G * NWAVES * 64;
}
__device__ __forceinline__ void m1_phase(ArgsP A, const Ctx& C, int l, float* outw) {
    const bf16* XIN = (const bf16*)(A->ws + WS_XIN); bf16* MIX = (bf16*)(A->ws + WS_MIX);
    const int half_g = C.G / 2, lt = ((int)blockIdx.x - half_g) * (NWAVES * 64) + C.tid, nlt = (C.G - half_g) * NWAVES * 64;
    if ((int)blockIdx.x >= half_g)
    for (int it = lt; it < (MTOK / 4) * 64; it += nlt) {
        const int ch = it & 63, row0 = (it >> 6) * 4, c0 = ch * 8; int t0, T; if (row0 < NCTX) { t0 = row0 & 255; T = SEQ; } else { t0 = (row0 - NCTX) & 2047; T = DSEQ; }
        v4u cg[6], sx[6], sb[4];
#pragma unroll
        for (int j = 0; j < 6; ++j) { const int tt = t0 + j - 1; cg[j] = (v4u){0u, 0u, 0u, 0u}; sx[j] = cg[j];
            if (tt >= 0 && tt < T) { const bf16* rp = XIN + (size_t)(row0 + j - 1) * DIN; cg[j] = *(const v4u*)(rp + C_SCG + c0); sx[j] = *(const v4u*)(rp + C_SX + c0); } }
#pragma unroll
        for (int j = 0; j < 4; ++j) sb[j] = *(const v4u*)(XIN + (size_t)(row0 + j) * DIN + C_SB + c0);
        float w[3][8];
#pragma unroll
        for (int dk = 0; dk < 3; ++dk)
#pragma unroll
            for (int i = 0; i < 8; ++i) w[dk][i] = A->in[I_SCW][(l * 3 + dk) * DSC + c0 + i];
        float z[6][8];
#pragma unroll
        for (int j = 0; j < 6; ++j) { z[j][0] = bflo(cg[j].x) * bflo(sx[j].x); z[j][1] = bfhi(cg[j].x) * bfhi(sx[j].x); z[j][2] = bflo(cg[j].y) * bflo(sx[j].y); z[j][3] = bfhi(cg[j].y) * bfhi(sx[j].y);
            z[j][4] = bflo(cg[j].z) * bflo(sx[j].z); z[j][5] = bfhi(cg[j].z) * bfhi(sx[j].z); z[j][6] = bflo(cg[j].w) * bflo(sx[j].w); z[j][7] = bfhi(cg[j].w) * bfhi(sx[j].w); }
#pragma unroll
        for (int j = 0; j < 4; ++j) { float acc[8];
#pragma unroll
            for (int i = 0; i < 8; ++i) acc[i] = w[0][i] * z[j][i] + w[1][i] * z[j + 1][i] + w[2][i] * z[j + 2][i];
            v4u o; o.x = pk2(bflo(sb[j].x) * acc[0], bfhi(sb[j].x) * acc[1]); o.y = pk2(bflo(sb[j].y) * acc[2], bfhi(sb[j].y) * acc[3]); o.z = pk2(bflo(sb[j].z) * acc[4], bfhi(sb[j].z) * acc[5]); o.w = pk2(bflo(sb[j].w) * acc[6], bfhi(sb[j].w) * acc[7]);
            *(v4u*)(MIX + (size_t)(row0 + j) * DM + 1536 + c0) = o; }
    }
    for (int u = blockIdx.x; u < 256; u += C.G) {
        if (u < 128) lru_unit<false>(A, C, l, NB + (u >> 6), (u >> 3) & 7, (u >> 1) & 3, u & 1, outw);
        else { const int v = u - 128; lru_unit<true>(A, C, l, v >> 3, 0, (v >> 1) & 3, v & 1, outw); }
    }
}
__device__ __forceinline__ void m2_phase(ArgsP A, LAS unsigned char* lds, const int wave0, int l, float* outw) {
    { Ctx C; mkctx(C, lds, wave0);
      for (int u = blockIdx.x; u < 256; u += C.G) { if (u < 128) attn_unit<true>(A, C, l, u, outw); else attn_unit<false>(A, C, l, u - 128, outw); } }
    { Ctx C; mkctx(C, lds, wave0);
      for (int u = (int)((blockIdx.x + (unsigned)C.G - (128u % (unsigned)C.G)) % (unsigned)C.G); u < 128; u += C.G) lru_unit<true>(A, C, l, NB + (u >> 6), (u >> 3) & 7, (u >> 1) & 3, u & 1, outw); }
}

#define PHASE_BEGIN() ArgsP A = (ArgsP)__builtin_amdgcn_kernarg_segment_ptr(); asm volatile("" : "+s"(A)); Ctx C; mkctx(C, (LAS unsigned char*)lds_raw, wave0); \
    float* mod = (float*)(A->ws + WS_MOD); bf16* U = (bf16*)(A->ws + WS_U); bf16* XIN = (bf16*)(A->ws + WS_XIN); bf16* ACT = (bf16*)(A->ws + WS_ACT); bf16* MIX = (bf16*)(A->ws + WS_MIX); \
    float* outw = A->out; (void)mod; (void)U; (void)XIN; (void)ACT; (void)MIX; (void)outw;
__global__ void __launch_bounds__(NWAVES * 64, 2) fwd(Args A_) {
    extern __shared__ __attribute__((aligned(16))) unsigned char lds_raw[];
    const int wave0 = __builtin_amdgcn_readfirstlane((int)threadIdx.x >> 6);
    { const int t0 = threadIdx.x; for (int u = t0; u < (LDS_BYTES - LDSCTL_OFF) / 4; u += NWAVES * 64) ((LAS unsigned*)((LAS unsigned char*)lds_raw + LDSCTL_OFF))[u] = 0u; }
    __syncthreads();
    volatile LAS unsigned* MISC = (volatile LAS unsigned*)((LAS unsigned char*)lds_raw + MISC_OFF);
    unsigned* barw = (unsigned*)(A_.ws + WS_CTL) + CW_BAR;
    XcdBarrier bar; bar.bar = barw; bar.x = 0; bar.st = nullptr;
    if (MK_MODE == 0) bar = xcd_barrier_post(barw, MISC + 8);
    const int lo = A_.ph_lo, hi = A_.ph_hi;
#define IN(k) (lo <= (k) && (k) < hi)
#define SEAM(k) do { if (IN(k) && IN((k) + 1)) xcd_barrier(bar); } while (0)
    if (IN(0)) { PHASE_BEGIN(); p0a(A, C); } SEAM(0);
    if (IN(1)) { PHASE_BEGIN(); p0b(A, C); } SEAM(1);
    if (IN(2)) { PHASE_BEGIN(); p0c(A, C); } SEAM(2);
    if (IN(3)) { PHASE_BEGIN(); p0d(A, C); } SEAM(3);
    for (int l = 0; l < DEPTH; ++l) {
        const int s0 = NPRO + l * STEPS_PER_LAYER;
        if (IN(s0 + 0)) { PHASE_BEGIN();
            pg8::Gemm g{U, (const bf16*)(A->ws + WS_WIN) + (size_t)l * DIN * DM, MTOK, DIN, DM}; pg8::StaticOrder S; S.init(MTOK, DIN, C.G, (int)blockIdx.x);
            const pg8::RstdTab rt = pg8::rstd_table(C.lds, S, (const float*)(A->ws + WS_HSSQ), C.tid);
            pg8::EpiIn E{XIN, (float*)(A->ws + WS_SSQ), outw + OUT_V + (size_t)l * SEQ * DATT, (const float*)(A->ws + WS_HSSQ), (const float*)(A->ws + WS_SHWI) + (size_t)l * 3 * DIN, rt};
            pg8::gemm_phase<pg8::EpiIn, pg8::StaticOrder, false, true>(C.lds + RING_OFF, g, S, E, wave0);
            { const int rem = (MTOK / 256 * (DIN / 256)) % C.G; if (l + 1 < DEPTH && rem && (int)blockIdx.x >= rem) convert_layer(A, C, l + 1, 0, ((int)blockIdx.x - rem) * NWAVES + C.wave, (C.G - rem) * NWAVES); }
        } SEAM(s0 + 0);
        if (IN(s0 + 1)) { PHASE_BEGIN(); if ((int)blockIdx.x < C.G / 2) { if (l + 1 < DEPTH) reduce_shw(A, C, l + 1, 0); if (l >= 1) reduce_shw(A, C, l, 1); } m1_phase(A, C, l, outw); m2_phase(A, (LAS unsigned char*)lds_raw, wave0, l, outw); } SEAM(s0 + 1);
        if (IN(s0 + 2)) { PHASE_BEGIN();
            pg8::Gemm g{MIX, (const bf16*)(A->ws + WS_WOUT) + (size_t)l * DM * DM, MTOK, DM, DM}; pg8::StaticOrder S; S.init(MTOK, DM, C.G, (int)blockIdx.x);
            bf16* HB = (bf16*)(A->ws + WS_HB);
            pg8::EpiRes E{A->in[I_XP], A->in[I_XS], (l == 0) ? (const bf16*)nullptr : (const bf16*)HB, nullptr, HB, mod + (size_t)l * 3 * 12288 + 4096, (const float*)(A->ws + WS_GS) + ((size_t)l * 2 + 1) * 3 * DM, U, (float*)(A->ws + WS_HSSQ)};
            pg8::gemm_phase<pg8::EpiRes, pg8::StaticOrder, true, true>(C.lds + RING_OFF, g, S, E, wave0);
        } SEAM(s0 + 2);
        if (IN(s0 + 3)) { PHASE_BEGIN();
            pg8::Gemm g{U, (const bf16*)(A->ws + WS_WGU) + (size_t)l * 2 * DFF * DM, MTOK, 2 * DFF, DM}; pg8::StaticOrder S; S.init(MTOK, 2 * DFF, C.G, (int)blockIdx.x);
            const pg8::RstdTab rt = pg8::rstd_table(C.lds, S, (const float*)(A->ws + WS_HSSQ), C.tid);
            pg8::EpiSwiGLU E{ACT, (const float*)(A->ws + WS_HSSQ), (const float*)(A->ws + WS_SHWG) + (size_t)l * 3 * 2 * DFF, rt};
            pg8::gemm_phase<pg8::EpiSwiGLU, pg8::StaticOrder, false, true>(C.lds + RING_OFF, g, S, E, wave0);
            { const int rem = (MTOK / 256 * (2 * DFF / 256)) % C.G; if (l + 1 < DEPTH && rem && (int)blockIdx.x >= rem) convert_layer(A, C, l + 1, 1, ((int)blockIdx.x - rem) * NWAVES + C.wave, (C.G - rem) * NWAVES); }
        } SEAM(s0 + 3);
        if (IN(s0 + 4)) { PHASE_BEGIN();
            pg8::Gemm g{ACT, (const bf16*)(A->ws + WS_WDN) + (size_t)l * DM * DFF, MTOK, DM, DFF}; pg8::StaticOrder S; S.init(MTOK, DM, C.G, (int)blockIdx.x);
            bf16* HB = (bf16*)(A->ws + WS_HB); const bool last = (l + 1 == DEPTH);
            pg8::EpiRes E{nullptr, nullptr, HB, outw, last ? (bf16*)nullptr : HB, mod + (size_t)l * 3 * 12288 + 10240, last ? (const float*)nullptr : (const float*)(A->ws + WS_GS) + ((size_t)(l + 1) * 2 + 0) * 3 * DM, U, (float*)(A->ws + WS_HSSQ)};
            pg8::gemm_phase<pg8::EpiRes, pg8::StaticOrder, true, true>(C.lds + RING_OFF, g, S, E, wave0);
        } SEAM(s0 + 4);
    }
#undef IN
#undef SEAM
}

extern "C" void kernel_launch(void* const* d_in, const int* in_sizes, int n_in, void* d_out, int out_size, void* d_ws, size_t ws_size, hipStream_t stream) {
    static int grid = 0;
    if (grid == 0) {
        if (n_in != 27 || (size_t)out_size != OUT_END || ws_size < WS_END3) { fprintf(stderr, "kernel_launch: shape mismatch: n_in %d out %d ws %zu (need 27, %zu, >= %zu)\n", n_in, out_size, ws_size, (size_t)OUT_END, (size_t)WS_END3); grid = -1; return; }
        int dev = 0, cus = 0, per_cu = 0;
        if (hipGetDevice(&dev) != hipSuccess || hipDeviceGetAttribute(&cus, hipDeviceAttributeMultiprocessorCount, dev) != hipSuccess) { fprintf(stderr, "kernel_launch: device query failed\n"); grid = -1; return; }
        if (hipFuncSetAttribute((const void*)fwd, hipFuncAttributeMaxDynamicSharedMemorySize, LDS_BYTES) != hipSuccess) { fprintf(stderr, "kernel_launch: hipFuncSetAttribute failed\n"); grid = -1; return; }
        if (hipOccupancyMaxActiveBlocksPerMultiprocessor(&per_cu, (const void*)fwd, NWAVES * 64, LDS_BYTES) != hipSuccess || per_cu < 1) fprintf(stderr, "kernel_launch: note: occupancy query reports %d workgroups per CU\n", per_cu);
        (void)hipGetLastError();
        grid = cus;
    }
    if (grid < 0) return;
    if (hipMemsetAsync((char*)d_ws + WS_CTL, 0, CTL_ZERO_BYTES, stream) != hipSuccess) { fprintf(stderr, "kernel_launch: memset failed\n"); return; }
    Args a{};
    for (int i = 0; i < 27; ++i) a.in[i] = (const float*)d_in[i];
    a.out = (float*)d_out; a.ws = (unsigned char*)d_ws;
#if MK_MODE == 0
    a.ph_lo = 0; a.ph_hi = NSTEPS;
    hipLaunchKernelGGL(fwd, dim3(grid), dim3(NWAVES * 64), LDS_BYTES, stream, a);
#else
    for (int s = 0; s < NSTEPS; ++s) { a.ph_lo = s; a.ph_hi = s + 1; hipLaunchKernelGGL(fwd, dim3(grid), dim3(NWAVES * 64), LDS_BYTES, stream, a); }
#endif
    const hipError_t le = hipPeekAtLastError();
    if (le != hipSuccess) fprintf(stderr, "kernel_launch: launch failed: %s\n", hipGetErrorName(le));
}
```

```cpp
#include <hip/hip_runtime.h>
#include <cstdio>
#include <cstdint>
namespace pg8 {
#define PG8_LAS __attribute__((address_space(3)))
typedef unsigned short bf16_t;
typedef short bf16x8 __attribute__((ext_vector_type(8)));
typedef float f32x4 __attribute__((ext_vector_type(4)));
typedef unsigned u32x4 __attribute__((ext_vector_type(4)));
constexpr int BM = 256, BK = 64, HALF = 128, HTB = HALF * BK * 2  , STAGE_BYTES = 8 * HTB, NXCD = 8, WGM = 8;

__host__ __device__ __forceinline__ int lds_byte(int r, int c) { const int st = (r >> 4) * 2 + (c >> 5), rr = r & 15, cc = c & 31, ob = rr * 64 + cc * 2; return st * 1024 + (ob ^ (((ob >> 9) & 1) << 5)); }
__host__ __device__ __forceinline__ void stage_rc(int b, int& R, int& C) { const int st = b / 1024, sb = b % 1024, swz = sb ^ (((sb >> 9) & 1) << 5); R = (st >> 1) * 16 + swz / 64; C = (st & 1) * 32 + (swz % 64) / 2; }
__host__ __device__ __forceinline__ int perm32(int rho) { const int n = rho >> 4, i = rho & 15; return 8 * (i >> 2) + 4 * n + (i & 3); }

struct Unit { int pm, pn; };
struct Gemm { const bf16_t* A; const bf16_t* Bt; int M, N, K; };

struct StaticOrder {
    int nM, nN, nwg, G, c;
    __host__ __device__ void init(int M, int N, int G_, int c_) { nM = M / BM; nN = N / BM; nwg = nM * nN; G = G_; c = c_; }
    __host__ __device__ bool next(int i, Unit& u) const {
        const long L = (long)i * G + c; if (L >= nwg) return false;
        int wgid = (int)L; { const int q = nwg / NXCD, r = nwg % NXCD, xcd = wgid % NXCD, off = wgid / NXCD; wgid = (xcd < r ? xcd * (q + 1) : r * (q + 1) + (xcd - r) * q) + off; }
        const int nig = WGM * nN, gid = wgid / nig, fm = gid * WGM, gsz = (nM - fm) < WGM ? (nM - fm) : WGM;
        u.pm = fm + ((wgid % nig) % gsz); u.pn = (wgid % nig) / gsz; return true;
    }
    __device__ __forceinline__ void a_ready(const Unit&) const {}
    __device__ __forceinline__ void done(const Unit&) const {}
};

__device__ __forceinline__ void st16(void* p, u32x4 v) { *(u32x4*)p = v; }
__device__ __forceinline__ unsigned cvt_pk_bf16(float lo, float hi) { unsigned r; asm volatile("v_cvt_pk_bf16_f32 %0, %1, %2" : "=v"(r) : "v"(lo), "v"(hi)); return r; }

__device__ __forceinline__ float xl16_sum(float s) { s += __builtin_bit_cast(float, __builtin_amdgcn_ds_swizzle(__builtin_bit_cast(int, s), 0x401f)); float a_ = s, b_ = s; asm volatile("s_nop 1\n\tv_permlane32_swap_b32 %0, %1\n\ts_nop 1" : "+v"(a_), "+v"(b_)); return a_ + b_; }
__device__ __forceinline__ void row_rstd(const float* hssq, int row0, int fq, float (&rs)[2][4]) {
#pragma unroll
    for (int ai = 0; ai < 2; ++ai) { f32x4 p[4][2];
#pragma unroll
        for (int m = 0; m < 4; ++m) { const float* hp = hssq + (size_t)(row0 + ai * HALF + m * 16) * 32 + fq * 8; p[m][0] = *(const f32x4*)hp; p[m][1] = *(const f32x4*)(hp + 4); }
#pragma unroll
        for (int m = 0; m < 4; ++m) { const f32x4 q = p[m][0] + p[m][1]; const float t = xl16_sum((q[0] + q[1]) + (q[2] + q[3])); rs[ai][m] = 1.0f / sqrtf(t * (1.0f / 2048.0f) + 1e-6f); } }
}
constexpr int RTAB_OFF = STAGE_BYTES, RTAB_ROWS = 3840;
struct RstdTab { const PG8_LAS float* tab; int row_lo; bool ok; };
template <class Sched>
__device__ __forceinline__ RstdTab rstd_table(PG8_LAS unsigned char* lds, const Sched& S, const float* hssq, int tid) {
    int lo = 1 << 30, hi = -1; Unit u; for (int i = 0; S.next(i, u); ++i) { lo = u.pm < lo ? u.pm : lo; hi = u.pm > hi ? u.pm : hi; }
    RstdTab T; T.tab = (const PG8_LAS float*)(lds + RTAB_OFF); T.row_lo = lo * BM; T.ok = (hi >= lo) && ((hi - lo + 1) * BM <= RTAB_ROWS);
    if (T.ok) { PG8_LAS float* tw = (PG8_LAS float*)(lds + RTAB_OFF); const int nrows = (hi - lo + 1) * BM;
        for (int r = tid; r < nrows; r += 512) { const f32x4* hp = (const f32x4*)(hssq + (size_t)(T.row_lo + r) * 32); f32x4 q = hp[0];
#pragma unroll
            for (int j = 1; j < 8; ++j) q += hp[j];
            tw[r] = 1.0f / sqrtf(((q[0] + q[1]) + (q[2] + q[3])) * (1.0f / 2048.0f) + 1e-6f); } }
    __syncthreads();
    return T;
}
__device__ __forceinline__ void get_rstd(const RstdTab& T, const float* hssq, int row0, int fq, float (&rs)[2][4]) {
    if (T.ok) {
#pragma unroll
        for (int ai = 0; ai < 2; ++ai)
#pragma unroll
            for (int m = 0; m < 4; ++m) rs[ai][m] = T.tab[row0 + ai * HALF + m * 16 - T.row_lo];
    } else row_rstd(hssq, row0, fq, rs);
}
struct EpiIn {
    static constexpr bool PERM = true, AFTER_DRAIN = false;
    bf16_t* O; float* ssq; float* vout; const float* hssq; const float* shw; RstdTab rt;
    __device__ __forceinline__ void operator()(const f32x4 (&acc)[2][2][4][2], const Unit& u, int wr, int wc, int fr, int fq) const {
        const int row0 = u.pm * BM + wr * 64 + fr, col0 = u.pn * BM + wc * 32 + 8 * fq;
        const int cond = u.pm < 16 ? 0 : (u.pm < 24 ? 1 : 2);
        float rs[2][4]; get_rstd(rt, hssq, row0, fq, rs);
        f32x4 bv[2][2];
#pragma unroll
        for (int bj = 0; bj < 2; ++bj)
#pragma unroll
            for (int n = 0; n < 2; ++n) bv[bj][n] = *(const f32x4*)(shw + (size_t)cond * 5632 + col0 + bj * HALF + 4 * n);
#pragma unroll
        for (int ai = 0; ai < 2; ++ai)
#pragma unroll
            for (int m = 0; m < 4; ++m) { const int row = row0 + ai * HALF + m * 16; bf16_t* rowp = O + (size_t)row * 5632 + col0;
#pragma unroll
                for (int bj = 0; bj < 2; ++bj) { const f32x4 v0 = acc[ai][bj][m][0] * rs[ai][m] + bv[bj][0], v1 = acc[ai][bj][m][1] * rs[ai][m] + bv[bj][1];
                    u32x4 w; w.x = cvt_pk_bf16(v0[0], v0[1]); w.y = cvt_pk_bf16(v0[2], v0[3]); w.z = cvt_pk_bf16(v1[0], v1[1]); w.w = cvt_pk_bf16(v1[2], v1[3]);
                    st16(rowp + bj * HALF, w);
                    if (u.pn < 8) {
                        float s = (v0[0] * v0[0] + v0[1] * v0[1]) + (v0[2] * v0[2] + v0[3] * v0[3]) + (v1[0] * v1[0] + v1[1] * v1[1]) + (v1[2] * v1[2] + v1[3] * v1[3]);
                        s = xl16_sum(s);
                        if (fq == 0) ssq[((size_t)row * 16 + (2 * u.pn + bj)) * 4 + wc] = s;
                    } else if (u.pn < 12 && u.pm < 16) {
                        const int b = row >> 8, t = row & 255, col = col0 + bj * HALF - 2048;
                        float* p = vout + ((size_t)b * 1024 + t) * 1024 + col;
                        __builtin_nontemporal_store(v0, (f32x4*)p); __builtin_nontemporal_store(v1, (f32x4*)(p + 4));
                    } } }
    }
};
struct EpiRes {
    static constexpr bool PERM = true, AFTER_DRAIN = false;
    const float* x_lo; const float* x_hi; const bf16_t* hb_in;
    float* y; bf16_t* hb_out;
    const float* gate;
    const float* gsn; bf16_t* un; float* hssq;
    __device__ __forceinline__ void operator()(const f32x4 (&acc)[2][2][4][2], const Unit& u, int wr, int wc, int fr, int fq) const {
        const int row0 = u.pm * BM + wr * 64 + fr, col0 = u.pn * BM + wc * 32 + 8 * fq;
        const int cond = u.pm < 16 ? 0 : (u.pm < 24 ? 1 : 2);
        f32x4 gv[2][2], gs[2][2];
#pragma unroll
        for (int bj = 0; bj < 2; ++bj)
#pragma unroll
            for (int n = 0; n < 2; ++n) { gv[bj][n] = *(const f32x4*)(gate + (size_t)cond * 12288 + col0 + bj * HALF + 4 * n);
                gs[bj][n] = gsn ? *(const f32x4*)(gsn + (size_t)cond * 2048 + col0 + bj * HALF + 4 * n) : (f32x4){0.f, 0.f, 0.f, 0.f}; }
#pragma unroll
        for (int ai = 0; ai < 2; ++ai)
#pragma unroll
            for (int m = 0; m < 4; ++m) { const int row = row0 + ai * HALF + m * 16; const size_t off = (size_t)row * 2048 + col0;
                float s = 0.f;
#pragma unroll
                for (int bj = 0; bj < 2; ++bj) { f32x4 b0, b1;
                    if (hb_in) { const u32x4 w = *(const u32x4*)(hb_in + off + bj * HALF);
                        b0 = (f32x4){__builtin_bit_cast(float, w.x << 16), __builtin_bit_cast(float, w.x & 0xffff0000u), __builtin_bit_cast(float, w.y << 16), __builtin_bit_cast(float, w.y & 0xffff0000u)};
                        b1 = (f32x4){__builtin_bit_cast(float, w.z << 16), __builtin_bit_cast(float, w.z & 0xffff0000u), __builtin_bit_cast(float, w.w << 16), __builtin_bit_cast(float, w.w & 0xffff0000u)}; }
                    else { const float* bp = (u.pm < 16) ? x_lo + off : x_hi + (off - (size_t)4096 * 2048); b0 = *(const f32x4*)(bp + bj * HALF); b1 = *(const f32x4*)(bp + bj * HALF + 4); }
                    const f32x4 o0 = b0 + gv[bj][0] * acc[ai][bj][m][0], o1 = b1 + gv[bj][1] * acc[ai][bj][m][1];
                    if (hb_out) { u32x4 w; w.x = cvt_pk_bf16(o0[0], o0[1]); w.y = cvt_pk_bf16(o0[2], o0[3]); w.z = cvt_pk_bf16(o1[0], o1[1]); w.w = cvt_pk_bf16(o1[2], o1[3]); st16(hb_out + off + bj * HALF, w); }
                    else { __builtin_nontemporal_store(o0, (f32x4*)(y + off + bj * HALF)); __builtin_nontemporal_store(o1, (f32x4*)(y + off + bj * HALF + 4)); }
                    if (gsn) { s += ((o0[0] * o0[0] + o0[1] * o0[1]) + (o0[2] * o0[2] + o0[3] * o0[3])) + ((o1[0] * o1[0] + o1[1] * o1[1]) + (o1[2] * o1[2] + o1[3] * o1[3]));
                        const f32x4 a0 = o0 * gs[bj][0], a1 = o1 * gs[bj][1];
                        u32x4 w; w.x = cvt_pk_bf16(a0[0], a0[1]); w.y = cvt_pk_bf16(a0[2], a0[3]); w.z = cvt_pk_bf16(a1[0], a1[1]); w.w = cvt_pk_bf16(a1[2], a1[3]); st16(un + off + bj * HALF, w); } }
                if (gsn) { s = xl16_sum(s); if (fq == 0) hssq[(size_t)row * 32 + u.pn * 4 + wc] = s; } }
    }
};
__device__ __forceinline__ float silu_f(float g) { return g * __builtin_amdgcn_rcpf(1.0f + __builtin_amdgcn_exp2f(-1.4426950408889634f * g)); }
struct EpiSwiGLU {
    static constexpr bool PERM = true, AFTER_DRAIN = false;
    bf16_t* O; const float* hssq; const float* shw; RstdTab rt;
    __device__ __forceinline__ void operator()(const f32x4 (&acc)[2][2][4][2], const Unit& u, int wr, int wc, int fr, int fq) const {
        const int row0 = u.pm * BM + wr * 64 + fr, col0 = u.pn * HALF + wc * 32 + 8 * fq, bcol0 = u.pn * BM + wc * 32 + 8 * fq;
        const int cond = u.pm < 16 ? 0 : (u.pm < 24 ? 1 : 2);
        float rs[2][4]; get_rstd(rt, hssq, row0, fq, rs);
        f32x4 bv[2][2];
#pragma unroll
        for (int bj = 0; bj < 2; ++bj)
#pragma unroll
            for (int n = 0; n < 2; ++n) bv[bj][n] = *(const f32x4*)(shw + (size_t)cond * 11264 + bcol0 + bj * HALF + 4 * n);
#pragma unroll
        for (int ai = 0; ai < 2; ++ai)
#pragma unroll
            for (int m = 0; m < 4; ++m) { const float r = rs[ai][m];
                const f32x4 g0 = acc[ai][0][m][0] * r + bv[0][0], g1 = acc[ai][0][m][1] * r + bv[0][1], u0 = acc[ai][1][m][0] * r + bv[1][0], u1 = acc[ai][1][m][1] * r + bv[1][1];
                u32x4 w; w.x = cvt_pk_bf16(silu_f(g0[0]) * u0[0], silu_f(g0[1]) * u0[1]); w.y = cvt_pk_bf16(silu_f(g0[2]) * u0[2], silu_f(g0[3]) * u0[3]);
                w.z = cvt_pk_bf16(silu_f(g1[0]) * u1[0], silu_f(g1[1]) * u1[1]); w.w = cvt_pk_bf16(silu_f(g1[2]) * u1[2], silu_f(g1[3]) * u1[3]);
                st16(O + (size_t)(row0 + ai * HALF + m * 16) * 5632 + col0, w); }
    }
};

template <class Epi, class Sched, bool ALIGN_EPI = false, bool SP2 = false>
__device__ __forceinline__ void gemm_phase(PG8_LAS unsigned char* lds, const Gemm g, const Sched& S, const Epi& E, const int wave_id  ) {
    int wv_ = wave_id; asm volatile("" : "+s"(wv_));
    int tid_ = wv_ * 64 + (int)__builtin_amdgcn_mbcnt_hi(~0u, __builtin_amdgcn_mbcnt_lo(~0u, 0u)); asm volatile("" : "+v"(tid_));
    const int tid = tid_, wid = wv_, lane = tid & 63, wr = wid >> 2, wc = wid & 3, fr = lane & 15, fq = lane >> 4;
    const int K = g.K, nt = K / BK;
    unsigned voffA[2], voffB[2];
#pragma unroll
    for (int i = 0; i < 2; ++i) { int R, C; stage_rc(tid * 16 + i * 8192, R, C); const int Rb = Epi::PERM ? ((R & ~31) + perm32(R & 31)) : R;
        voffA[i] = (unsigned)(R * K + C) * 2u; voffB[i] = (unsigned)(Rb * K + C) * 2u; }
    const size_t kstep = (size_t)(BK * 2);
    const size_t hstep = (size_t)HALF * K * 2;
    const size_t tstep = 2 * hstep;
    const unsigned ldsw = (unsigned)wid * 1024u;
    const int aoff = lds_byte(wr * 64 + fr, fq * 8), boff = lds_byte(wc * 32 + fr, fq * 8);
#define PG8_SA(b, h) (((b) * 2 + (h)) * HTB)
#define PG8_SB(b, h) ((4 + (b) * 2 + (h)) * HTB)
#define PG8_STAGE(bufoff, gbase, voff) do { _Pragma("unroll") for (int _i = 0; _i < 2; ++_i) \
        __builtin_amdgcn_global_load_lds((const unsigned*)((const char*)(gbase) + (voff)[_i]), (PG8_LAS unsigned*)(lds + (bufoff) + ldsw + _i * 8192), 16, 0, 0); } while (0)
#define PG8_LDA(dst, b, h) do { _Pragma("unroll") for (int m = 0; m < 4; ++m) _Pragma("unroll") for (int k = 0; k < 2; ++k) dst[m][k] = *(const PG8_LAS bf16x8*)(lds + PG8_SA(b, h) + aoff + m * 2048 + k * 1024); } while (0)
#define PG8_LDB(dst, b, h) do { _Pragma("unroll") for (int n = 0; n < 2; ++n) _Pragma("unroll") for (int k = 0; k < 2; ++k) dst[n][k] = *(const PG8_LAS bf16x8*)(lds + PG8_SB(b, h) + boff + n * 2048 + k * 1024); } while (0)
#define PG8_MMA(ai, bj, At, Bt) do { __builtin_amdgcn_s_setprio(1); _Pragma("unroll") for (int m = 0; m < 4; ++m) _Pragma("unroll") for (int n = 0; n < 2; ++n) _Pragma("unroll") for (int k = 0; k < 2; ++k) \
        acc[ai][bj][m][n] = __builtin_amdgcn_mfma_f32_16x16x32_bf16(Bt[n][k], At[m][k], acc[ai][bj][m][n], 0, 0, 0); __builtin_amdgcn_s_setprio(0); } while (0)
#define PG8_WAIT_V(n) asm volatile("s_waitcnt vmcnt(" #n ")" ::: "memory")
#define PG8_WAIT_L(n) asm volatile("s_waitcnt lgkmcnt(" #n ")" ::: "memory")
#define PG8_BAR __builtin_amdgcn_s_barrier()
#define PG8_SCHED __builtin_amdgcn_sched_barrier(0)
    Unit cur, nxt; int ui = 0;
    if (!S.next(0, cur)) return;
    f32x4 acc[2][2][4][2];
#pragma unroll
    for (int a = 0; a < 2; ++a)
#pragma unroll
        for (int b = 0; b < 2; ++b)
#pragma unroll
            for (int m = 0; m < 4; ++m)
#pragma unroll
                for (int n = 0; n < 2; ++n) acc[a][b][m][n] = (f32x4){0.f, 0.f, 0.f, 0.f};
    bf16x8 At[4][2], B0[2][2], B1[2][2];
    const char* cA = (const char*)g.A + (size_t)cur.pm * tstep; const char* cB = (const char*)g.Bt + (size_t)cur.pn * tstep;
    S.a_ready(cur);
    if constexpr (SP2) {
        PG8_STAGE(PG8_SB(0, 0), cB, voffB); PG8_STAGE(PG8_SB(0, 1), cB + hstep, voffB); PG8_STAGE(PG8_SA(0, 0), cA, voffA); PG8_STAGE(PG8_SA(0, 1), cA + hstep, voffA);
        if (wr == 1) PG8_BAR;
        PG8_WAIT_V(2); PG8_BAR;
        PG8_STAGE(PG8_SB(1, 0), cB + kstep, voffB); PG8_STAGE(PG8_SA(1, 0), cA + kstep, voffA); PG8_STAGE(PG8_SB(1, 1), cB + hstep + kstep, voffB);
        PG8_WAIT_V(6); PG8_BAR;
    } else {
        PG8_STAGE(PG8_SB(0, 0), cB, voffB); PG8_STAGE(PG8_SA(0, 0), cA, voffA); PG8_STAGE(PG8_SB(0, 1), cB + hstep, voffB); PG8_STAGE(PG8_SA(0, 1), cA + hstep, voffA);
        if (wr == 1) PG8_BAR;
        PG8_WAIT_V(4); PG8_BAR;
        PG8_STAGE(PG8_SB(1, 0), cB + kstep, voffB); PG8_STAGE(PG8_SA(1, 0), cA + kstep, voffA); PG8_STAGE(PG8_SB(1, 1), cB + hstep + kstep, voffB);
        PG8_WAIT_V(6); PG8_BAR;
    }
    for (;;) {
        const bool has_next = S.next(ui + 1, nxt);
        const char* nA = has_next ? (const char*)g.A + (size_t)nxt.pm * tstep : cA; const char* nB = has_next ? (const char*)g.Bt + (size_t)nxt.pn * tstep : cB;
        for (int t = 0; t < nt; t += 2) {
            const bool last = (t == nt - 2);
            const char* a1 = cA + (size_t)(t + 1) * kstep;
            const char* a2 = last ? nA : cA + (size_t)(t + 2) * kstep; const char* b2 = last ? nB : cB + (size_t)(t + 2) * kstep;
            const char* a3 = a2 + kstep; const char* b3 = b2 + kstep;
            if (last && has_next) S.a_ready(nxt);
            if constexpr (SP2) {
            PG8_LDB(B0, 0, 0); PG8_LDB(B1, 0, 1); PG8_SCHED; PG8_LDA(At, 0, 0); PG8_STAGE(PG8_SA(1, 1), a1 + hstep, voffA);
            PG8_WAIT_V(8); PG8_WAIT_L(0); PG8_BAR; PG8_MMA(0, 0, At, B0); PG8_MMA(0, 1, At, B1); PG8_BAR; PG8_SCHED;
            PG8_LDA(At, 0, 1); PG8_STAGE(PG8_SB(0, 0), b2, voffB); PG8_STAGE(PG8_SB(0, 1), b2 + hstep, voffB); PG8_STAGE(PG8_SA(0, 0), a2, voffA);
            PG8_WAIT_V(8); PG8_WAIT_L(0); PG8_BAR; PG8_MMA(1, 0, At, B0); PG8_MMA(1, 1, At, B1); PG8_BAR; PG8_SCHED;
            PG8_LDB(B0, 1, 0); PG8_LDB(B1, 1, 1); PG8_SCHED; PG8_LDA(At, 1, 0); PG8_STAGE(PG8_SA(0, 1), a2 + hstep, voffA);
            PG8_WAIT_V(8); PG8_WAIT_L(0); PG8_BAR; PG8_MMA(0, 0, At, B0); PG8_MMA(0, 1, At, B1); PG8_BAR; PG8_SCHED;
            PG8_LDA(At, 1, 1); PG8_STAGE(PG8_SB(1, 0), b3, voffB); PG8_STAGE(PG8_SB(1, 1), b3 + hstep, voffB); PG8_STAGE(PG8_SA(1, 0), a3, voffA);
            PG8_WAIT_V(8); PG8_WAIT_L(0); PG8_BAR; PG8_MMA(1, 0, At, B0); PG8_MMA(1, 1, At, B1); PG8_BAR; PG8_SCHED;
            } else {
            PG8_LDB(B0, 0, 0); PG8_SCHED; PG8_LDA(At, 0, 0); PG8_STAGE(PG8_SA(1, 1), a1 + hstep, voffA);
            PG8_WAIT_L(8); PG8_BAR; PG8_WAIT_L(0); PG8_MMA(0, 0, At, B0); PG8_BAR; PG8_SCHED;
            PG8_LDB(B1, 0, 1); PG8_STAGE(PG8_SB(0, 0), b2, voffB);
            PG8_BAR; PG8_WAIT_L(0); PG8_MMA(0, 1, At, B1); PG8_BAR;
            PG8_LDA(At, 0, 1); PG8_STAGE(PG8_SA(0, 0), a2, voffA);
            PG8_BAR; PG8_WAIT_L(0); PG8_MMA(1, 0, At, B0); PG8_BAR; PG8_SCHED;
            PG8_STAGE(PG8_SB(0, 1), b2 + hstep, voffB);
            PG8_WAIT_V(6); PG8_BAR; PG8_MMA(1, 1, At, B1); PG8_BAR;
            PG8_LDB(B0, 1, 0); PG8_SCHED; PG8_LDA(At, 1, 0); PG8_STAGE(PG8_SA(0, 1), a2 + hstep, voffA);
            PG8_WAIT_L(8); PG8_BAR; PG8_WAIT_L(0); PG8_MMA(0, 0, At, B0); PG8_BAR; PG8_SCHED;
            PG8_LDB(B1, 1, 1); PG8_STAGE(PG8_SB(1, 0), b3, voffB);
            PG8_BAR; PG8_WAIT_L(0); PG8_MMA(0, 1, At, B1); PG8_BAR;
            PG8_LDA(At, 1, 1); PG8_STAGE(PG8_SA(1, 0), a3, voffA);
            PG8_BAR; PG8_WAIT_L(0); PG8_MMA(1, 0, At, B0); PG8_BAR; PG8_SCHED;
            PG8_STAGE(PG8_SB(1, 1), b3 + hstep, voffB);
            PG8_WAIT_V(6); PG8_BAR; PG8_MMA(1, 1, At, B1); PG8_BAR;
            }
        }
        if constexpr (ALIGN_EPI) { if (wr == 0) PG8_BAR; }
        if constexpr (!Epi::AFTER_DRAIN) { E(acc, cur, wr, wc, fr, fq); S.done(cur); }
        if (!has_next) break;
#pragma unroll
        for (int a = 0; a < 2; ++a)
#pragma unroll
            for (int b = 0; b < 2; ++b)
#pragma unroll
                for (int m = 0; m < 4; ++m)
#pragma unroll
                    for (int n = 0; n < 2; ++n) acc[a][b][m][n] = (f32x4){0.f, 0.f, 0.f, 0.f};
        cur = nxt; cA = nA; cB = nB; ++ui;
        if constexpr (ALIGN_EPI) { if (wr == 1) PG8_BAR; }
    }
    PG8_WAIT_V(0);
    if constexpr (!ALIGN_EPI) { if (wr == 0) PG8_BAR; }
    PG8_BAR;
    if constexpr (Epi::AFTER_DRAIN) { E.fused(acc, cur, wr, wc, fr, fq, lds, wid, lane); S.done(cur); }
#undef PG8_SA
#undef PG8_SB
#undef PG8_STAGE
#undef PG8_LDA
#undef PG8_LDB
#undef PG8_MMA
#undef PG8_WAIT_V
#undef PG8_WAIT_L
#undef PG8_BAR
#undef PG8_SCHED
}
}

constexpr int DM = 2048, NCTX = 4096, NLAT = 4096, MTOK = 8192, DEPTH = 4, SEQ = 256, DSEQ = 2048, NB = 16, DB = 2;
constexpr int DIN = 5632, DFF = 5632, DATT = 1024, DLRU = 512, DSC = 512, NH = 8, HD = 128, GW = 64;
constexpr int C_Q = 0, C_K = 1024, C_V = 2048, C_LX = 3072, C_LY = 3584, C_SB = 4096, C_SCG = 4608, C_SX = 5120;
constexpr float EPS = 1e-6f;
constexpr int NWAVES = 8;
#ifndef MK_MODE
#define MK_MODE 0
#endif
constexpr int STEPS_PER_LAYER = 5, NPRO = 4, NSTEPS = NPRO + DEPTH * STEPS_PER_LAYER;

constexpr size_t OUT_Y = 0, OUT_K = (size_t)MTOK * DM, OUT_V = OUT_K + (size_t)NB * DEPTH * SEQ * DATT, OUT_S = OUT_V + (size_t)NB * DEPTH * SEQ * DATT, OUT_END = OUT_S + (size_t)NB * DEPTH * 2 * DLRU;

constexpr size_t MiB = 1u << 20;
constexpr size_t WS_CTL = 0, CTL_ZERO_BYTES = 1 * MiB;
constexpr size_t WS_MOD  = 1 * MiB;
constexpr size_t WS_MODP = 2 * MiB;
constexpr size_t WS_WIN  = 24 * MiB;
constexpr size_t WS_WOUT = WS_WIN + (size_t)DEPTH * DIN * DM * 2;
constexpr size_t WS_WGU  = WS_WOUT + (size_t)DEPTH * DM * DM * 2;
constexpr size_t WS_WDN  = WS_WGU + (size_t)DEPTH * 2 * DFF * DM * 2;
constexpr size_t WS_U    = WS_WDN + (size_t)DEPTH * DM * DFF * 2;
constexpr size_t WS_XIN  = WS_U + (size_t)MTOK * DM * 2;
constexpr size_t WS_ACT  = WS_XIN;
constexpr size_t WS_MIX  = WS_XIN + (size_t)MTOK * DIN * 2;
constexpr size_t WS_SSQ  = WS_MIX + (size_t)MTOK * DM * 2;
constexpr size_t WS_END  = WS_SSQ + (size_t)MTOK * 64 * 4;
constexpr int CW_BAR = 4096;

constexpr int RING_OFF = 0, RING_BYTES = 131072, LDS_BYTES = 147456, LDSCTL_OFF = LDS_BYTES - 512  , MISC_OFF = LDSCTL_OFF + 320;

#define GAS __attribute__((address_space(1)))
#define LAS __attribute__((address_space(3)))
typedef unsigned short bf16;
typedef unsigned v4u __attribute__((ext_vector_type(4)));
typedef float f32x4 __attribute__((ext_vector_type(4)));
typedef GAS unsigned gu32;
#define RLX_AGENT __ATOMIC_RELAXED, __HIP_MEMORY_SCOPE_AGENT
#define LDS_WAIT() asm volatile("s_waitcnt lgkmcnt(0)" ::: "memory")
#define VM_WAIT() asm volatile("s_waitcnt vmcnt(0)" ::: "memory")
__device__ __forceinline__ unsigned f2bf(float f) { unsigned u = __builtin_bit_cast(unsigned, f); return (u + 0x7fffu + ((u >> 16) & 1u)) >> 16; }
__device__ __forceinline__ unsigned pk2(float lo, float hi) { return f2bf(lo) | (f2bf(hi) << 16); }
__device__ __forceinline__ float bflo(unsigned w) { return __builtin_bit_cast(float, w << 16); }
__device__ __forceinline__ float bfhi(unsigned w) { return __builtin_bit_cast(float, w & 0xffff0000u); }
__device__ __forceinline__ float bf2f(bf16 b) { return __builtin_bit_cast(float, ((unsigned)b) << 16); }

#define XB_TMO      128
#define XB_XCNT(j)  (256  + 64 * (j))
#define XB_XSUB(j)  (1280 + 64 * (j))
#define XB_XGEN(j)  (2304 + 64 * (j))
#define XB_TOP      3328
#define XB_TOPGEN   3392
#define XCD_BAR_WORDS 3456
#define XB_SPIN_CAP (1u << 18)

__device__ __forceinline__ unsigned xb_ld(unsigned* p)              { return __hip_atomic_load(p, __ATOMIC_RELAXED, __HIP_MEMORY_SCOPE_AGENT); }
__device__ __forceinline__ unsigned xb_add(unsigned* p, unsigned v) { return __hip_atomic_fetch_add(p, v, __ATOMIC_RELAXED, __HIP_MEMORY_SCOPE_AGENT); }
__device__ __forceinline__ unsigned xb_xcc_id() { return (unsigned)__builtin_amdgcn_s_getreg((3 << 11) | 20) & 0xFu; }
#define XB_SPIN(cond, bar) do { unsigned _sp = 0; while (cond) { __builtin_amdgcn_s_sleep(1); \
    if ((++_sp & 255u) == 0u) { if (xb_ld(&(bar)[XB_TMO])) break; if (_sp > XB_SPIN_CAP) { atomicAdd(&(bar)[XB_TMO], 1u); break; } } } } while (0)

struct XcdBarrier {
    unsigned* bar; unsigned x;
    volatile LAS unsigned* st;
};

__device__ __forceinline__ XcdBarrier xcd_barrier_post(unsigned* bar, volatile LAS unsigned* st) {
    XcdBarrier b; b.bar = bar; b.x = xb_xcc_id(); b.st = st;
    if (threadIdx.x == 0) (void)xb_add(&bar[XB_XCNT(b.x)], 1u);
    return b;
}
__device__ __forceinline__ void xcd_barrier_complete(unsigned* bar, unsigned x, unsigned& nloc, unsigned& nx) {
    const unsigned G = gridDim.x * gridDim.y * gridDim.z;
    unsigned sum, cnt, mine, sp = 0u;
    for (;;) {
        sum = 0u; cnt = 0u; mine = 0u;
#pragma unroll
        for (unsigned j = 0; j < 16; ++j) { const unsigned c = xb_ld(&bar[XB_XCNT(j)]); sum += c; cnt += (c > 0u) ? 1u : 0u; mine = (j == x) ? c : mine; }
        if (sum == G) break;
        __builtin_amdgcn_s_sleep(1);
        if ((++sp & 255u) == 0u) { if (xb_ld(&bar[XB_TMO])) break; if (sp > XB_SPIN_CAP) { atomicAdd(&bar[XB_TMO], 1u); break; } }
    }
    nloc = mine > 0u ? mine : 1u; nx = cnt > 0u ? cnt : 1u;
}

__device__ __forceinline__ void xcd_barrier(const XcdBarrier& b) {
    asm volatile("s_waitcnt vmcnt(0)" ::: "memory");
    __syncthreads();
    if (threadIdx.x == 0) {
        unsigned* bar = b.bar;
        __builtin_amdgcn_s_waitcnt(0);
        unsigned nloc = b.st[0], nx = b.st[1];
        if (nloc == 0u) { xcd_barrier_complete(bar, b.x, nloc, nx); b.st[0] = nloc; b.st[1] = nx; }
        const unsigned old = xb_add(&bar[XB_XSUB(b.x)], 1u);
        const unsigned gen = old / nloc;
        if (old + 1u == (gen + 1u) * nloc) {
            __builtin_amdgcn_fence(__ATOMIC_RELEASE, "agent");
            asm volatile("s_waitcnt vmcnt(0)" ::: "memory");
            const unsigned og = xb_add(&bar[XB_TOP], 1u);
            const unsigned tg = og / nx;
            if (og + 1u == (tg + 1u) * nx) xb_add(&bar[XB_TOPGEN], 1u);
            else XB_SPIN(xb_ld(&bar[XB_TOPGEN]) == tg, bar);
            __builtin_amdgcn_fence(__ATOMIC_ACQUIRE, "agent");
            xb_add(&bar[XB_XGEN(b.x)], 1u);
            asm volatile("s_waitcnt vmcnt(0)" ::: "memory");
        } else {
            XB_SPIN(xb_ld(&bar[XB_XGEN(b.x)]) == gen, bar);
            __builtin_amdgcn_fence(__ATOMIC_ACQUIRE, "agent");
            asm volatile("s_waitcnt vmcnt(0)" ::: "memory");
        }
    }
    __syncthreads();
}

struct Args { const float* in[27]; float* out; unsigned char* ws; int ph_lo, ph_hi; };
typedef const __attribute__((address_space(4))) Args* ArgsP;
struct Ctx { LAS unsigned char* lds; int tid, lane, wave, G, gw, ngw, gt, ngt; };
enum { I_XP = 0, I_XS, I_CK, I_CV, I_ST, I_C, I_CCTX, I_WMOD, I_BMOD, I_GMIX, I_GFFN, I_WIN, I_QG, I_KG, I_NAB, I_LCW, I_LCB, I_LWA, I_LBA, I_LWI, I_LBI, I_LAM, I_SCW, I_WOUT, I_WG, I_WU, I_WD };

template <int XM> __device__ __forceinline__ float swz_xor(float v) { return __builtin_bit_cast(float, __builtin_amdgcn_ds_swizzle(__builtin_bit_cast(int, v), 0x1f | (XM << 10))); }
__device__ __forceinline__ void swap32(float v, float& own, float& other) { own = v; other = v; asm volatile("s_nop 1\n\tv_permlane32_swap_b32 %0, %1\n\ts_nop 1" : "+v"(own), "+v"(other)); }
__device__ __forceinline__ float xor32_sum(float v) { float a, b; swap32(v, a, b); return a + b; }
__device__ __forceinline__ float xor32_max(float v) { float a, b; swap32(v, a, b); return fmaxf(a, b); }
__device__ __forceinline__ float wave_sum(float v) { v += swz_xor<1>(v); v += swz_xor<2>(v); v += swz_xor<4>(v); v += swz_xor<8>(v); v += swz_xor<16>(v); return xor32_sum(v); }
__device__ __forceinline__ float bperm(float v, int byte_idx) { return __builtin_bit_cast(float, __builtin_amdgcn_ds_bpermute(byte_idx, __builtin_bit_cast(int, v))); }

struct ConvItem { const float* W; bf16* WT; const LAS float* sh; float* shwp; int K, N, k0, n0, drow0, ntot; };
__device__ __forceinline__ void conv_load(const ConvItem& d, int lane, float (&v)[32]) {
    const float* wp = d.W + (size_t)(d.k0 + (lane >> 3)) * d.N + d.n0 + 4 * (lane & 7);
#pragma unroll
    for (int i = 0; i < 8; ++i) { const f32x4 t = __builtin_nontemporal_load((const f32x4*)(wp + (size_t)(8 * i) * d.N)); v[4 * i] = t.x; v[4 * i + 1] = t.y; v[4 * i + 2] = t.z; v[4 * i + 3] = t.w; }
}
__device__ __forceinline__ void conv_process(const ConvItem& d, int lane, const float (&v)[32], LAS float* scr) {
#pragma unroll
    for (int i = 0; i < 8; ++i)
#pragma unroll
        for (int j = 0; j < 4; ++j) scr[((lane >> 3) + 8 * i) * 33 + 4 * (lane & 7) + j] = v[4 * i + j];
    LDS_WAIT(); asm volatile("" ::: "memory");
    const int c = lane & 7;
#pragma unroll
    for (int j = 0; j < 4; ++j) { const int n = (lane >> 3) + 8 * j; const LAS float* s = scr + (8 * c) * 33 + n;
        v4u o; o.x = pk2(s[0 * 33], s[1 * 33]); o.y = pk2(s[2 * 33], s[3 * 33]); o.z = pk2(s[4 * 33], s[5 * 33]); o.w = pk2(s[6 * 33], s[7 * 33]);
        __builtin_nontemporal_store(o, (v4u*)(d.WT + (size_t)(d.drow0 + n) * d.K + d.k0 + 8 * c)); }
    if (d.sh) {
        const int n = lane & 31, hf = lane >> 5; float a0 = 0.f, a1 = 0.f, a2 = 0.f;
#pragma unroll
        for (int q = 0; q < 8; ++q) { const int kk = hf * 32 + q * 4; const LAS float* sp = d.sh + d.k0 + kk;
            const f32x4 s0 = *(const LAS f32x4*)sp, s1 = *(const LAS f32x4*)(sp + 2048), s2 = *(const LAS f32x4*)(sp + 4096);
#pragma unroll
            for (int j = 0; j < 4; ++j) { const float w = scr[(kk + j) * 33 + n]; a0 += s0[j] * w; a1 += s1[j] * w; a2 += s2[j] * w; } }
        a0 = xor32_sum(a0); a1 = xor32_sum(a1); a2 = xor32_sum(a2);
        if (lane < 32) { d.shwp[d.drow0 + n] = a0; d.shwp[(size_t)d.ntot + d.drow0 + n] = a1; d.shwp[2 * (size_t)d.ntot + d.drow0 + n] = a2; }
    }
    LDS_WAIT(); asm volatile("" ::: "memory");
}
typedef short bf16x8_t __attribute__((ext_vector_type(8)));
constexpr int XC_STRIDE = 272;
__device__ __forceinline__ int xaddr(int row, int colb) { return row * XC_STRIDE + (colb ^ (((row >> 4) & 3) << 6)); }
constexpr size_t WS_WFRAG = WS_END;
constexpr size_t WS_CKB   = WS_WFRAG + (size_t)DEPTH * 2 * 4 * 2 * 8 * 4 * 64 * 16;
constexpr size_t WS_CVB   = WS_CKB + (size_t)DB * DEPTH * 256 * 1024 * 2;
constexpr size_t WS_END2  = WS_CVB + (size_t)DB * DEPTH * 256 * 1024 * 2;
constexpr size_t WS_HSSQ  = WS_END2;
constexpr size_t WS_GS    = WS_HSSQ + (size_t)MTOK * 32 * 4;
constexpr size_t WS_SHWI  = WS_GS + (size_t)DEPTH * 2 * 3 * DM * 4;
constexpr size_t WS_SHWG  = WS_SHWI + (size_t)DEPTH * 3 * DIN * 4;
constexpr size_t WS_SHPI  = WS_SHWG + (size_t)DEPTH * 3 * 2 * DFF * 4;
constexpr size_t WS_SHPG  = WS_SHPI + (size_t)DEPTH * 32 * 3 * DIN * 4;
constexpr size_t WS_HB    = WS_SHPG + (size_t)DEPTH * 32 * 3 * 2 * DFF * 4;
constexpr size_t WS_END2B = WS_HB + (size_t)MTOK * DM * 2;
constexpr size_t WS_END3  = WS_END2B;

constexpr size_t CTL_GRAN = 262144;
typedef __attribute__((address_space(1))) unsigned long long gu64_t;
__device__ __forceinline__ void gran_store(gu64_t* g, unsigned tag, float v) { __hip_atomic_store(g, ((unsigned long long)tag << 32) | __builtin_bit_cast(unsigned, v), __ATOMIC_RELAXED, __HIP_MEMORY_SCOPE_AGENT); }
struct Aff { float a, b; };
__device__ __forceinline__ Aff aff_then(const Aff first, const Aff second) { Aff r; r.a = second.a * first.a; r.b = second.a * first.b + second.b; return r; }

__device__ __forceinline__ void lru_gate(float pa, float pi, float x, float sp8l, float& a, float& u) {
    const float r = __builtin_amdgcn_rcpf(1.0f + __builtin_amdgcn_exp2f(pa)), ig = __builtin_amdgcn_rcpf(1.0f + __builtin_amdgcn_exp2f(pi));
    a = __builtin_amdgcn_exp2f(sp8l * r);
    const float em = fmaf(-a, a, 1.0f);
    u = __builtin_amdgcn_sqrtf(em) * (ig * x);
}
constexpr int S_OFF = 256 * XC_STRIDE, S_STRIDE = 68;
static_assert(S_OFF + 256 * S_STRIDE * 4 <= LDSCTL_OFF, "LRU LDS tiles below the control words");
__device__ __forceinline__ float gelu_fast(float x) { const float z = 0.7978845608028654f * (x + 0.044715f * x * x * x); return x * __builtin_amdgcn_rcpf(1.0f + __builtin_amdgcn_exp2f(-2.8853900817779268f * z)); }
template <bool FULL>
__device__ __forceinline__ void lru_unit(ArgsP A, const Ctx& C, int l, int sq  , int chunk, int n, int hh, float* outw) {
    const bf16* XIN = (const bf16*)(A->ws + WS_XIN); bf16* MIX = (bf16*)(A->ws + WS_MIX);
    const int T = sq < NB ? SEQ : DSEQ, tlo = chunk * 256, row0 = (sq < NB ? sq * SEQ : NCTX + (sq - NB) * DSEQ) + tlo;
    LAS unsigned char* xl = C.lds;
    LAS float* S = (LAS float*)(C.lds + S_OFF);
    const int tid = C.tid, lane = C.lane, w = C.wave, fr = lane & 15, fq = lane >> 4;
    v4u lyv[4];
    if (FULL) {
#pragma unroll
        for (int k = 0; k < 4; ++k) { const int it = tid + 512 * k, tok = it >> 3, c8 = (it & 7) * 8; lyv[k] = *(const v4u*)(XIN + (size_t)(row0 + tok) * DIN + C_LY + n * 128 + hh * 64 + c8); }
    }
    {
        const int c8 = (tid & 15) * 8, chb = n * 128 + c8; float wt[4][8], bb[8];
#pragma unroll
        for (int i = 0; i < 8; ++i) bb[i] = A->in[I_LCB][l * DLRU + chb + i];
#pragma unroll
        for (int dk = 0; dk < 4; ++dk)
#pragma unroll
            for (int i = 0; i < 8; ++i) wt[dk][i] = A->in[I_LCW][(l * 4 + dk) * DLRU + chb + i];
#pragma unroll
        for (int q = 0; q < 2; ++q) {
            const int tb = 4 * (tid >> 4) + 128 * q;
            v4u xr[7];
#pragma unroll
            for (int j = 0; j < 7; ++j) { const int tt = tlo + tb + j - 2; xr[j] = (v4u){0u, 0u, 0u, 0u}; if (tt >= 0 && tt < T) xr[j] = *(const v4u*)(XIN + (size_t)(row0 + tb + j - 2) * DIN + C_LX + chb); }
#pragma unroll
            for (int t4 = 0; t4 < 4; ++t4) { float xc[8];
#pragma unroll
                for (int i = 0; i < 8; ++i) xc[i] = bb[i];
#pragma unroll
                for (int dk = 0; dk < 4; ++dk) { const v4u x = xr[t4 + dk];
                    xc[0] += wt[dk][0] * bflo(x.x); xc[1] += wt[dk][1] * bfhi(x.x); xc[2] += wt[dk][2] * bflo(x.y); xc[3] += wt[dk][3] * bfhi(x.y);
                    xc[4] += wt[dk][4] * bflo(x.z); xc[5] += wt[dk][5] * bfhi(x.z); xc[6] += wt[dk][6] * bflo(x.w); xc[7] += wt[dk][7] * bfhi(x.w); }
                v4u o; o.x = pk2(xc[0], xc[1]); o.y = pk2(xc[2], xc[3]); o.z = pk2(xc[4], xc[5]); o.w = pk2(xc[6], xc[7]);
                *(LAS v4u*)(xl + xaddr(tb + t4, c8 * 2)) = o; }
        }
    }
    __syncthreads();
    const int d = w >> 2, cg = w & 3, wq = 4 * hh + cg, ch = n * 128 + wq * 16 + fr;
    const bf16x8_t* wfrag = (const bf16x8_t*)(A->ws + WS_WFRAG); gu64_t* gran = (gu64_t*)(A->ws + WS_CTL + CTL_GRAN); const unsigned tag = (unsigned)l + 1u;
    bf16x8_t bfr[2][4];
#pragma unroll
    for (int g = 0; g < 2; ++g)
#pragma unroll
        for (int ks = 0; ks < 4; ++ks) bfr[g][ks] = wfrag[((((((size_t)l * 2 + d) * 4 + n) * 2 + g) * 8 + wq) * 4 + ks) * 64 + lane];
    const float ba = -1.4426950408889634f * A->in[I_LBA][(l * 2 + d) * DLRU + ch], bi = -1.4426950408889634f * A->in[I_LBI][(l * 2 + d) * DLRU + ch];
    const float sp8 = -8.0f * 1.4426950408889634f * log1pf(expf(-A->in[I_LAM][(l * 2 + d) * DLRU + ch]));
    float hrun = 0.f; Aff run; run.a = 1.f; run.b = 0.f;
    if (FULL && sq >= NB) {
        const int b = sq - NB; float h = A->in[I_ST][((b * DEPTH + l) * 2 + d) * DLRU + ch];
        float ga[8], gb[8];
        for (unsigned spins = 0; spins < (1u << 20); ++spins) { bool ok = true;
#pragma unroll
            for (int c2 = 0; c2 < 8; ++c2) { const bool need = (d == 0) ? (c2 < chunk) : (c2 > chunk); ga[c2] = 1.f; gb[c2] = 0.f;
                if (need) { gu64_t* sp = gran + ((((size_t)b * 8 + c2) * 2 + d) * DLRU + ch) * 2;
                    const unsigned long long x0 = __hip_atomic_load(sp, __ATOMIC_RELAXED, __HIP_MEMORY_SCOPE_AGENT), x1 = __hip_atomic_load(sp + 1, __ATOMIC_RELAXED, __HIP_MEMORY_SCOPE_AGENT);
                    ok = ok && ((unsigned)(x0 >> 32) == tag) && ((unsigned)(x1 >> 32) == tag); ga[c2] = __builtin_bit_cast(float, (unsigned)x0); gb[c2] = __builtin_bit_cast(float, (unsigned)x1); } }
            if (__all(ok)) break;
            __builtin_amdgcn_s_sleep(2); }
#pragma unroll
        for (int k = 0; k < 8; ++k) { const int c2 = (d == 0) ? k : 7 - k; h = ga[c2] * h + gb[c2]; }
        hrun = h;
    }
    const int up16 = ((lane - 16) & 63) * 4, up32 = ((lane - 32) & 63) * 4, last = (48 + fr) * 4;
    const int taur = 16 * (fr >> 2) + (fr & 3);
#pragma unroll 1
    for (int half = 0; half < 2; ++half) {
#pragma unroll 1
        for (int k = 0; k < 2; ++k) {
            const int si = half * 2 + k, st = d ? 3 - si : si;
            f32x4 accA[4], accI[4];
#pragma unroll
            for (int j = 0; j < 4; ++j) { accA[j] = (f32x4){ba, ba, ba, ba}; accI[j] = (f32x4){bi, bi, bi, bi};
                const int trow = d ? 64 * st + 63 - (taur + 4 * j) : 64 * st + taur + 4 * j;
#pragma unroll
                for (int ks = 0; ks < 4; ++ks) { const bf16x8_t af = *(const LAS bf16x8_t*)(xl + xaddr(trow, (32 * ks + 8 * fq) * 2));
                    accA[j] = __builtin_amdgcn_mfma_f32_16x16x32_bf16(af, bfr[0][ks], accA[j], 0, 0, 0); accI[j] = __builtin_amdgcn_mfma_f32_16x16x32_bf16(af, bfr[1][ks], accI[j], 0, 0, 0); } }
            const int tokb = d ? 64 * st + 48 - 16 * fq : 64 * st + 16 * fq;
            float a[16], u[16];
            { const LAS unsigned char* xp = xl + xaddr(tokb, (wq * 16 + fr) * 2); float xs[16];
#pragma unroll
              for (int k = 0; k < 16; ++k) xs[k] = bf2f(*(const LAS bf16*)(xp + k * XC_STRIDE));
#pragma unroll
              for (int j = 0; j < 4; ++j)
#pragma unroll
                for (int i = 0; i < 4; ++i) { const int n2 = 4 * j + i; const float x = d ? xs[15 - n2] : xs[n2]; lru_gate(accA[j][i], accI[j][i], x, sp8, a[n2], u[n2]); } }
            Aff L; L.a = 1.f; L.b = 0.f;
#pragma unroll
            for (int n2 = 0; n2 < 16; ++n2) { L.b = a[n2] * L.b + u[n2]; L.a = a[n2] * L.a; }
            Aff I = L;
            { Aff Q; Q.a = bperm(I.a, up16); Q.b = bperm(I.b, up16); const Aff J = aff_then(Q, I); const bool has = fq >= 1; I.a = has ? J.a : I.a; I.b = has ? J.b : I.b; }
            { Aff Q; Q.a = bperm(I.a, up32); Q.b = bperm(I.b, up32); const Aff J = aff_then(Q, I); const bool has = fq >= 2; I.a = has ? J.a : I.a; I.b = has ? J.b : I.b; }
            Aff E; E.a = bperm(I.a, up16); E.b = bperm(I.b, up16); if (fq == 0) { E.a = 1.f; E.b = 0.f; }
            Aff Tt; Tt.a = bperm(I.a, last); Tt.b = bperm(I.b, last);
            if (FULL) {
                float h = E.a * hrun + E.b;
#pragma unroll
                for (int n2 = 0; n2 < 16; ++n2) { h = a[n2] * h + u[n2]; u[n2] = h; }
                LAS float* sp = S + tokb * S_STRIDE + cg * 16 + fr;
                if (half == 0) {
#pragma unroll
                    for (int k = 0; k < 16; ++k) sp[k * S_STRIDE] = d ? u[15 - k] : u[k];
                } else {
#pragma unroll
                    for (int k = 0; k < 16; ++k) sp[k * S_STRIDE] += d ? u[15 - k] : u[k];
                }
                hrun = Tt.a * hrun + Tt.b;
            } else { run = aff_then(run, Tt); }
        }
        if (FULL) __syncthreads();
    }
    if (FULL) {
        if (sq < NB && lane < 16) outw[OUT_S + ((size_t)(sq * DEPTH + l) * 2 + d) * DLRU + ch] = hrun;
#pragma unroll
        for (int k = 0; k < 4; ++k) { const int it = tid + 512 * k, tok = it >> 3, c8 = (it & 7) * 8; const size_t row = (size_t)(row0 + tok);
            const f32x4 s0 = *(const LAS f32x4*)(S + tok * S_STRIDE + c8), s1 = *(const LAS f32x4*)(S + tok * S_STRIDE + c8 + 4);
            const v4u ly = lyv[k]; v4u o;
            o.x = pk2(s0.x * gelu_fast(bflo(ly.x)), s0.y * gelu_fast(bfhi(ly.x))); o.y = pk2(s0.z * gelu_fast(bflo(ly.y)), s0.w * gelu_fast(bfhi(ly.y)));
            o.z = pk2(s1.x * gelu_fast(bflo(ly.z)), s1.y * gelu_fast(bfhi(ly.z))); o.w = pk2(s1.z * gelu_fast(bflo(ly.w)), s1.w * gelu_fast(bfhi(ly.w)));
            *(v4u*)(MIX + row * DM + 1024 + n * 128 + hh * 64 + c8) = o; }
    } else if (lane < 16) { gu64_t* sp = gran + ((((size_t)(sq - NB) * 8 + chunk) * 2 + d) * DLRU + ch) * 2; gran_store(sp, tag, run.a); gran_store(sp + 1, tag, run.b); }
    __syncthreads();
}
__device__ __forceinline__ void lru_prep_wfrag(ArgsP A, const Ctx& C) {
    v4u* wf = (v4u*)(A->ws + WS_WFRAG);
    for (int it = C.gt; it < DEPTH * 2 * 4 * 2 * 8 * 4 * 64; it += C.ngt) {
        const int lane = it & 63, ks = (it >> 6) & 3, w = (it >> 8) & 7, g = (it >> 11) & 1, ldn = it >> 12;
        const float* W = (g == 0 ? A->in[I_LWA] : A->in[I_LWI]) + (size_t)ldn * 128 * 128;
        const int k0 = 32 * ks + 8 * (lane >> 4), j = 16 * w + (lane & 15);
        const float sc = -1.4426950408889634f;
        v4u o; o.x = pk2(sc * W[(k0 + 0) * 128 + j], sc * W[(k0 + 1) * 128 + j]); o.y = pk2(sc * W[(k0 + 2) * 128 + j], sc * W[(k0 + 3) * 128 + j]);
        o.z = pk2(sc * W[(k0 + 4) * 128 + j], sc * W[(k0 + 5) * 128 + j]); o.w = pk2(sc * W[(k0 + 6) * 128 + j], sc * W[(k0 + 7) * 128 + j]);
        wf[it] = o;
    }
}
namespace att {
using bf16x8 = __attribute__((ext_vector_type(8))) short;
using s16x4  = __attribute__((ext_vector_type(4))) short;
using f32x16 = __attribute__((ext_vector_type(16))) float;
using u32x4  = __attribute__((ext_vector_type(4))) unsigned;
constexpr float SCALE = 0.088388347648318440f, THR = 8.f;
constexpr int SHM_V = 16384, SHM_K = 16384, OFF_V = 0, OFF_K = 2 * SHM_V, OFF_WS = 2 * SHM_V + 2 * SHM_K, OFF_BT = OFF_WS + 8 * 256, BT_PITCH = 36, OFF_OT = OFF_BT + 4 * 15 * BT_PITCH * 4 + 64, LDS_ATT = OFF_OT + 8 * 32 * 272;
static_assert(LDS_ATT <= LDSCTL_OFF, "attention LDS tiles below the control words");
#define KSWZ(row, colB) ((row) * 256 + ((colB) ^ (((row) & 7) << 4)))
#define SBAR() __builtin_amdgcn_sched_barrier(0)
__device__ __forceinline__ int crow(int r, int hi) { return (r & 3) + 8 * (r >> 2) + 4 * hi; }
__device__ __forceinline__ unsigned cvtpk(float lo, float hi) { unsigned r; asm volatile("v_cvt_pk_bf16_f32 %0, %1, %2" : "=v"(r) : "v"(lo), "v"(hi)); return r; }
__device__ __forceinline__ void partialSM(f32x16& p0, f32x16& p1, float& m_reg, float& mn, float& alpha) {
  constexpr float C = SCALE * 1.4426950408889634f;
  float pmax = p0[0];
#pragma unroll
  for (int r = 1; r < 16; ++r) pmax = fmaxf(pmax, p0[r]);
#pragma unroll
  for (int r = 0; r < 16; ++r) pmax = fmaxf(pmax, p1[r]);
  pmax = xor32_max(pmax);
  if (__builtin_expect(__all(pmax - m_reg <= THR / SCALE), 1)) { mn = m_reg; alpha = 1.f; }
  else { mn = fmaxf(m_reg, pmax); alpha = __builtin_amdgcn_exp2f((m_reg - mn) * C); m_reg = mn; }
  float mnC = -mn * C;
#pragma unroll
  for (int r = 0; r < 16; ++r) p0[r] = fmaf(p0[r], C, mnC);
#pragma unroll
  for (int r = 0; r < 16; ++r) p1[r] = fmaf(p1[r], C, mnC);
#pragma unroll
  for (int r = 0; r < 16; ++r) p0[r] = __builtin_amdgcn_exp2f(p0[r]);
}
__device__ __forceinline__ void finishSM(f32x16& p0, f32x16& p1, float alpha, float& l_reg, bf16x8& pa0, bf16x8& pa1, bf16x8& pa2, bf16x8& pa3) {
#pragma unroll
  for (int r = 0; r < 16; ++r) p1[r] = __builtin_amdgcn_exp2f(p1[r]);
  float ps = 0;
#pragma unroll
  for (int r = 0; r < 16; ++r) ps += p0[r];
#pragma unroll
  for (int r = 0; r < 16; ++r) ps += p1[r];
  ps = xor32_sum(ps);
  l_reg = l_reg * alpha + ps;
#define PK4(P, BASE, OUT) do { unsigned a0 = cvtpk(P[BASE + 0], P[BASE + 1]), a1 = cvtpk(P[BASE + 2], P[BASE + 3]);   \
    unsigned b0 = cvtpk(P[BASE + 4], P[BASE + 5]), b1 = cvtpk(P[BASE + 6], P[BASE + 7]);                              \
    auto r0 = __builtin_amdgcn_permlane32_swap(a0, b0, false, false); auto r1 = __builtin_amdgcn_permlane32_swap(a1, b1, false, false); \
    u32x4 w = {r0[0], r1[0], r0[1], r1[1]}; OUT = *reinterpret_cast<bf16x8*>(&w); } while (0)
  PK4(p0, 0, pa0); PK4(p0, 8, pa1); PK4(p1, 0, pa2); PK4(p1, 8, pa3);
#undef PK4
}
__device__ __forceinline__ void qkt(f32x16& p0, f32x16& p1, const LAS unsigned char* Ks, const bf16x8* qr, int r32, int hi) {
  p0 = f32x16{}; p1 = f32x16{};
#pragma unroll
  for (int d0 = 0; d0 < 8; ++d0) { int cb = (d0 * 16 + hi * 8) * 2;
    bf16x8 b0 = *reinterpret_cast<const LAS bf16x8*>(Ks + KSWZ(r32, cb));
    bf16x8 b1 = *reinterpret_cast<const LAS bf16x8*>(Ks + KSWZ(32 + r32, cb));
    p0 = __builtin_amdgcn_mfma_f32_32x32x16_bf16(b0, qr[d0], p0, 0, 0, 0);
    p1 = __builtin_amdgcn_mfma_f32_32x32x16_bf16(b1, qr[d0], p1, 0, 0, 0); }
}
__device__ __forceinline__ int v_st(int k, int c) { const int kk = (k & ~0xC) | ((k & 4) << 1) | ((k & 8) >> 1); return ((kk >> 3) * 4 + (c >> 5)) * 512 + ((kk & 7) * 32 + (c & 31)) * 2; }
__device__ __forceinline__ int v_rd_base(int lane) { return ((lane & 3) << 3) | (((lane >> 2) & 3) << 6) | (((lane >> 4) & 1) << 5) | (((lane >> 5) & 1) << 8); }
constexpr int v_rd_off(int d0, int ks, int half) { return d0 * 512 + ks * 4096 + half * 2048; }
template <int OFF> __device__ __forceinline__ s16x4 tr_read(int vb) {
  s16x4 r; asm volatile("ds_read_b64_tr_b16 %0, %1 offset:%2" : "=&v"(r) : "v"(vb), "i"(OFF) : "memory"); return r;
}
template <int D0> __device__ __forceinline__ void pv_one(f32x16& od, int vb, bf16x8 pa0, bf16x8 pa1, bf16x8 pa2, bf16x8 pa3) {
  const s16x4 l0 = tr_read<v_rd_off(D0, 0, 0)>(vb), h0 = tr_read<v_rd_off(D0, 0, 1)>(vb), l1 = tr_read<v_rd_off(D0, 1, 0)>(vb), h1 = tr_read<v_rd_off(D0, 1, 1)>(vb);
  const s16x4 l2 = tr_read<v_rd_off(D0, 2, 0)>(vb), h2 = tr_read<v_rd_off(D0, 2, 1)>(vb), l3 = tr_read<v_rd_off(D0, 3, 0)>(vb), h3 = tr_read<v_rd_off(D0, 3, 1)>(vb);
  asm volatile("s_waitcnt lgkmcnt(0)" ::: "memory"); SBAR();
#define PK(L, H) (bf16x8){L[0], L[1], L[2], L[3], H[0], H[1], H[2], H[3]}
  od = __builtin_amdgcn_mfma_f32_32x32x16_bf16(pa0, PK(l0, h0), od, 0, 0, 0);
  od = __builtin_amdgcn_mfma_f32_32x32x16_bf16(pa1, PK(l1, h1), od, 0, 0, 0);
  od = __builtin_amdgcn_mfma_f32_32x32x16_bf16(pa2, PK(l2, h2), od, 0, 0, 0);
  od = __builtin_amdgcn_mfma_f32_32x32x16_bf16(pa3, PK(l3, h3), od, 0, 0, 0);
#undef PK
}
__device__ __forceinline__ void pv_d0(f32x16* o, int vb, bf16x8 pa0, bf16x8 pa1, bf16x8 pa2, bf16x8 pa3) {
  pv_one<0>(o[0], vb, pa0, pa1, pa2, pa3); pv_one<1>(o[1], vb, pa0, pa1, pa2, pa3); pv_one<2>(o[2], vb, pa0, pa1, pa2, pa3); pv_one<3>(o[3], vb, pa0, pa1, pa2, pa3);
}
__device__ __forceinline__ void qkt_half(f32x16& p0, const LAS unsigned char* Ks, const bf16x8* qr, int krow, int hi) {
  p0 = f32x16{};
#pragma unroll
  for (int d0 = 0; d0 < 8; ++d0) { int cb = (d0 * 16 + hi * 8) * 2;
    bf16x8 b0 = *reinterpret_cast<const LAS bf16x8*>(Ks + KSWZ(krow, cb));
    p0 = __builtin_amdgcn_mfma_f32_32x32x16_bf16(b0, qr[d0], p0, 0, 0, 0); }
}
__device__ __forceinline__ void partialSM_h(f32x16& p0, float& m_reg, float& mn, float& alpha) {
  constexpr float C = SCALE * 1.4426950408889634f;
  float pmax = p0[0];
#pragma unroll
  for (int r = 1; r < 16; ++r) pmax = fmaxf(pmax, p0[r]);
  pmax = xor32_max(pmax);
  if (__builtin_expect(__all(pmax - m_reg <= THR / SCALE), 1)) { mn = m_reg; alpha = 1.f; }
  else { mn = fmaxf(m_reg, pmax); alpha = __builtin_amdgcn_exp2f((m_reg - mn) * C); m_reg = mn; }
  float mnC = -mn * C;
#pragma unroll
  for (int r = 0; r < 16; ++r) p0[r] = __builtin_amdgcn_exp2f(fmaf(p0[r], C, mnC));
}
__device__ __forceinline__ void finishSM_h(f32x16& p0, float alpha, float& l_reg, bf16x8& pa0, bf16x8& pa1) {
  float ps = 0;
#pragma unroll
  for (int r = 0; r < 16; ++r) ps += p0[r];
  ps = xor32_sum(ps);
  l_reg = l_reg * alpha + ps;
#define PK4(P, BASE, OUT) do { unsigned a0 = cvtpk(P[BASE + 0], P[BASE + 1]), a1 = cvtpk(P[BASE + 2], P[BASE + 3]);   \
    unsigned b0 = cvtpk(P[BASE + 4], P[BASE + 5]), b1 = cvtpk(P[BASE + 6], P[BASE + 7]);                              \
    auto r0 = __builtin_amdgcn_permlane32_swap(a0, b0, false, false); auto r1 = __builtin_amdgcn_permlane32_swap(a1, b1, false, false); \
    u32x4 w = {r0[0], r1[0], r0[1], r1[1]}; OUT = *reinterpret_cast<bf16x8*>(&w); } while (0)
  PK4(p0, 0, pa0); PK4(p0, 8, pa1);
#undef PK4
}
template <int D0> __device__ __forceinline__ void pv_half_one(f32x16& od, int vb, bf16x8 pa0, bf16x8 pa1) {
  const s16x4 l0 = tr_read<v_rd_off(D0, 0, 0)>(vb), h0 = tr_read<v_rd_off(D0, 0, 1)>(vb), l1 = tr_read<v_rd_off(D0, 1, 0)>(vb), h1 = tr_read<v_rd_off(D0, 1, 1)>(vb);
  asm volatile("s_waitcnt lgkmcnt(0)" ::: "memory"); SBAR();
#define PK(L, H) (bf16x8){L[0], L[1], L[2], L[3], H[0], H[1], H[2], H[3]}
  od = __builtin_amdgcn_mfma_f32_32x32x16_bf16(pa0, PK(l0, h0), od, 0, 0, 0);
  od = __builtin_amdgcn_mfma_f32_32x32x16_bf16(pa1, PK(l1, h1), od, 0, 0, 0);
#undef PK
}
__device__ __forceinline__ void pv_half(f32x16* o, int vb, bf16x8 pa0, bf16x8 pa1) {
  pv_half_one<0>(o[0], vb, pa0, pa1); pv_half_one<1>(o[1], vb, pa0, pa1); pv_half_one<2>(o[2], vb, pa0, pa1); pv_half_one<3>(o[3], vb, pa0, pa1);
}
}

template <bool LATENT>
__device__ __forceinline__ void attn_unit(ArgsP A, const Ctx& C, int l, int uidx, float* outw) {
  using namespace att;
  const bf16* XIN = (const bf16*)(A->ws + WS_XIN); bf16* MIX = (bf16*)(A->ws + WS_MIX);
  int tid_ = C.tid, wid_ = C.wave; asm volatile("" : "+v"(tid_)); asm volatile("" : "+s"(wid_));
  const int tid = tid_, wid = wid_, lane = tid & 63, r32 = lane & 31, hi = lane >> 5;
  const int h = uidx & 7, b = LATENT ? (uidx >> 6) : (uidx >> 3), rg = (uidx >> 3) & 7;
  const int q0 = LATENT ? NCTX + b * DSEQ + rg * 256 : b * SEQ;
  const int R0 = (rg == 7) ? 24 : max(4 * rg - 4, 0);
  const int NT = LATENT ? ((rg == 0 || rg == 7) ? 12 : 15) : 4;
  LAS unsigned char* lds = C.lds;
  LAS float* wsf = (LAS float*)(lds + OFF_WS) + wid * 64; LAS float* li_l = wsf; LAS float* al_l = wsf + 32;
  LAS float* btab = (LAS float*)(lds + OFF_BT);
  const float* ssq = (const float*)(A->ws + WS_SSQ);
  const float* gkb = A->in[I_KG] + l * HD;
  const int sr = tid >> 4, sc = (tid & 15) * 8, vst0 = v_st(sr, sc), vst1 = v_st(32 + sr, sc);
  const int vb0 = (int)(uintptr_t)(lds + OFF_V) + v_rd_base(lane);
  bf16x8 sv0, sv1, sk0, sk1; f32x4 sq0 = {0.f, 0.f, 0.f, 0.f}, sq1 = sq0; int skrow = 0;
#define SLOAD(j) do { const bf16* kp; const bf16* vp; int ld; \
    if (!LATENT) { skrow = b * SEQ + 64 * (j) + sr; const size_t ro = (size_t)(b * SEQ + 64 * (j)) * DIN + h * HD; kp = XIN + ro + C_K; vp = XIN + ro + C_V; ld = DIN; } \
    else if ((j) < 4) { const size_t ro = (((size_t)b * DEPTH + l) * 256 + 64 * (j)) * 1024 + h * HD; kp = (const bf16*)(A->ws + WS_CKB) + ro; vp = (const bf16*)(A->ws + WS_CVB) + ro; ld = 1024; } \
    else { skrow = NCTX + b * DSEQ + (R0 + (j) - 4) * GW + sr; const size_t ro = (size_t)(NCTX + b * DSEQ + (R0 + (j) - 4) * GW) * DIN + h * HD; kp = XIN + ro + C_K; vp = XIN + ro + C_V; ld = DIN; } \
    if (!LATENT || (j) >= 4) { sq0 = *(const f32x4*)(ssq + ((size_t)skrow * 16 + 8 + h) * 4); sq1 = *(const f32x4*)(ssq + ((size_t)(skrow + 32) * 16 + 8 + h) * 4); } \
    sv0 = *reinterpret_cast<const bf16x8*>(vp + (size_t)sr * ld + sc); sv1 = *reinterpret_cast<const bf16x8*>(vp + (size_t)(32 + sr) * ld + sc); \
    sk0 = *reinterpret_cast<const bf16x8*>(kp + (size_t)sr * ld + sc); sk1 = *reinterpret_cast<const bf16x8*>(kp + (size_t)(32 + sr) * ld + sc); } while (0)
#define KNORM(skx, sqx, rowx) do { const float rk = __builtin_amdgcn_rsqf(((sqx.x + sqx.y) + (sqx.z + sqx.w)) * (1.0f / HD) + EPS); const u32x4 w = *reinterpret_cast<const u32x4*>(&skx); \
    const f32x4 y0 = {bflo(w.x) * rk * gk0.x, bfhi(w.x) * rk * gk0.y, bflo(w.y) * rk * gk0.z, bfhi(w.y) * rk * gk0.w}, y1 = {bflo(w.z) * rk * gk1.x, bfhi(w.z) * rk * gk1.y, bflo(w.w) * rk * gk1.z, bfhi(w.w) * rk * gk1.w}; \
    u32x4 o; o.x = cvtpk(y0.x, y0.y); o.y = cvtpk(y0.z, y0.w); o.z = cvtpk(y1.x, y1.y); o.w = cvtpk(y1.z, y1.w); skx = *reinterpret_cast<bf16x8*>(&o); \
    if (!LATENT) { float* op = outw + OUT_K + (((size_t)b * DEPTH + l) * SEQ + ((rowx) & 255)) * DATT + h * HD + sc; __builtin_nontemporal_store(y0, (f32x4*)op); __builtin_nontemporal_store(y1, (f32x4*)(op + 4)); } } while (0)
#define SWRITE(bu, jn) do { if (!LATENT || (jn) >= 4) { int sc_ = sc; asm volatile("" : "+v"(sc_)); const f32x4 gk0 = *(const f32x4*)(gkb + sc_), gk1 = *(const f32x4*)(gkb + sc_ + 4); KNORM(sk0, sq0, skrow); KNORM(sk1, sq1, skrow + 32); } \
    *(LAS bf16x8*)(lds + OFF_V + (bu) * SHM_V + vst0) = sv0; *(LAS bf16x8*)(lds + OFF_V + (bu) * SHM_V + vst1) = sv1; const int kc = sc * 2; \
    *(LAS bf16x8*)(lds + OFF_K + (bu) * SHM_K + KSWZ(sr, kc)) = sk0; *(LAS bf16x8*)(lds + OFF_K + (bu) * SHM_K + KSWZ(32 + sr, kc)) = sk1; } while (0)
  float m_reg = -1e30f, l_reg = 0.f; f32x16 o[4] = {};
  SLOAD(0);
  bf16x8 qr[8];
  { const int qrow_ = LATENT ? q0 + (r32 >> 3) * 64 + 8 * wid + (r32 & 7) : q0 + wid * 32 + r32; const bf16* Qw = XIN + (size_t)qrow_ * DIN + C_Q + h * HD + hi * 8;
    const f32x4 pq = *(const f32x4*)(ssq + ((size_t)qrow_ * 16 + h) * 4); const float rq = __builtin_amdgcn_rsqf(((pq.x + pq.y) + (pq.z + pq.w)) * (1.0f / HD) + EPS);
    const float* gq = A->in[I_QG] + l * HD + hi * 8;
#pragma unroll
    for (int d0 = 0; d0 < 8; ++d0) { const u32x4 w = *reinterpret_cast<const u32x4*>(Qw + d0 * 16); const f32x4 g0 = *(const f32x4*)(gq + d0 * 16), g1 = *(const f32x4*)(gq + d0 * 16 + 4);
      u32x4 o; o.x = cvtpk(bflo(w.x) * rq * g0.x, bfhi(w.x) * rq * g0.y); o.y = cvtpk(bflo(w.y) * rq * g0.z, bfhi(w.y) * rq * g0.w);
      o.z = cvtpk(bflo(w.z) * rq * g1.x, bfhi(w.z) * rq * g1.y); o.w = cvtpk(bflo(w.w) * rq * g1.z, bfhi(w.w) * rq * g1.w); qr[d0] = *reinterpret_cast<bf16x8*>(&o); } }
  if (LATENT) { for (int i = tid; i < 4 * 15 * 31; i += 512) { const int sft = i / 465, q = i % 465, dr = q / 31, dc = q % 31; btab[(sft * 15 + dr) * BT_PITCH + dc + sft] = A->in[I_NAB][((l * NH + h) * 15 + dr) * 31 + dc] * (1.0f / SCALE); } }
  asm volatile("s_waitcnt vmcnt(0)" ::: "memory"); SWRITE(0, 0); __syncthreads();
  const int ND = LATENT ? 4 : NT;
#pragma unroll 1
  for (int j = 0; j < ND; ++j) {
    const int bu = j & 1;
    if (j + 1 < NT) SLOAD(j + 1);
    {
      f32x16 p0, p1; float mn, alpha; bf16x8 pa0, pa1, pa2, pa3;
      qkt(p0, p1, lds + OFF_K + bu * SHM_K, qr, r32, hi);
      partialSM(p0, p1, m_reg, mn, alpha);
      if (__any(alpha < 1.f)) { if (hi == 0) al_l[r32] = alpha; asm volatile("s_waitcnt lgkmcnt(0)" ::: "memory");
#pragma unroll
        for (int d = 0; d < 4; ++d)
#pragma unroll
          for (int r = 0; r < 16; ++r) o[d][r] *= al_l[crow(r, hi)];
        asm volatile("s_waitcnt lgkmcnt(0)" ::: "memory"); }
      finishSM(p0, p1, alpha, l_reg, pa0, pa1, pa2, pa3); SBAR();
      pv_d0(o, vb0 + bu * SHM_V, pa0, pa1, pa2, pa3);
    }
    if (j + 1 < NT) { asm volatile("s_waitcnt vmcnt(0)" ::: "memory"); SWRITE(bu ^ 1, j + 1); }
    __syncthreads();
  }
  if (LATENT) {
    int tl2 = tid; asm volatile("" : "+v"(tl2));
    const int r32b = tl2 & 31, hib = (tl2 >> 5) & 1;
    const int qrow = 4 * rg + (r32b >> 3), qcol = 8 * wid + (r32b & 7), rs = min(max(qrow - 4, 0), 24), cs = min(max(qcol - 8, 0), 48);
    const int kb16 = wid < 3 ? 0 : (wid < 5 ? 1 : 2);
    const int wsh = cs - 4 * hib - 16 * kb16;
    const unsigned wlo = wsh >= 0 ? (0xFFFFu << wsh) : (0xFFFFu >> (-wsh));
    const int sft = (qcol + 1) & 3, bt0 = (sft * 15 + 7 - qrow) * BT_PITCH + (15 - qcol) + sft + 4 * hib + 16 * kb16;
#pragma unroll 1
    for (int j = 4; j < NT; ++j) {
      const int bu = j & 1;
      if (j + 1 < NT) SLOAD(j + 1);
      {
      const int kr = R0 + j - 4;
      f32x16 p0; float mn, alpha; bf16x8 pa0, pa1;
      qkt_half(p0, lds + OFF_K + bu * SHM_K, qr, 16 * kb16 + r32b, hib);
      {
        const LAS f32x4* brow = (const LAS f32x4*)(btab + bt0 + kr * BT_PITCH);
        unsigned wl = ((unsigned)(kr - rs) < 8u) ? wlo : 0u; asm volatile("" : "+v"(wl));
#define MSK1(V, B, X, W) do { const int m_ = ((int)((W) << (31 - (X)))) >> 31; const unsigned t_ = __builtin_bit_cast(unsigned, (V) + (B)); V = __builtin_bit_cast(float, (t_ & (unsigned)m_) | (0xff800000u & ~(unsigned)m_)); } while (0)
#pragma unroll
        for (int g = 0; g < 4; ++g) { const f32x4 b0 = brow[2 * g];
          MSK1(p0[4 * g + 0], b0.x, 8 * g + 0, wl); MSK1(p0[4 * g + 1], b0.y, 8 * g + 1, wl); MSK1(p0[4 * g + 2], b0.z, 8 * g + 2, wl); MSK1(p0[4 * g + 3], b0.w, 8 * g + 3, wl); }
#undef MSK1
      }
      partialSM_h(p0, m_reg, mn, alpha);
      if (__any(alpha < 1.f)) { if (hib == 0) al_l[r32b] = alpha; asm volatile("s_waitcnt lgkmcnt(0)" ::: "memory");
#pragma unroll
        for (int d = 0; d < 4; ++d)
#pragma unroll
          for (int r = 0; r < 16; ++r) o[d][r] *= al_l[crow(r, hib)];
        asm volatile("s_waitcnt lgkmcnt(0)" ::: "memory"); }
      finishSM_h(p0, alpha, l_reg, pa0, pa1); SBAR();
      pv_half(o, vb0 + bu * SHM_V + kb16 * 4096, pa0, pa1);
      }
      if (j + 1 < NT) { asm volatile("s_waitcnt vmcnt(0)" ::: "memory"); SWRITE(bu ^ 1, j + 1); }
      __syncthreads();
    }
  }
  int ln2 = lane; asm volatile("" : "+v"(ln2)); const int r32e = ln2 & 31, hie = ln2 >> 5;
  if (hie == 0) li_l[r32e] = l_reg; asm volatile("s_waitcnt lgkmcnt(0)" ::: "memory");
  float rli[16];
#pragma unroll
  for (int r = 0; r < 16; ++r) rli[r] = __builtin_amdgcn_rcpf(li_l[crow(r, hie)]);
  LAS unsigned char* ot = lds + OFF_OT + wid * (32 * 272);
#pragma unroll
  for (int r = 0; r < 16; ++r) { const int orow = crow(r, hie);
#pragma unroll
    for (int d0 = 0; d0 < 4; ++d0) *(LAS bf16*)(ot + orow * 272 + (d0 * 32 + r32e) * 2) = (bf16)f2bf(o[d0][r] * rli[r]); }
  asm volatile("s_waitcnt lgkmcnt(0)" ::: "memory");
  bf16* Ow = MIX + (size_t)(LATENT ? q0 + 8 * wid : q0 + wid * 32) * DM + h * HD;
#pragma unroll
  for (int i = 0; i < 8; ++i) { const int orow = 4 * i + (ln2 >> 4), oc = (ln2 & 15) * 8, grow = LATENT ? (orow >> 3) * 64 + (orow & 7) : orow;
    *(u32x4*)(Ow + (size_t)grow * DM + oc) = *(const LAS u32x4*)(ot + orow * 272 + oc * 2); }
  __syncthreads();
#undef SLOAD
#undef SWRITE
#undef KNORM
}
#undef KSWZ
#undef SBAR
__device__ __forceinline__ ConvItem conv_desc(ArgsP A, int l, int set, int r, const LAS float* sht) {
    ConvItem d;
    if (set == 0) {
        if (r < 5632) { const int kb = r / 176, nb = r % 176, n0 = 32 * nb; d.W = A->in[I_WIN] + (size_t)l * DM * DIN; d.WT = (bf16*)(A->ws + WS_WIN) + (size_t)l * DIN * DM; d.K = DM; d.N = DIN; d.k0 = 64 * kb; d.n0 = n0; d.drow0 = n0;
            d.sh = sht; d.shwp = (float*)(A->ws + WS_SHPI) + ((size_t)l * 32 + kb) * 3 * DIN; d.ntot = DIN; }
        else { const int q = r - 5632, kb = q / 64, nb = q % 64; d.W = A->in[I_WOUT] + (size_t)l * DM * DM; d.WT = (bf16*)(A->ws + WS_WOUT) + (size_t)l * DM * DM; d.K = DM; d.N = DM; d.k0 = 64 * kb; d.n0 = 32 * nb; d.drow0 = 32 * nb; d.sh = nullptr; d.shwp = nullptr; d.ntot = 0; }
    } else { const int m = r / 5632, q = r % 5632;
        if (m < 2) { const int kb = q / 176, nb = q % 176, n0 = 32 * nb; d.W = (m ? A->in[I_WU] : A->in[I_WG]) + (size_t)l * DM * DFF; d.WT = (bf16*)(A->ws + WS_WGU) + (size_t)l * 2 * DFF * DM; d.K = DM; d.N = DFF; d.k0 = 64 * kb; d.n0 = n0;
            d.drow0 = 256 * (n0 >> 7) + 128 * m + (n0 & 127); d.sh = sht; d.shwp = (float*)(A->ws + WS_SHPG) + ((size_t)l * 32 + kb) * 3 * 2 * DFF; d.ntot = 2 * DFF; }
        else { const int kb = q / 64, nb = q % 64; d.W = A->in[I_WD] + (size_t)l * DFF * DM; d.WT = (bf16*)(A->ws + WS_WDN) + (size_t)l * DM * DFF; d.K = DFF; d.N = DM; d.k0 = 64 * kb; d.n0 = 32 * nb; d.drow0 = 32 * nb; d.sh = nullptr; d.shwp = nullptr; d.ntot = 0; }
    }
    return d;
}
__device__ __forceinline__ void convert_layer(ArgsP A, const Ctx& C, int l, int set, int jw, int nw) {
    LAS float* scr = (LAS float*)(C.lds + C.wave * 8448);
    LAS float* sht = (LAS float*)(C.lds + 69632);
    const float* mod = (const float*)(A->ws + WS_MOD);
    __syncthreads();
    for (int i = C.tid; i < 3 * DM; i += 512) { const int c = i / DM, k = i % DM; sht[i] = mod[((size_t)l * 3 + c) * 12288 + (set ? 6144 : 0) + k]; }
    __syncthreads();
    const int nitems = set ? 3 * 5632 : 5632 + 2048;
    if (jw < nitems) {
        ConvItem c0 = conv_desc(A, l, set, jw, sht), c1, c2; float v0[32], v1[32], v2[32]; conv_load(c0, C.lane, v0);
        c1 = conv_desc(A, l, set, jw + nw < nitems ? jw + nw : 0, sht); conv_load(c1, C.lane, v1);
        int r = jw;
#define CONV_STEP(VA, CA, VC, CC) { CC = conv_desc(A, l, set, r + 2 * nw < nitems ? r + 2 * nw : 0, sht); conv_load(CC, C.lane, VC); conv_process(CA, C.lane, VA, scr); r += nw; if (r >= nitems) break; }
        for (;;) { CONV_STEP(v0, c0, v2, c2) CONV_STEP(v1, c1, v0, c0) CONV_STEP(v2, c2, v1, c1) }
#undef CONV_STEP
    }
    __syncthreads();
}
__device__ __forceinline__ void reduce_shw(ArgsP A, const Ctx& C, int l, int which, bool half_grid = true) {
    const int t0 = (int)blockIdx.x * (NWAVES * 64) + C.tid, nt = (half_grid ? C.G / 2 : C.G) * NWAVES * 64;
    if (which == 0) { const float* shpi = (const float*)(A->ws + WS_SHPI); float* shwi = (float*)(A->ws + WS_SHWI);
        for (int r = t0; r < 3 * DIN; r += nt) { float s = 0.f; for (int kb = 0; kb < 32; ++kb) s += shpi[((size_t)l * 32 + kb) * 3 * DIN + r]; shwi[(size_t)l * 3 * DIN + r] = s; } }
    else { const float* shpg = (const float*)(A->ws + WS_SHPG); float* shwg = (float*)(A->ws + WS_SHWG);
        for (int r = t0; r < 3 * 2 * DFF; r += nt) { float s = 0.f; for (int kb = 0; kb < 32; ++kb) s += shpg[((size_t)l * 32 + kb) * 3 * 2 * DFF + r]; shwg[(size_t)l * 3 * 2 * DFF + r] = s; } }
}
__device__ __forceinline__ void p0a(ArgsP A, const Ctx& C) {
    LAS float* st = (LAS float*)(C.lds + 98304);
    for (int i = C.tid; i < 3 * DM; i += 512) { const int c = i / DM, k = i % DM; const float x = (c == 0) ? A->in[I_CCTX][k] : A->in[I_C][(c - 1) * DM + k]; st[i] = x / (1.0f + expf(-x)); }
    __syncthreads();
    float* modp = (float*)(A->ws + WS_MODP);
    for (int it = C.gw; it < DEPTH * 32 * 48; it += C.ngw) {
        const int nb = it % 48, ks = (it / 48) % 32, l = it / (48 * 32), n = nb * 256 + C.lane * 4;
        const float* w = A->in[I_WMOD] + ((size_t)l * DM + ks * 64) * 12288 + n;
        f32x4 a0 = {0.f, 0.f, 0.f, 0.f}, a1 = a0, a2 = a0;
#pragma unroll 8
        for (int kk = 0; kk < 64; ++kk) { const f32x4 wv = __builtin_nontemporal_load((const f32x4*)(w + (size_t)kk * 12288)); const int k = ks * 64 + kk; a0 += st[k] * wv; a1 += st[DM + k] * wv; a2 += st[2 * DM + k] * wv; }
        float* o = modp + (((size_t)l * 32 + ks) * 3) * 12288 + n;
        *(f32x4*)o = a0; *(f32x4*)(o + 12288) = a1; *(f32x4*)(o + 2 * 12288) = a2;
    }
    lru_prep_wfrag(A, C);
    for (int i = C.gt; i < 2 * DB * DEPTH * 256 * 1024 / 8; i += C.ngt) {
        const int half = DB * DEPTH * 256 * 1024 / 8; const bool isk = i < half; const int j = isk ? i : i - half;
        const float* src = (isk ? A->in[I_CK] : A->in[I_CV]) + (size_t)j * 8; const f32x4 x0 = __builtin_nontemporal_load((const f32x4*)src), x1 = __builtin_nontemporal_load((const f32x4*)(src + 4));
        v4u o; o.x = pk2(x0.x, x0.y); o.y = pk2(x0.z, x0.w); o.z = pk2(x1.x, x1.y); o.w = pk2(x1.z, x1.w);
        *(v4u*)(A->ws + (isk ? WS_CKB : WS_CVB) + (size_t)j * 16) = o; }
}
__device__ __forceinline__ void p0b(ArgsP A, const Ctx& C) {
    const float* modp = (const float*)(A->ws + WS_MODP); float* mod = (float*)(A->ws + WS_MOD); float* gs = (float*)(A->ws + WS_GS);
    for (int i = C.gt; i < DEPTH * 3 * 12288; i += C.ngt) { const int n = i % 12288, c = (i / 12288) % 3, l = i / (3 * 12288);
        float s = A->in[I_BMOD][l * 12288 + n];
        for (int ks = 0; ks < 32; ++ks) s += modp[(((size_t)l * 32 + ks) * 3 + c) * 12288 + n];
        mod[i] = s;
        if (n >= 2048 && n < 4096) gs[(((size_t)l * 2 + 0) * 3 + c) * DM + (n - 2048)] = A->in[I_GMIX][l * DM + n - 2048] * (1.0f + s);
        if (n >= 8192 && n < 10240) gs[(((size_t)l * 2 + 1) * 3 + c) * DM + (n - 8192)] = A->in[I_GFFN][l * DM + n - 8192] * (1.0f + s); }
}
__device__ __forceinline__ void p0c(ArgsP A, const Ctx& C) {
    convert_layer(A, C, 0, 0, C.gw, C.ngw); convert_layer(A, C, 0, 1, C.gw, C.ngw);
    bf16* U = (bf16*)(A->ws + WS_U); float* hssq = (float*)(A->ws + WS_HSSQ); const float* gs0 = (const float*)(A->ws + WS_GS);
    for (int row = C.gw; row < MTOK; row += C.ngw) {
        const int cond = row < NCTX ? 0 : 1 + ((row - NCTX) >> 11);
        const float* hr = row < NCTX ? A->in[I_XP] + (size_t)row * DM : A->in[I_XS] + (size_t)(row - NCTX) * DM;
        const f32x4* xr = (const f32x4*)hr + C.lane; f32x4 v[8]; float s = 0.f;
#pragma unroll
        for (int j = 0; j < 8; ++j) { v[j] = __builtin_nontemporal_load(xr + 64 * j); s += (v[j].x * v[j].x + v[j].y * v[j].y) + (v[j].z * v[j].z + v[j].w * v[j].w); }
        s = wave_sum(s);
        if (C.lane < 32) hssq[(size_t)row * 32 + C.lane] = (C.lane == 0) ? s : 0.f;
#pragma unroll
        for (int j = 0; j < 8; ++j) { const int col = 4 * C.lane + 256 * j; const f32x4 y = v[j] * *(const f32x4*)(gs0 + (size_t)cond * DM + col);
            *(unsigned long long*)(U + (size_t)row * DM + col) = (unsigned long long)pk2(y.x, y.y) | ((unsigned long long)pk2(y.z, y.w) << 32); }
    }
}
__device__ __forceinline__ void p0d(ArgsP A, const Ctx& C) { reduce_shw(A, C, 0, 0, false); reduce_shw(A, C, 0, 1, false); }
__device__ __forceinline__ void mkctx(Ctx& C, LAS unsigned char* lds, const int wave) {
    int wv = wave; asm volatile("" : "+s"(wv));
    int t = wv * 64 + (int)__builtin_amdgcn_mbcnt_hi(~0u, __builtin_amdgcn_mbcnt_lo(~0u, 0u)); asm volatile("" : "+v"(t));
    C.lds = lds; C.tid = t; C.lane = t & 63; C.wave = wv;
    C.G = gridDim.x; C.gw = blockIdx.x * NWAVES + C.wave; C.ngw = C.G * NWAVES; C.gt = blockIdx.x * (NWAVES * 64) + t; C.ngt = C.G * NWAVES * 64;
}
__device__ __forceinline__ void m1_phase(ArgsP A, const Ctx& C, int l, float* outw) {
    const bf16* XIN = (const bf16*)(A->ws + WS_XIN); bf16* MIX = (bf16*)(A->ws + WS_MIX);
    const int half_g = C.G / 2, lt = ((int)blockIdx.x - half_g) * (NWAVES * 64) + C.tid, nlt = (C.G - half_g) * NWAVES * 64;
    if ((int)blockIdx.x >= half_g)
    for (int it = lt; it < (MTOK / 4) * 64; it += nlt) {
        const int ch = it & 63, row0 = (it >> 6) * 4, c0 = ch * 8; int t0, T; if (row0 < NCTX) { t0 = row0 & 255; T = SEQ; } else { t0 = (row0 - NCTX) & 2047; T = DSEQ; }
        v4u cg[6], sx[6], sb[4];
#pragma unroll
        for (int j = 0; j < 6; ++j) { const int tt = t0 + j - 1; cg[j] = (v4u){0u, 0u, 0u, 0u}; sx[j] = cg[j];
            if (tt >= 0 && tt < T) { const bf16* rp = XIN + (size_t)(row0 + j - 1) * DIN; cg[j] = *(const v4u*)(rp + C_SCG + c0); sx[j] = *(const v4u*)(rp + C_SX + c0); } }
#pragma unroll
        for (int j = 0; j < 4; ++j) sb[j] = *(const v4u*)(XIN + (size_t)(row0 + j) * DIN + C_SB + c0);
        float w[3][8];
#pragma unroll
        for (int dk = 0; dk < 3; ++dk)
#pragma unroll
            for (int i = 0; i < 8; ++i) w[dk][i] = A->in[I_SCW][(l * 3 + dk) * DSC + c0 + i];
        float z[6][8];
#pragma unroll
        for (int j = 0; j < 6; ++j) { z[j][0] = bflo(cg[j].x) * bflo(sx[j].x); z[j][1] = bfhi(cg[j].x) * bfhi(sx[j].x); z[j][2] = bflo(cg[j].y) * bflo(sx[j].y); z[j][3] = bfhi(cg[j].y) * bfhi(sx[j].y);
            z[j][4] = bflo(cg[j].z) * bflo(sx[j].z); z[j][5] = bfhi(cg[j].z) * bfhi(sx[j].z); z[j][6] = bflo(cg[j].w) * bflo(sx[j].w); z[j][7] = bfhi(cg[j].w) * bfhi(sx[j].w); }
#pragma unroll
        for (int j = 0; j < 4; ++j) { float acc[8];
#pragma unroll
            for (int i = 0; i < 8; ++i) acc[i] = w[0][i] * z[j][i] + w[1][i] * z[j + 1][i] + w[2][i] * z[j + 2][i];
            v4u o; o.x = pk2(bflo(sb[j].x) * acc[0], bfhi(sb[j].x) * acc[1]); o.y = pk2(bflo(sb[j].y) * acc[2], bfhi(sb[j].y) * acc[3]); o.z = pk2(bflo(sb[j].z) * acc[4], bfhi(sb[j].z) * acc[5]); o.w = pk2(bflo(sb[j].w) * acc[6], bfhi(sb[j].w) * acc[7]);
            *(v4u*)(MIX + (size_t)(row0 + j) * DM + 1536 + c0) = o; }
    }
    for (int u = blockIdx.x; u < 256; u += C.G) {
        if (u < 128) lru_unit<false>(A, C, l, NB + (u >> 6), (u >> 3) & 7, (u >> 1) & 3, u & 1, outw);
        else { const int v = u - 128; lru_unit<true>(A, C, l, v >> 3, 0, (v >> 1) & 3, v & 1, outw); }
    }
}
__device__ __forceinline__ void m2_phase(ArgsP A, LAS unsigned char* lds, const int wave0, int l, float* outw) {
    { Ctx C; mkctx(C, lds, wave0);
      for (int u = blockIdx.x; u < 256; u += C.G) { if (u < 128) attn_unit<true>(A, C, l, u, outw); else attn_unit<false>(A, C, l, u - 128, outw); } }
    { Ctx C; mkctx(C, lds, wave0);
      for (int u = (int)((blockIdx.x + (unsigned)C.G - (128u % (unsigned)C.G)) % (unsigned)C.G); u < 128; u += C.G) lru_unit<true>(A, C, l, NB + (u >> 6), (u >> 3) & 7, (u >> 1) & 3, u & 1, outw); }
}

#define PHASE_BEGIN() ArgsP A = (ArgsP)__builtin_amdgcn_kernarg_segment_ptr(); asm volatile("" : "+s"(A)); Ctx C; mkctx(C, (LAS unsigned char*)lds_raw, wave0); \
    float* mod = (float*)(A->ws + WS_MOD); bf16* U = (bf16*)(A->ws + WS_U); bf16* XIN = (bf16*)(A->ws + WS_XIN); bf16* ACT = (bf16*)(A->ws + WS_ACT); bf16* MIX = (bf16*)(A->ws + WS_MIX); \
    float* outw = A->out; (void)mod; (void)U; (void)XIN; (void)ACT; (void)MIX; (void)outw;
__global__ void __launch_bounds__(NWAVES * 64, 2) fwd(Args A_) {
    extern __shared__ __attribute__((aligned(16))) unsigned char lds_raw[];
    const int wave0 = __builtin_amdgcn_readfirstlane((int)threadIdx.x >> 6);
    { const int t0 = threadIdx.x; for (int u = t0; u < (LDS_BYTES - LDSCTL_OFF) / 4; u += NWAVES * 64) ((LAS unsigned*)((LAS unsigned char*)lds_raw + LDSCTL_OFF))[u] = 0u; }
    __syncthreads();
    volatile LAS unsigned* MISC = (volatile LAS unsigned*)((LAS unsigned char*)lds_raw + MISC_OFF);
    unsigned* barw = (unsigned*)(A_.ws + WS_CTL) + CW_BAR;
    XcdBarrier bar; bar.bar = barw; bar.x = 0; bar.st = nullptr;
    if (MK_MODE == 0) bar = xcd_barrier_post(barw, MISC + 8);
    const int lo = A_.ph_lo, hi = A_.ph_hi;
#define IN(k) (lo <= (k) && (k) < hi)
#define SEAM(k) do { if (IN(k) && IN((k) + 1)) xcd_barrier(bar); } while (0)
    if (IN(0)) { PHASE_BEGIN(); p0a(A, C); } SEAM(0);
    if (IN(1)) { PHASE_BEGIN(); p0b(A, C); } SEAM(1);
    if (IN(2)) { PHASE_BEGIN(); p0c(A, C); } SEAM(2);
    if (IN(3)) { PHASE_BEGIN(); p0d(A, C); } SEAM(3);
    for (int l = 0; l < DEPTH; ++l) {
        const int s0 = NPRO + l * STEPS_PER_LAYER;
        if (IN(s0 + 0)) { PHASE_BEGIN();
            pg8::Gemm g{U, (const bf16*)(A->ws + WS_WIN) + (size_t)l * DIN * DM, MTOK, DIN, DM}; pg8::StaticOrder S; S.init(MTOK, DIN, C.G, (int)blockIdx.x);
            const pg8::RstdTab rt = pg8::rstd_table(C.lds, S, (const float*)(A->ws + WS_HSSQ), C.tid);
            pg8::EpiIn E{XIN, (float*)(A->ws + WS_SSQ), outw + OUT_V + (size_t)l * SEQ * DATT, (const float*)(A->ws + WS_HSSQ), (const float*)(A->ws + WS_SHWI) + (size_t)l * 3 * DIN, rt};
            pg8::gemm_phase<pg8::EpiIn, pg8::StaticOrder, false, true>(C.lds + RING_OFF, g, S, E, wave0);
            { const int rem = (MTOK / 256 * (DIN / 256)) % C.G; if (l + 1 < DEPTH && rem && (int)blockIdx.x >= rem) convert_layer(A, C, l + 1, 0, ((int)blockIdx.x - rem) * NWAVES + C.wave, (C.G - rem) * NWAVES); }
        } SEAM(s0 + 0);
        if (IN(s0 + 1)) { PHASE_BEGIN(); if ((int)blockIdx.x < C.G / 2) { if (l + 1 < DEPTH) reduce_shw(A, C, l + 1, 0); if (l >= 1) reduce_shw(A, C, l, 1); } m1_phase(A, C, l, outw); m2_phase(A, (LAS unsigned char*)lds_raw, wave0, l, outw); } SEAM(s0 + 1);
        if (IN(s0 + 2)) { PHASE_BEGIN();
            pg8::Gemm g{MIX, (const bf16*)(A->ws + WS_WOUT) + (size_t)l * DM * DM, MTOK, DM, DM}; pg8::StaticOrder S; S.init(MTOK, DM, C.G, (int)blockIdx.x);
            bf16* HB = (bf16*)(A->ws + WS_HB);
            pg8::EpiRes E{A->in[I_XP], A->in[I_XS], (l == 0) ? (const bf16*)nullptr : (const bf16*)HB, nullptr, HB, mod + (size_t)l * 3 * 12288 + 4096, (const float*)(A->ws + WS_GS) + ((size_t)l * 2 + 1) * 3 * DM, U, (float*)(A->ws + WS_HSSQ)};
            pg8::gemm_phase<pg8::EpiRes, pg8::StaticOrder, true, true>(C.lds + RING_OFF, g, S, E, wave0);
        } SEAM(s0 + 2);
        if (IN(s0 + 3)) { PHASE_BEGIN();
            pg8::Gemm g{U, (const bf16*)(A->ws + WS_WGU) + (size_t)l * 2 * DFF * DM, MTOK, 2 * DFF, DM}; pg8::StaticOrder S; S.init(MTOK, 2 * DFF, C.G, (int)blockIdx.x);
            const pg8::RstdTab rt = pg8::rstd_table(C.lds, S, (const float*)(A->ws + WS_HSSQ), C.tid);
            pg8::EpiSwiGLU E{ACT, (const float*)(A->ws + WS_HSSQ), (const float*)(A->ws + WS_SHWG) + (size_t)l * 3 * 2 * DFF, rt};
            pg8::gemm_phase<pg8::EpiSwiGLU, pg8::StaticOrder, false, true>(C.lds + RING_OFF, g, S, E, wave0);
            { const int rem = (MTOK / 256 * (2 * DFF / 256)) % C.G; if (l + 1 < DEPTH && rem && (int)blockIdx.x >= rem) convert_layer(A, C, l + 1, 1, ((int)blockIdx.x - rem) * NWAVES + C.wave, (C.G - rem) * NWAVES); }
        } SEAM(s0 + 3);
        if (IN(s0 + 4)) { PHASE_BEGIN();
            pg8::Gemm g{ACT, (const bf16*)(A->ws + WS_WDN) + (size_t)l * DM * DFF, MTOK, DM, DFF}; pg8::StaticOrder S; S.init(MTOK, DM, C.G, (int)blockIdx.x);
            bf16* HB = (bf16*)(A->ws + WS_HB); const bool last = (l + 1 == DEPTH);
            pg8::EpiRes E{nullptr, nullptr, HB, outw, last ? (bf16*)nullptr : HB, mod + (size_t)l * 3 * 12288 + 10240, last ? (const float*)nullptr : (const float*)(A->ws + WS_GS) + ((size_t)(l + 1) * 2 + 0) * 3 * DM, U, (float*)(A->ws + WS_HSSQ)};
            pg8::gemm_phase<pg8::EpiRes, pg8::StaticOrder, true, true>(C.lds + RING_OFF, g, S, E, wave0);
        } SEAM(s0 + 4);
    }
#undef IN
#undef SEAM
}

extern "C" void kernel_launch(void* const* d_in, const int* in_sizes, int n_in, void* d_out, int out_size, void* d_ws, size_t ws_size, hipStream_t stream) {
    static int grid = 0;
    if (grid == 0) {
        if (n_in != 27 || (size_t)out_size != OUT_END || ws_size < WS_END3) { fprintf(stderr, "kernel_launch: shape mismatch: n_in %d out %d ws %zu (need 27, %zu, >= %zu)\n", n_in, out_size, ws_size, (size_t)OUT_END, (size_t)WS_END3); grid = -1; return; }
        int dev = 0, cus = 0, per_cu = 0;
        if (hipGetDevice(&dev) != hipSuccess || hipDeviceGetAttribute(&cus, hipDeviceAttributeMultiprocessorCount, dev) != hipSuccess) { fprintf(stderr, "kernel_launch: device query failed\n"); grid = -1; return; }
        if (hipFuncSetAttribute((const void*)fwd, hipFuncAttributeMaxDynamicSharedMemorySize, LDS_BYTES) != hipSuccess) { fprintf(stderr, "kernel_launch: hipFuncSetAttribute failed\n"); grid = -1; return; }
        if (hipOccupancyMaxActiveBlocksPerMultiprocessor(&per_cu, (const void*)fwd, NWAVES * 64, LDS_BYTES) != hipSuccess || per_cu < 1) fprintf(stderr, "kernel_launch: note: occupancy query reports %d workgroups per CU\n", per_cu);
        (void)hipGetLastError();
        grid = cus;
    }
    if (grid < 0) return;
    if (hipMemsetAsync((char*)d_ws + WS_CTL, 0, CTL_ZERO_BYTES, stream) != hipSuccess) { fprintf(stderr, "kernel_launch: memset failed\n"); return; }
    Args a{};
    for (int i = 0; i < 27; ++i) a.in[i] = (const float*)d_in[i];
    a.out = (float*)d_out; a.ws = (unsigned char*)d_ws;
#if MK_MODE == 0
    a.ph_lo = 0; a.ph_hi = NSTEPS;
    hipLaunchKernelGGL(fwd, dim3(grid), dim3(NWAVES * 64), LDS_BYTES, stream, a);
#else
    for (int s = 0; s < NSTEPS; ++s) { a.ph_lo = s; a.ph_hi = s + 1; hipLaunchKernelGGL(fwd, dim3(grid), dim3(NWAVES * 64), LDS_BYTES, stream, a); }
#endif
    const hipError_t le = hipPeekAtLastError();
    if (le != hipSuccess) fprintf(stderr, "kernel_launch: launch failed: %s\n", hipGetErrorName(le));
}
```

```cpp
#include <hip/hip_runtime.h>
#include <cstdio>
#include <cstdint>
namespace pg8 {
#define PG8_LAS __attribute__((address_space(3)))
typedef unsigned short bf16_t;
typedef short bf16x8 __attribute__((ext_vector_type(8)));
typedef float f32x4 __attribute__((ext_vector_type(4)));
typedef unsigned u32x4 __attribute__((ext_vector_type(4)));
constexpr int BM = 256, BK = 64, HALF = 128, HTB = HALF * BK * 2  , STAGE_BYTES = 8 * HTB, NXCD = 8, WGM = 8;

__host__ __device__ __forceinline__ int lds_byte(int r, int c) { const int st = (r >> 4) * 2 + (c >> 5), rr = r & 15, cc = c & 31, ob = rr * 64 + cc * 2; return st * 1024 + (ob ^ (((ob >> 9) & 1) << 5)); }
__host__ __device__ __forceinline__ void stage_rc(int b, int& R, int& C) { const int st = b / 1024, sb = b % 1024, swz = sb ^ (((sb >> 9) & 1) << 5); R = (st >> 1) * 16 + swz / 64; C = (st & 1) * 32 + (swz % 64) / 2; }
__host__ __device__ __forceinline__ int perm32(int rho) { const int n = rho >> 4, i = rho & 15; return 8 * (i >> 2) + 4 * n + (i & 3); }

struct Unit { int pm, pn; };
struct Gemm { const bf16_t* A; const bf16_t* Bt; int M, N, K; };

struct StaticOrder {
    int nM, nN, nwg, G, c;
    __host__ __device__ void init(int M, int N, int G_, int c_) { nM = M / BM; nN = N / BM; nwg = nM * nN; G = G_; c = c_; }
    __host__ __device__ bool next(int i, Unit& u) const {
        const long L = (long)i * G + c; if (L >= nwg) return false;
        int wgid = (int)L; { const int q = nwg / NXCD, r = nwg % NXCD, xcd = wgid % NXCD, off = wgid / NXCD; wgid = (xcd < r ? xcd * (q + 1) : r * (q + 1) + (xcd - r) * q) + off; }
        const int nig = WGM * nN, gid = wgid / nig, fm = gid * WGM, gsz = (nM - fm) < WGM ? (nM - fm) : WGM;
        u.pm = fm + ((wgid % nig) % gsz); u.pn = (wgid % nig) / gsz; return true;
    }
    __device__ __forceinline__ void a_ready(const Unit&) const {}
    __device__ __forceinline__ void done(const Unit&) const {}
};

__device__ __forceinline__ void st16(void* p, u32x4 v) { *(u32x4*)p = v; }
__device__ __forceinline__ unsigned cvt_pk_bf16(float lo, float hi) { unsigned r; asm volatile("v_cvt_pk_bf16_f32 %0, %1, %2" : "=v"(r) : "v"(lo), "v"(hi)); return r; }

__device__ __forceinline__ float xl16_sum(float s) { s += __builtin_bit_cast(float, __builtin_amdgcn_ds_swizzle(__builtin_bit_cast(int, s), 0x401f)); float a_ = s, b_ = s; asm volatile("s_nop 1\n\tv_permlane32_swap_b32 %0, %1\n\ts_nop 1" : "+v"(a_), "+v"(b_)); return a_ + b_; }
__device__ __forceinline__ void row_rstd(const float* hssq, int row0, int fq, float (&rs)[2][4]) {
#pragma unroll
    for (int ai = 0; ai < 2; ++ai) { f32x4 p[4][2];
#pragma unroll
        for (int m = 0; m < 4; ++m) { const float* hp = hssq + (size_t)(row0 + ai * HALF + m * 16) * 32 + fq * 8; p[m][0] = *(const f32x4*)hp; p[m][1] = *(const f32x4*)(hp + 4); }
#pragma unroll
        for (int m = 0; m < 4; ++m) { const f32x4 q = p[m][0] + p[m][1]; const float t = xl16_sum((q[0] + q[1]) + (q[2] + q[3])); rs[ai][m] = 1.0f / sqrtf(t * (1.0f / 2048.0f) + 1e-6f); } }
}
constexpr int RTAB_OFF = STAGE_BYTES, RTAB_ROWS = 3840;
struct RstdTab { const PG8_LAS float* tab; int row_lo; bool ok; };
template <class Sched>
__device__ __forceinline__ RstdTab rstd_table(PG8_LAS unsigned char* lds, const Sched& S, const float* hssq, int tid) {
    int lo = 1 << 30, hi = -1; Unit u; for (int i = 0; S.next(i, u); ++i) { lo = u.pm < lo ? u.pm : lo; hi = u.pm > hi ? u.pm : hi; }
    RstdTab T; T.tab = (const PG8_LAS float*)(lds + RTAB_OFF); T.row_lo = lo * BM; T.ok = (hi >= lo) && ((hi - lo + 1) * BM <= RTAB_ROWS);
    if (T.ok) { PG8_LAS float* tw = (PG8_LAS float*)(lds + RTAB_OFF); const int nrows = (hi - lo + 1) * BM;
        for (int r = tid; r < nrows; r += 512) { const f32x4* hp = (const f32x4*)(hssq + (size_t)(T.row_lo + r) * 32); f32x4 q = hp[0];
#pragma unroll
            for (int j = 1; j < 8; ++j) q += hp[j];
            tw[r] = 1.0f / sqrtf(((q[0] + q[1]) + (q[2] + q[3])) * (1.0f / 2048.0f) + 1e-6f); } }
    __syncthreads();
    return T;
}
__device__ __forceinline__ void get_rstd(const RstdTab& T, const float* hssq, int row0, int fq, float (&rs)[2][4]) {
    if (T.ok) {
#pragma unroll
        for (int ai = 0; ai < 2; ++ai)
#pragma unroll
            for (int m = 0; m < 4; ++m) rs[ai][m] = T.tab[row0 + ai * HALF + m * 16 - T.row_lo];
    } else row_rstd(hssq, row0, fq, rs);
}
struct EpiIn {
    static constexpr bool PERM = true, AFTER_DRAIN = false;
    bf16_t* O; float* ssq; float* vout; const float* hssq; const float* shw; RstdTab rt;
    __device__ __forceinline__ void operator()(const f32x4 (&acc)[2][2][4][2], const Unit& u, int wr, int wc, int fr, int fq) const {
        const int row0 = u.pm * BM + wr * 64 + fr, col0 = u.pn * BM + wc * 32 + 8 * fq;
        const int cond = u.pm < 16 ? 0 : (u.pm < 24 ? 1 : 2);
        float rs[2][4]; get_rstd(rt, hssq, row0, fq, rs);
        f32x4 bv[2][2];
#pragma unroll
        for (int bj = 0; bj < 2; ++bj)
#pragma unroll
            for (int n = 0; n < 2; ++n) bv[bj][n] = *(const f32x4*)(shw + (size_t)cond * 5632 + col0 + bj * HALF + 4 * n);
#pragma unroll
        for (int ai = 0; ai < 2; ++ai)
#pragma unroll
            for (int m = 0; m < 4; ++m) { const int row = row0 + ai * HALF + m * 16; bf16_t* rowp = O + (size_t)row * 5632 + col0;
#pragma unroll
                for (int bj = 0; bj < 2; ++bj) { const f32x4 v0 = acc[ai][bj][m][0] * rs[ai][m] + bv[bj][0], v1 = acc[ai][bj][m][1] * rs[ai][m] + bv[bj][1];
                    u32x4 w; w.x = cvt_pk_bf16(v0[0], v0[1]); w.y = cvt_pk_bf16(v0[2], v0[3]); w.z = cvt_pk_bf16(v1[0], v1[1]); w.w = cvt_pk_bf16(v1[2], v1[3]);
                    st16(rowp + bj * HALF, w); } }
    }
};
struct EpiRes {
    static constexpr bool PERM = true, AFTER_DRAIN = false;
    const float* x_lo; const float* x_hi; const bf16_t* hb_in;
    float* y; bf16_t* hb_out;
    const float* gate;
    const float* gsn; bf16_t* un; float* hssq;
    __device__ __forceinline__ void operator()(const f32x4 (&acc)[2][2][4][2], const Unit& u, int wr, int wc, int fr, int fq) const {
        const int row0 = u.pm * BM + wr * 64 + fr, col0 = u.pn * BM + wc * 32 + 8 * fq;
        const int cond = u.pm < 16 ? 0 : (u.pm < 24 ? 1 : 2);
        f32x4 gv[2][2], gs[2][2];
#pragma unroll
        for (int bj = 0; bj < 2; ++bj)
#pragma unroll
            for (int n = 0; n < 2; ++n) { gv[bj][n] = *(const f32x4*)(gate + (size_t)cond * 12288 + col0 + bj * HALF + 4 * n);
                gs[bj][n] = gsn ? *(const f32x4*)(gsn + (size_t)cond * 2048 + col0 + bj * HALF + 4 * n) : (f32x4){0.f, 0.f, 0.f, 0.f}; }
#pragma unroll
        for (int ai = 0; ai < 2; ++ai)
#pragma unroll
            for (int m = 0; m < 4; ++m) { const int row = row0 + ai * HALF + m * 16; const size_t off = (size_t)row * 2048 + col0;
                float s = 0.f;
#pragma unroll
                for (int bj = 0; bj < 2; ++bj) { f32x4 b0, b1;
                    if (hb_in) { const u32x4 w = *(const u32x4*)(hb_in + off + bj * HALF);
                        b0 = (f32x4){__builtin_bit_cast(float, w.x << 16), __builtin_bit_cast(float, w.x & 0xffff0000u), __builtin_bit_cast(float, w.y << 16), __builtin_bit_cast(float, w.y & 0xffff0000u)};
                        b1 = (f32x4){__builtin_bit_cast(float, w.z << 16), __builtin_bit_cast(float, w.z & 0xffff0000u), __builtin_bit_cast(float, w.w << 16), __builtin_bit_cast(float, w.w & 0xffff0000u)}; }
                    else { const float* bp = (u.pm < 16) ? x_lo + off : x_hi + (off - (size_t)4096 * 2048); b0 = __builtin_nontemporal_load((const f32x4*)(bp + bj * HALF)); b1 = __builtin_nontemporal_load((const f32x4*)(bp + bj * HALF + 4)); }
                    const f32x4 o0 = b0 + gv[bj][0] * acc[ai][bj][m][0], o1 = b1 + gv[bj][1] * acc[ai][bj][m][1];
                    if (hb_out) { u32x4 w; w.x = cvt_pk_bf16(o0[0], o0[1]); w.y = cvt_pk_bf16(o0[2], o0[3]); w.z = cvt_pk_bf16(o1[0], o1[1]); w.w = cvt_pk_bf16(o1[2], o1[3]); st16(hb_out + off + bj * HALF, w); }
                    else { __builtin_nontemporal_store(o0, (f32x4*)(y + off + bj * HALF)); __builtin_nontemporal_store(o1, (f32x4*)(y + off + bj * HALF + 4)); }
                    if (gsn) { const f32x4 q = o0 * o0 + o1 * o1; s += (q[0] + q[1]) + (q[2] + q[3]);
                        const f32x4 a0 = o0 * gs[bj][0], a1 = o1 * gs[bj][1];
                        u32x4 w; w.x = cvt_pk_bf16(a0[0], a0[1]); w.y = cvt_pk_bf16(a0[2], a0[3]); w.z = cvt_pk_bf16(a1[0], a1[1]); w.w = cvt_pk_bf16(a1[2], a1[3]); st16(un + off + bj * HALF, w); } }
                if (gsn) { s = xl16_sum(s); if (fq == 0) hssq[(size_t)row * 32 + u.pn * 4 + wc] = s; } }
    }
};
__device__ __forceinline__ float silu_f(float g) { return g * __builtin_amdgcn_rcpf(1.0f + __builtin_amdgcn_exp2f(-1.4426950408889634f * g)); }
struct EpiSwiGLU {
    static constexpr bool PERM = true, AFTER_DRAIN = false;
    bf16_t* O; const float* hssq; const float* shw; RstdTab rt;
    __device__ __forceinline__ void operator()(const f32x4 (&acc)[2][2][4][2], const Unit& u, int wr, int wc, int fr, int fq) const {
        const int row0 = u.pm * BM + wr * 64 + fr, col0 = u.pn * HALF + wc * 32 + 8 * fq, bcol0 = u.pn * BM + wc * 32 + 8 * fq;
        const int cond = u.pm < 16 ? 0 : (u.pm < 24 ? 1 : 2);
        float rs[2][4]; get_rstd(rt, hssq, row0, fq, rs);
        f32x4 bv[2][2];
#pragma unroll
        for (int bj = 0; bj < 2; ++bj)
#pragma unroll
            for (int n = 0; n < 2; ++n) bv[bj][n] = *(const f32x4*)(shw + (size_t)cond * 11264 + bcol0 + bj * HALF + 4 * n);
        const float NL2E = -1.4426950408889634f;
        const f32x4 bl0 = bv[0][0] * NL2E, bl1 = bv[0][1] * NL2E;
#pragma unroll
        for (int ai = 0; ai < 2; ++ai)
#pragma unroll
            for (int m = 0; m < 4; ++m) { const float r = rs[ai][m], rl = r * NL2E;
                const f32x4 g0 = acc[ai][0][m][0] * r + bv[0][0], g1 = acc[ai][0][m][1] * r + bv[0][1], u0 = acc[ai][1][m][0] * r + bv[1][0], u1 = acc[ai][1][m][1] * r + bv[1][1];
                const f32x4 t0 = acc[ai][0][m][0] * rl + bl0, t1 = acc[ai][0][m][1] * rl + bl1;
                const f32x4 e0 = {__builtin_amdgcn_exp2f(t0[0]), __builtin_amdgcn_exp2f(t0[1]), __builtin_amdgcn_exp2f(t0[2]), __builtin_amdgcn_exp2f(t0[3])};
                const f32x4 e1 = {__builtin_amdgcn_exp2f(t1[0]), __builtin_amdgcn_exp2f(t1[1]), __builtin_amdgcn_exp2f(t1[2]), __builtin_amdgcn_exp2f(t1[3])};
                const f32x4 d0 = e0 + 1.0f, d1 = e1 + 1.0f;
                const f32x4 q0 = {__builtin_amdgcn_rcpf(d0[0]), __builtin_amdgcn_rcpf(d0[1]), __builtin_amdgcn_rcpf(d0[2]), __builtin_amdgcn_rcpf(d0[3])};
                const f32x4 q1 = {__builtin_amdgcn_rcpf(d1[0]), __builtin_amdgcn_rcpf(d1[1]), __builtin_amdgcn_rcpf(d1[2]), __builtin_amdgcn_rcpf(d1[3])};
                const f32x4 p0 = (g0 * u0) * q0, p1 = (g1 * u1) * q1;
                u32x4 w; w.x = cvt_pk_bf16(p0[0], p0[1]); w.y = cvt_pk_bf16(p0[2], p0[3]); w.z = cvt_pk_bf16(p1[0], p1[1]); w.w = cvt_pk_bf16(p1[2], p1[3]);
                st16(O + (size_t)(row0 + ai * HALF + m * 16) * 5632 + col0, w); }
    }
};

template <class Epi, class Sched, bool ALIGN_EPI = false, bool SP2 = false>
__device__ __forceinline__ void gemm_phase(PG8_LAS unsigned char* lds, const Gemm g, const Sched& S, const Epi& E, const int wave_id  ) {
    int wv_ = wave_id; asm volatile("" : "+s"(wv_));
    int tid_ = wv_ * 64 + (int)__builtin_amdgcn_mbcnt_hi(~0u, __builtin_amdgcn_mbcnt_lo(~0u, 0u)); asm volatile("" : "+v"(tid_));
    const int tid = tid_, wid = wv_, lane = tid & 63, wr = wid >> 2, wc = wid & 3, fr = lane & 15, fq = lane >> 4;
    const int K = g.K, nt = K / BK;
    unsigned voffA[2], voffB[2];
#pragma unroll
    for (int i = 0; i < 2; ++i) { int R, C; stage_rc(tid * 16 + i * 8192, R, C); const int Rb = Epi::PERM ? ((R & ~31) + perm32(R & 31)) : R;
        voffA[i] = (unsigned)(R * K + C) * 2u; voffB[i] = (unsigned)(Rb * K + C) * 2u; }
    const size_t kstep = (size_t)(BK * 2);
    const size_t hstep = (size_t)HALF * K * 2;
    const size_t tstep = 2 * hstep;
    const unsigned ldsw = (unsigned)wid * 1024u;
    const int aoff = lds_byte(wr * 64 + fr, fq * 8), boff = lds_byte(wc * 32 + fr, fq * 8);
#define PG8_SA(b, h) (((b) * 2 + (h)) * HTB)
#define PG8_SB(b, h) ((4 + (b) * 2 + (h)) * HTB)
#define PG8_STAGE(bufoff, gbase, voff) do { _Pragma("unroll") for (int _i = 0; _i < 2; ++_i) \
        __builtin_amdgcn_global_load_lds((const unsigned*)((const char*)(gbase) + (voff)[_i]), (PG8_LAS unsigned*)(lds + (bufoff) + ldsw + _i * 8192), 16, 0, 0); } while (0)
#define PG8_LDA(dst, b, h) do { _Pragma("unroll") for (int m = 0; m < 4; ++m) _Pragma("unroll") for (int k = 0; k < 2; ++k) dst[m][k] = *(const PG8_LAS bf16x8*)(lds + PG8_SA(b, h) + aoff + m * 2048 + k * 1024); } while (0)
#define PG8_LDB(dst, b, h) do { _Pragma("unroll") for (int n = 0; n < 2; ++n) _Pragma("unroll") for (int k = 0; k < 2; ++k) dst[n][k] = *(const PG8_LAS bf16x8*)(lds + PG8_SB(b, h) + boff + n * 2048 + k * 1024); } while (0)
#define PG8_MMA(ai, bj, At, Bt) do { __builtin_amdgcn_s_setprio(1); _Pragma("unroll") for (int m = 0; m < 4; ++m) _Pragma("unroll") for (int n = 0; n < 2; ++n) _Pragma("unroll") for (int k = 0; k < 2; ++k) \
        acc[ai][bj][m][n] = __builtin_amdgcn_mfma_f32_16x16x32_bf16(Bt[n][k], At[m][k], acc[ai][bj][m][n], 0, 0, 0); __builtin_amdgcn_s_setprio(0); } while (0)
#define PG8_WAIT_V(n) asm volatile("s_waitcnt vmcnt(" #n ")" ::: "memory")
#define PG8_WAIT_L(n) asm volatile("s_waitcnt lgkmcnt(" #n ")" ::: "memory")
#define PG8_BAR __builtin_amdgcn_s_barrier()
#define PG8_SCHED __builtin_amdgcn_sched_barrier(0)
    Unit cur, nxt; int ui = 0;
    if (!S.next(0, cur)) return;
    f32x4 acc[2][2][4][2];
#pragma unroll
    for (int a = 0; a < 2; ++a)
#pragma unroll
        for (int b = 0; b < 2; ++b)
#pragma unroll
            for (int m = 0; m < 4; ++m)
#pragma unroll
                for (int n = 0; n < 2; ++n) acc[a][b][m][n] = (f32x4){0.f, 0.f, 0.f, 0.f};
    bf16x8 At[4][2], B0[2][2], B1[2][2];
    const char* cA = (const char*)g.A + (size_t)cur.pm * tstep; const char* cB = (const char*)g.Bt + (size_t)cur.pn * tstep;
    S.a_ready(cur);
    if constexpr (SP2) {
        PG8_STAGE(PG8_SB(0, 0), cB, voffB); PG8_STAGE(PG8_SB(0, 1), cB + hstep, voffB); PG8_STAGE(PG8_SA(0, 0), cA, voffA); PG8_STAGE(PG8_SA(0, 1), cA + hstep, voffA);
        if (wr == 1) PG8_BAR;
        PG8_WAIT_V(2); PG8_BAR;
        PG8_STAGE(PG8_SB(1, 0), cB + kstep, voffB); PG8_STAGE(PG8_SA(1, 0), cA + kstep, voffA); PG8_STAGE(PG8_SB(1, 1), cB + hstep + kstep, voffB);
        PG8_WAIT_V(6); PG8_BAR;
    } else {
        PG8_STAGE(PG8_SB(0, 0), cB, voffB); PG8_STAGE(PG8_SA(0, 0), cA, voffA); PG8_STAGE(PG8_SB(0, 1), cB + hstep, voffB); PG8_STAGE(PG8_SA(0, 1), cA + hstep, voffA);
        if (wr == 1) PG8_BAR;
        PG8_WAIT_V(4); PG8_BAR;
        PG8_STAGE(PG8_SB(1, 0), cB + kstep, voffB); PG8_STAGE(PG8_SA(1, 0), cA + kstep, voffA); PG8_STAGE(PG8_SB(1, 1), cB + hstep + kstep, voffB);
        PG8_WAIT_V(6); PG8_BAR;
    }
    for (;;) {
        const bool has_next = S.next(ui + 1, nxt);
        const char* nA = has_next ? (const char*)g.A + (size_t)nxt.pm * tstep : cA; const char* nB = has_next ? (const char*)g.Bt + (size_t)nxt.pn * tstep : cB;
        for (int t = 0; t < nt; t += 2) {
            const bool last = (t == nt - 2);
            const char* a1 = cA + (size_t)(t + 1) * kstep;
            const char* a2 = last ? nA : cA + (size_t)(t + 2) * kstep; const char* b2 = last ? nB : cB + (size_t)(t + 2) * kstep;
            const char* a3 = a2 + kstep; const char* b3 = b2 + kstep;
            if (last && has_next) S.a_ready(nxt);
            if constexpr (SP2) {
            PG8_LDB(B0, 0, 0); PG8_LDB(B1, 0, 1); PG8_SCHED; PG8_LDA(At, 0, 0); PG8_STAGE(PG8_SA(1, 1), a1 + hstep, voffA);
            PG8_WAIT_V(8); PG8_WAIT_L(0); PG8_BAR; PG8_MMA(0, 0, At, B0); PG8_MMA(0, 1, At, B1); PG8_BAR; PG8_SCHED;
            PG8_LDA(At, 0, 1); PG8_STAGE(PG8_SB(0, 0), b2, voffB); PG8_STAGE(PG8_SB(0, 1), b2 + hstep, voffB); PG8_STAGE(PG8_SA(0, 0), a2, voffA);
            PG8_WAIT_V(8); PG8_WAIT_L(0); PG8_BAR; PG8_MMA(1, 0, At, B0); PG8_MMA(1, 1, At, B1); PG8_BAR; PG8_SCHED;
            PG8_LDB(B0, 1, 0); PG8_LDB(B1, 1, 1); PG8_SCHED; PG8_LDA(At, 1, 0); PG8_STAGE(PG8_SA(0, 1), a2 + hstep, voffA);
            PG8_WAIT_V(8); PG8_WAIT_L(0); PG8_BAR; PG8_MMA(0, 0, At, B0); PG8_MMA(0, 1, At, B1); PG8_BAR; PG8_SCHED;
            PG8_LDA(At, 1, 1); PG8_STAGE(PG8_SB(1, 0), b3, voffB); PG8_STAGE(PG8_SB(1, 1), b3 + hstep, voffB); PG8_STAGE(PG8_SA(1, 0), a3, voffA);
            PG8_WAIT_V(8); PG8_WAIT_L(0); PG8_BAR; PG8_MMA(1, 0, At, B0); PG8_MMA(1, 1, At, B1); PG8_BAR; PG8_SCHED;
            } else {
            PG8_LDB(B0, 0, 0); PG8_SCHED; PG8_LDA(At, 0, 0); PG8_STAGE(PG8_SA(1, 1), a1 + hstep, voffA);
            PG8_WAIT_L(8); PG8_BAR; PG8_WAIT_L(0); PG8_MMA(0, 0, At, B0); PG8_BAR; PG8_SCHED;
            PG8_LDB(B1, 0, 1); PG8_STAGE(PG8_SB(0, 0), b2, voffB);
            PG8_BAR; PG8_WAIT_L(0); PG8_MMA(0, 1, At, B1); PG8_BAR;
            PG8_LDA(At, 0, 1); PG8_STAGE(PG8_SA(0, 0), a2, voffA);
            PG8_BAR; PG8_WAIT_L(0); PG8_MMA(1, 0, At, B0); PG8_BAR; PG8_SCHED;
            PG8_STAGE(PG8_SB(0, 1), b2 + hstep, voffB);
            PG8_WAIT_V(6); PG8_BAR; PG8_MMA(1, 1, At, B1); PG8_BAR;
            PG8_LDB(B0, 1, 0); PG8_SCHED; PG8_LDA(At, 1, 0); PG8_STAGE(PG8_SA(0, 1), a2 + hstep, voffA);
            PG8_WAIT_L(8); PG8_BAR; PG8_WAIT_L(0); PG8_MMA(0, 0, At, B0); PG8_BAR; PG8_SCHED;
            PG8_LDB(B1, 1, 1); PG8_STAGE(PG8_SB(1, 0), b3, voffB);
            PG8_BAR; PG8_WAIT_L(0); PG8_MMA(0, 1, At, B1); PG8_BAR;
            PG8_LDA(At, 1, 1); PG8_STAGE(PG8_SA(1, 0), a3, voffA);
            PG8_BAR; PG8_WAIT_L(0); PG8_MMA(1, 0, At, B0); PG8_BAR; PG8_SCHED;
            PG8_STAGE(PG8_SB(1, 1), b3 + hstep, voffB);
            PG8_WAIT_V(6); PG8_BAR; PG8_MMA(1, 1, At, B1); PG8_BAR;
            }
        }
        if constexpr (ALIGN_EPI) { if (wr == 0) PG8_BAR; }
        if constexpr (!Epi::AFTER_DRAIN) { E(acc, cur, wr, wc, fr, fq); S.done(cur); }
        if (!has_next) break;
#pragma unroll
        for (int a = 0; a < 2; ++a)
#pragma unroll
            for (int b = 0; b < 2; ++b)
#pragma unroll
                for (int m = 0; m < 4; ++m)
#pragma unroll
                    for (int n = 0; n < 2; ++n) acc[a][b][m][n] = (f32x4){0.f, 0.f, 0.f, 0.f};
        cur = nxt; cA = nA; cB = nB; ++ui;
        if constexpr (ALIGN_EPI) { if (wr == 1) PG8_BAR; }
    }
    PG8_WAIT_V(0);
    if constexpr (!ALIGN_EPI) { if (wr == 0) PG8_BAR; }
    PG8_BAR;
    if constexpr (Epi::AFTER_DRAIN) { E.fused(acc, cur, wr, wc, fr, fq, lds, wid, lane); S.done(cur); }
#undef PG8_SA
#undef PG8_SB
#undef PG8_STAGE
#undef PG8_LDA
#undef PG8_LDB
#undef PG8_MMA
#undef PG8_WAIT_V
#undef PG8_WAIT_L
#undef PG8_BAR
#undef PG8_SCHED
}
}

constexpr int DM = 2048, NCTX = 4096, NLAT = 4096, MTOK = 8192, DEPTH = 4, SEQ = 256, DSEQ = 2048, NB = 16, DB = 2;
constexpr int DIN = 5632, DFF = 5632, DATT = 1024, DLRU = 512, DSC = 512, NH = 8, HD = 128, GW = 64;
constexpr int C_Q = 0, C_K = 1024, C_V = 2048, C_LX = 3072, C_LY = 3584, C_SB = 4096, C_SCG = 4608, C_SX = 5120;
constexpr float EPS = 1e-6f;
constexpr int NWAVES = 8;
#ifndef MK_MODE
#define MK_MODE 0
#endif
constexpr int STEPS_PER_LAYER = 5, NPRO = 4, NSTEPS = NPRO + DEPTH * STEPS_PER_LAYER;

constexpr size_t OUT_Y = 0, OUT_K = (size_t)MTOK * DM, OUT_V = OUT_K + (size_t)NB * DEPTH * SEQ * DATT, OUT_S = OUT_V + (size_t)NB * DEPTH * SEQ * DATT, OUT_END = OUT_S + (size_t)NB * DEPTH * 2 * DLRU;

constexpr size_t MiB = 1u << 20;
constexpr size_t WS_CTL = 0, CTL_ZERO_BYTES = 1 * MiB;
constexpr size_t WS_MOD  = 1 * MiB;
constexpr size_t WS_MODP = 2 * MiB;
constexpr size_t WS_WIN  = 24 * MiB;
constexpr size_t WS_WOUT = WS_WIN + (size_t)DEPTH * DIN * DM * 2;
constexpr size_t WS_WGU  = WS_WOUT + (size_t)DEPTH * DM * DM * 2;
constexpr size_t WS_WDN  = WS_WGU + (size_t)DEPTH * 2 * DFF * DM * 2;
constexpr size_t WS_U    = WS_WDN + (size_t)DEPTH * DM * DFF * 2;
constexpr size_t WS_XIN  = WS_U + (size_t)MTOK * DM * 2;
constexpr size_t WS_ACT  = WS_XIN;
constexpr size_t WS_MIX  = WS_XIN + (size_t)MTOK * DIN * 2;
constexpr size_t WS_SSQ  = WS_MIX + (size_t)MTOK * DM * 2;
constexpr size_t WS_END  = WS_SSQ + (size_t)MTOK * 64 * 4;
constexpr int CW_BAR = 4096;

constexpr int RING_OFF = 0, RING_BYTES = 131072, LDS_BYTES = 147456, LDSCTL_OFF = LDS_BYTES - 512  , MISC_OFF = LDSCTL_OFF + 320;

#define GAS __attribute__((address_space(1)))
#define LAS __attribute__((address_space(3)))
typedef unsigned short bf16;
typedef unsigned v4u __attribute__((ext_vector_type(4)));
typedef float f32x4 __attribute__((ext_vector_type(4)));
typedef GAS unsigned gu32;
#define RLX_AGENT __ATOMIC_RELAXED, __HIP_MEMORY_SCOPE_AGENT
#define LDS_WAIT() asm volatile("s_waitcnt lgkmcnt(0)" ::: "memory")
#define VM_WAIT() asm volatile("s_waitcnt vmcnt(0)" ::: "memory")
__device__ __forceinline__ unsigned f2bf(float f) { unsigned u = __builtin_bit_cast(unsigned, f); return (u + 0x7fffu + ((u >> 16) & 1u)) >> 16; }
__device__ __forceinline__ unsigned pk2(float lo, float hi) { return f2bf(lo) | (f2bf(hi) << 16); }
__device__ __forceinline__ float bflo(unsigned w) { return __builtin_bit_cast(float, w << 16); }
__device__ __forceinline__ float bfhi(unsigned w) { return __builtin_bit_cast(float, w & 0xffff0000u); }
__device__ __forceinline__ float bf2f(bf16 b) { return __builtin_bit_cast(float, ((unsigned)b) << 16); }

#define XB_TMO      128
#define XB_XCNT(j)  (256  + 64 * (j))
#define XB_XSUB(j)  (1280 + 64 * (j))
#define XB_XGEN(j)  (2304 + 64 * (j))
#define XB_TOP      3328
#define XB_TOPGEN   3392
#define XCD_BAR_WORDS 3456
#define XB_SPIN_CAP (1u << 18)

__device__ __forceinline__ unsigned xb_ld(unsigned* p)              { return __hip_atomic_load(p, __ATOMIC_RELAXED, __HIP_MEMORY_SCOPE_AGENT); }
__device__ __forceinline__ unsigned xb_add(unsigned* p, unsigned v) { return __hip_atomic_fetch_add(p, v, __ATOMIC_RELAXED, __HIP_MEMORY_SCOPE_AGENT); }
__device__ __forceinline__ unsigned xb_xcc_id() { return (unsigned)__builtin_amdgcn_s_getreg((3 << 11) | 20) & 0xFu; }
#define XB_SPIN(cond, bar) do { unsigned _sp = 0; while (cond) { __builtin_amdgcn_s_sleep(1); \
    if ((++_sp & 255u) == 0u) { if (xb_ld(&(bar)[XB_TMO])) break; if (_sp > XB_SPIN_CAP) { atomicAdd(&(bar)[XB_TMO], 1u); break; } } } } while (0)

struct XcdBarrier {
    unsigned* bar; unsigned x;
    volatile LAS unsigned* st;
};

__device__ __forceinline__ XcdBarrier xcd_barrier_post(unsigned* bar, volatile LAS unsigned* st) {
    XcdBarrier b; b.bar = bar; b.x = xb_xcc_id(); b.st = st;
    if (threadIdx.x == 0) (void)xb_add(&bar[XB_XCNT(b.x)], 1u);
    return b;
}
__device__ __forceinline__ void xcd_barrier_complete(unsigned* bar, unsigned x, unsigned& nloc, unsigned& nx) {
    const unsigned G = gridDim.x * gridDim.y * gridDim.z;
    unsigned sum, cnt, mine, sp = 0u;
    for (;;) {
        sum = 0u; cnt = 0u; mine = 0u;
#pragma unroll
        for (unsigned j = 0; j < 16; ++j) { const unsigned c = xb_ld(&bar[XB_XCNT(j)]); sum += c; cnt += (c > 0u) ? 1u : 0u; mine = (j == x) ? c : mine; }
        if (sum == G) break;
        __builtin_amdgcn_s_sleep(1);
        if ((++sp & 255u) == 0u) { if (xb_ld(&bar[XB_TMO])) break; if (sp > XB_SPIN_CAP) { atomicAdd(&bar[XB_TMO], 1u); break; } }
    }
    nloc = mine > 0u ? mine : 1u; nx = cnt > 0u ? cnt : 1u;
}

__device__ __forceinline__ void xcd_barrier(const XcdBarrier& b) {
    asm volatile("s_waitcnt vmcnt(0)" ::: "memory");
    __syncthreads();
    if (threadIdx.x == 0) {
        unsigned* bar = b.bar;
        __builtin_amdgcn_s_waitcnt(0);
        unsigned nloc = b.st[0], nx = b.st[1];
        if (nloc == 0u) { xcd_barrier_complete(bar, b.x, nloc, nx); b.st[0] = nloc; b.st[1] = nx; }
        const unsigned old = xb_add(&bar[XB_XSUB(b.x)], 1u);
        const unsigned gen = old / nloc;
        if (old + 1u == (gen + 1u) * nloc) {
            __builtin_amdgcn_fence(__ATOMIC_RELEASE, "agent");
            asm volatile("s_waitcnt vmcnt(0)" ::: "memory");
            const unsigned og = xb_add(&bar[XB_TOP], 1u);
            const unsigned tg = og / nx;
            if (og + 1u == (tg + 1u) * nx) xb_add(&bar[XB_TOPGEN], 1u);
            else XB_SPIN(xb_ld(&bar[XB_TOPGEN]) == tg, bar);
            __builtin_amdgcn_fence(__ATOMIC_ACQUIRE, "agent");
            xb_add(&bar[XB_XGEN(b.x)], 1u);
            asm volatile("s_waitcnt vmcnt(0)" ::: "memory");
        } else {
            XB_SPIN(xb_ld(&bar[XB_XGEN(b.x)]) == gen, bar);
            __builtin_amdgcn_fence(__ATOMIC_ACQUIRE, "agent");
            asm volatile("s_waitcnt vmcnt(0)" ::: "memory");
        }
    }
    __syncthreads();
}

struct Args { const float* in[27]; float* out; unsigned char* ws; int ph_lo, ph_hi; };
typedef const __attribute__((address_space(4))) Args* ArgsP;
struct Ctx { LAS unsigned char* lds; int tid, lane, wave, G, gw, ngw, gt, ngt; };
enum { I_XP = 0, I_XS, I_CK, I_CV, I_ST, I_C, I_CCTX, I_WMOD, I_BMOD, I_GMIX, I_GFFN, I_WIN, I_QG, I_KG, I_NAB, I_LCW, I_LCB, I_LWA, I_LBA, I_LWI, I_LBI, I_LAM, I_SCW, I_WOUT, I_WG, I_WU, I_WD };

template <int XM> __device__ __forceinline__ float swz_xor(float v) { return __builtin_bit_cast(float, __builtin_amdgcn_ds_swizzle(__builtin_bit_cast(int, v), 0x1f | (XM << 10))); }
__device__ __forceinline__ void swap32(float v, float& own, float& other) { own = v; other = v; asm volatile("s_nop 1\n\tv_permlane32_swap_b32 %0, %1\n\ts_nop 1" : "+v"(own), "+v"(other)); }
__device__ __forceinline__ float xor32_sum(float v) { float a, b; swap32(v, a, b); return a + b; }
__device__ __forceinline__ float xor32_max(float v) { float a, b; swap32(v, a, b); return fmaxf(a, b); }
__device__ __forceinline__ float wave_sum(float v) { v += swz_xor<1>(v); v += swz_xor<2>(v); v += swz_xor<4>(v); v += swz_xor<8>(v); v += swz_xor<16>(v); return xor32_sum(v); }
__device__ __forceinline__ float bperm(float v, int byte_idx) { return __builtin_bit_cast(float, __builtin_amdgcn_ds_bpermute(byte_idx, __builtin_bit_cast(int, v))); }

struct ConvItem { const float* W; bf16* WT; const LAS float* sh; float* shwp; int K, N, k0, n0, drow0, ntot; };
__device__ __forceinline__ void conv_load(const ConvItem& d, int lane, float (&v)[32]) {
    const float* wp = d.W + (size_t)(d.k0 + (lane >> 3)) * d.N + d.n0 + 4 * (lane & 7);
#pragma unroll
    for (int i = 0; i < 8; ++i) { const f32x4 t = __builtin_nontemporal_load((const f32x4*)(wp + (size_t)(8 * i) * d.N)); v[4 * i] = t.x; v[4 * i + 1] = t.y; v[4 * i + 2] = t.z; v[4 * i + 3] = t.w; }
}
__device__ __forceinline__ void conv_process(const ConvItem& d, int lane, const float (&v)[32], LAS float* scr) {
#pragma unroll
    for (int i = 0; i < 8; ++i)
#pragma unroll
        for (int j = 0; j < 4; ++j) scr[((lane >> 3) + 8 * i) * 33 + 4 * (lane & 7) + j] = v[4 * i + j];
    LDS_WAIT(); asm volatile("" ::: "memory");
    const int c = lane & 7;
#pragma unroll
    for (int j = 0; j < 4; ++j) { const int n = (lane >> 3) + 8 * j; const LAS float* s = scr + (8 * c) * 33 + n;
        v4u o; o.x = pk2(s[0 * 33], s[1 * 33]); o.y = pk2(s[2 * 33], s[3 * 33]); o.z = pk2(s[4 * 33], s[5 * 33]); o.w = pk2(s[6 * 33], s[7 * 33]);
        __builtin_nontemporal_store(o, (v4u*)(d.WT + (size_t)(d.drow0 + n) * d.K + d.k0 + 8 * c)); }
    if (d.sh) {
        const int n = lane & 31, hf = lane >> 5; float a0 = 0.f, a1 = 0.f, a2 = 0.f;
#pragma unroll
        for (int q = 0; q < 8; ++q) { const int kk = hf * 32 + q * 4; const LAS float* sp = d.sh + d.k0 + kk;
            const f32x4 s0 = *(const LAS f32x4*)sp, s1 = *(const LAS f32x4*)(sp + 2048), s2 = *(const LAS f32x4*)(sp + 4096);
#pragma unroll
            for (int j = 0; j < 4; ++j) { const float w = scr[(kk + j) * 33 + n]; a0 += s0[j] * w; a1 += s1[j] * w; a2 += s2[j] * w; } }
        a0 = xor32_sum(a0); a1 = xor32_sum(a1); a2 = xor32_sum(a2);
        if (lane < 32) { d.shwp[d.drow0 + n] = a0; d.shwp[(size_t)d.ntot + d.drow0 + n] = a1; d.shwp[2 * (size_t)d.ntot + d.drow0 + n] = a2; }
    }
    LDS_WAIT(); asm volatile("" ::: "memory");
}
typedef short bf16x8_t __attribute__((ext_vector_type(8)));
constexpr int XC_STRIDE = 272;
__device__ __forceinline__ int xaddr(int row, int colb) { return row * XC_STRIDE + (colb ^ (((row >> 4) & 3) << 6)); }
constexpr size_t WS_WFRAG = WS_END;
constexpr size_t WS_CKB   = WS_WFRAG + (size_t)DEPTH * 2 * 4 * 2 * 8 * 4 * 64 * 16;
constexpr size_t WS_CVB   = WS_CKB + (size_t)DB * DEPTH * 256 * 1024 * 2;
constexpr size_t WS_END2  = WS_CVB + (size_t)DB * DEPTH * 256 * 1024 * 2;
constexpr size_t WS_HSSQ  = WS_END2;
constexpr size_t WS_GS    = WS_HSSQ + (size_t)MTOK * 32 * 4;
constexpr size_t WS_SHWI  = WS_GS + (size_t)DEPTH * 2 * 3 * DM * 4;
constexpr size_t WS_SHWG  = WS_SHWI + (size_t)DEPTH * 3 * DIN * 4;
constexpr size_t WS_SHPI  = WS_SHWG + (size_t)DEPTH * 3 * 2 * DFF * 4;
constexpr size_t WS_SHPG  = WS_SHPI + (size_t)DEPTH * 32 * 3 * DIN * 4;
constexpr size_t WS_HB    = WS_SHPG + (size_t)DEPTH * 32 * 3 * 2 * DFF * 4;
constexpr size_t WS_END2B = WS_HB + (size_t)MTOK * DM * 2;
constexpr size_t WS_END3  = WS_END2B;

constexpr size_t CTL_GRAN = 262144;
typedef __attribute__((address_space(1))) unsigned long long gu64_t;
__device__ __forceinline__ void gran_store(gu64_t* g, unsigned tag, float v) { __hip_atomic_store(g, ((unsigned long long)tag << 32) | __builtin_bit_cast(unsigned, v), __ATOMIC_RELAXED, __HIP_MEMORY_SCOPE_AGENT); }
struct Aff { float a, b; };
__device__ __forceinline__ Aff aff_then(const Aff first, const Aff second) { Aff r; r.a = second.a * first.a; r.b = second.a * first.b + second.b; return r; }

__device__ __forceinline__ void lru_gate(float pa, float pi, float x, float sp8l, float& a, float& u) {
    const float r = __builtin_amdgcn_rcpf(1.0f + __builtin_amdgcn_exp2f(pa)), ig = __builtin_amdgcn_rcpf(1.0f + __builtin_amdgcn_exp2f(pi));
    a = __builtin_amdgcn_exp2f(sp8l * r);
    const float em = fmaf(-a, a, 1.0f);
    u = __builtin_amdgcn_sqrtf(em) * (ig * x);
}
constexpr int S_OFF = 256 * XC_STRIDE, S_STRIDE = 68;
static_assert(S_OFF + 256 * S_STRIDE * 4 <= LDSCTL_OFF, "LRU LDS tiles below the control words");
__device__ __forceinline__ float gelu_fast(float x) { const float z = 0.7978845608028654f * (x + 0.044715f * x * x * x); return x * __builtin_amdgcn_rcpf(1.0f + __builtin_amdgcn_exp2f(-2.8853900817779268f * z)); }
template <bool FULL>
__device__ __forceinline__ void lru_unit(ArgsP A, const Ctx& C, int l, int sq  , int chunk, int n, int hh, float* outw) {
    const bf16* XIN = (const bf16*)(A->ws + WS_XIN); bf16* MIX = (bf16*)(A->ws + WS_MIX);
    const int T = sq < NB ? SEQ : DSEQ, tlo = chunk * 256, row0 = (sq < NB ? sq * SEQ : NCTX + (sq - NB) * DSEQ) + tlo;
    LAS unsigned char* xl = C.lds;
    LAS float* S = (LAS float*)(C.lds + S_OFF);
    const int tid = C.tid, lane = C.lane, w = C.wave, fr = lane & 15, fq = lane >> 4;
    v4u lyv[4];
    if (FULL) {
#pragma unroll
        for (int k = 0; k < 4; ++k) { const int it = tid + 512 * k, tok = it >> 3, c8 = (it & 7) * 8; lyv[k] = *(const v4u*)(XIN + (size_t)(row0 + tok) * DIN + C_LY + n * 128 + hh * 64 + c8); }
    }
    {
        const int c8 = (tid & 15) * 8, chb = n * 128 + c8; float wt[4][8], bb[8];
#pragma unroll
        for (int i = 0; i < 8; ++i) bb[i] = A->in[I_LCB][l * DLRU + chb + i];
#pragma unroll
        for (int dk = 0; dk < 4; ++dk)
#pragma unroll
            for (int i = 0; i < 8; ++i) wt[dk][i] = A->in[I_LCW][(l * 4 + dk) * DLRU + chb + i];
#pragma unroll
        for (int q = 0; q < 2; ++q) {
            const int tb = 4 * (tid >> 4) + 128 * q;
            v4u xr[7];
#pragma unroll
            for (int j = 0; j < 7; ++j) { const int tt = tlo + tb + j - 2; xr[j] = (v4u){0u, 0u, 0u, 0u}; if (tt >= 0 && tt < T) xr[j] = *(const v4u*)(XIN + (size_t)(row0 + tb + j - 2) * DIN + C_LX + chb); }
#pragma unroll
            for (int t4 = 0; t4 < 4; ++t4) { float xc[8];
#pragma unroll
                for (int i = 0; i < 8; ++i) xc[i] = bb[i];
#pragma unroll
                for (int dk = 0; dk < 4; ++dk) { const v4u x = xr[t4 + dk];
                    xc[0] += wt[dk][0] * bflo(x.x); xc[1] += wt[dk][1] * bfhi(x.x); xc[2] += wt[dk][2] * bflo(x.y); xc[3] += wt[dk][3] * bfhi(x.y);
                    xc[4] += wt[dk][4] * bflo(x.z); xc[5] += wt[dk][5] * bfhi(x.z); xc[6] += wt[dk][6] * bflo(x.w); xc[7] += wt[dk][7] * bfhi(x.w); }
                v4u o; o.x = pk2(xc[0], xc[1]); o.y = pk2(xc[2], xc[3]); o.z = pk2(xc[4], xc[5]); o.w = pk2(xc[6], xc[7]);
                *(LAS v4u*)(xl + xaddr(tb + t4, c8 * 2)) = o; }
        }
    }
    __syncthreads();
    const int d = w >> 2, cg = w & 3, wq = 4 * hh + cg, ch = n * 128 + wq * 16 + fr;
    const bf16x8_t* wfrag = (const bf16x8_t*)(A->ws + WS_WFRAG); gu64_t* gran = (gu64_t*)(A->ws + WS_CTL + CTL_GRAN); const unsigned tag = (unsigned)l + 1u;
    bf16x8_t bfr[2][4];
#pragma unroll
    for (int g = 0; g < 2; ++g)
#pragma unroll
        for (int ks = 0; ks < 4; ++ks) bfr[g][ks] = wfrag[((((((size_t)l * 2 + d) * 4 + n) * 2 + g) * 8 + wq) * 4 + ks) * 64 + lane];
    const float ba = -1.4426950408889634f * A->in[I_LBA][(l * 2 + d) * DLRU + ch], bi = -1.4426950408889634f * A->in[I_LBI][(l * 2 + d) * DLRU + ch];
    const float sp8 = -8.0f * 1.4426950408889634f * log1pf(expf(-A->in[I_LAM][(l * 2 + d) * DLRU + ch]));
    float hrun = 0.f; Aff run; run.a = 1.f; run.b = 0.f;
    if (FULL && sq >= NB) {
        const int b = sq - NB; float h = A->in[I_ST][((b * DEPTH + l) * 2 + d) * DLRU + ch];
        float ga[8], gb[8];
        for (unsigned spins = 0; spins < (1u << 20); ++spins) { bool ok = true;
#pragma unroll
            for (int c2 = 0; c2 < 8; ++c2) { const bool need = (d == 0) ? (c2 < chunk) : (c2 > chunk); ga[c2] = 1.f; gb[c2] = 0.f;
                if (need) { gu64_t* sp = gran + ((((size_t)b * 8 + c2) * 2 + d) * DLRU + ch) * 2;
                    const unsigned long long x0 = __hip_atomic_load(sp, __ATOMIC_RELAXED, __HIP_MEMORY_SCOPE_AGENT), x1 = __hip_atomic_load(sp + 1, __ATOMIC_RELAXED, __HIP_MEMORY_SCOPE_AGENT);
                    ok = ok && ((unsigned)(x0 >> 32) == tag) && ((unsigned)(x1 >> 32) == tag); ga[c2] = __builtin_bit_cast(float, (unsigned)x0); gb[c2] = __builtin_bit_cast(float, (unsigned)x1); } }
            if (__all(ok)) break;
            __builtin_amdgcn_s_sleep(2); }
#pragma unroll
        for (int k = 0; k < 8; ++k) { const int c2 = (d == 0) ? k : 7 - k; h = ga[c2] * h + gb[c2]; }
        hrun = h;
    }
    const int up16 = ((lane - 16) & 63) * 4, up32 = ((lane - 32) & 63) * 4, last = (48 + fr) * 4;
    const int taur = 16 * (fr >> 2) + (fr & 3);
#pragma unroll 1
    for (int half = 0; half < 2; ++half) {
#pragma unroll 1
        for (int k = 0; k < 2; ++k) {
            const int si = half * 2 + k, st = d ? 3 - si : si;
            f32x4 accA[4], accI[4];
#pragma unroll
            for (int j = 0; j < 4; ++j) { accA[j] = (f32x4){ba, ba, ba, ba}; accI[j] = (f32x4){bi, bi, bi, bi};
                const int trow = d ? 64 * st + 63 - (taur + 4 * j) : 64 * st + taur + 4 * j;
#pragma unroll
                for (int ks = 0; ks < 4; ++ks) { const bf16x8_t af = *(const LAS bf16x8_t*)(xl + xaddr(trow, (32 * ks + 8 * fq) * 2));
                    accA[j] = __builtin_amdgcn_mfma_f32_16x16x32_bf16(af, bfr[0][ks], accA[j], 0, 0, 0); accI[j] = __builtin_amdgcn_mfma_f32_16x16x32_bf16(af, bfr[1][ks], accI[j], 0, 0, 0); } }
            const int tokb = d ? 64 * st + 48 - 16 * fq : 64 * st + 16 * fq;
            float a[16], u[16];
            { const LAS unsigned char* xp = xl + xaddr(tokb, (wq * 16 + fr) * 2); float xs[16];
#pragma unroll
              for (int k = 0; k < 16; ++k) xs[k] = bf2f(*(const LAS bf16*)(xp + k * XC_STRIDE));
#pragma unroll
              for (int j = 0; j < 4; ++j)
#pragma unroll
                for (int i = 0; i < 4; ++i) { const int n2 = 4 * j + i; const float x = d ? xs[15 - n2] : xs[n2]; lru_gate(accA[j][i], accI[j][i], x, sp8, a[n2], u[n2]); } }
            Aff L; L.a = 1.f; L.b = 0.f;
#pragma unroll
            for (int n2 = 0; n2 < 16; ++n2) { L.b = a[n2] * L.b + u[n2]; L.a = a[n2] * L.a; }
            Aff I = L;
            { Aff Q; Q.a = bperm(I.a, up16); Q.b = bperm(I.b, up16); const Aff J = aff_then(Q, I); const bool has = fq >= 1; I.a = has ? J.a : I.a; I.b = has ? J.b : I.b; }
            { Aff Q; Q.a = bperm(I.a, up32); Q.b = bperm(I.b, up32); const Aff J = aff_then(Q, I); const bool has = fq >= 2; I.a = has ? J.a : I.a; I.b = has ? J.b : I.b; }
            Aff E; E.a = bperm(I.a, up16); E.b = bperm(I.b, up16); if (fq == 0) { E.a = 1.f; E.b = 0.f; }
            Aff Tt; Tt.a = bperm(I.a, last); Tt.b = bperm(I.b, last);
            if (FULL) {
                float h = E.a * hrun + E.b;
#pragma unroll
                for (int n2 = 0; n2 < 16; ++n2) { h = a[n2] * h + u[n2]; u[n2] = h; }
                LAS float* sp = S + tokb * S_STRIDE + cg * 16 + fr;
                if (half == 0) {
#pragma unroll
                    for (int k = 0; k < 16; ++k) sp[k * S_STRIDE] = d ? u[15 - k] : u[k];
                } else {
#pragma unroll
                    for (int k = 0; k < 16; ++k) sp[k * S_STRIDE] += d ? u[15 - k] : u[k];
                }
                hrun = Tt.a * hrun + Tt.b;
            } else { run = aff_then(run, Tt); }
        }
        if (FULL) __syncthreads();
    }
    if (FULL) {
        if (sq < NB && lane < 16) outw[OUT_S + ((size_t)(sq * DEPTH + l) * 2 + d) * DLRU + ch] = hrun;
#pragma unroll
        for (int k = 0; k < 4; ++k) { const int it = tid + 512 * k, tok = it >> 3, c8 = (it & 7) * 8; const size_t row = (size_t)(row0 + tok);
            const f32x4 s0 = *(const LAS f32x4*)(S + tok * S_STRIDE + c8), s1 = *(const LAS f32x4*)(S + tok * S_STRIDE + c8 + 4);
            const v4u ly = lyv[k]; v4u o;
            o.x = pk2(s0.x * gelu_fast(bflo(ly.x)), s0.y * gelu_fast(bfhi(ly.x))); o.y = pk2(s0.z * gelu_fast(bflo(ly.y)), s0.w * gelu_fast(bfhi(ly.y)));
            o.z = pk2(s1.x * gelu_fast(bflo(ly.z)), s1.y * gelu_fast(bfhi(ly.z))); o.w = pk2(s1.z * gelu_fast(bflo(ly.w)), s1.w * gelu_fast(bfhi(ly.w)));
            *(v4u*)(MIX + row * DM + 1024 + n * 128 + hh * 64 + c8) = o; }
    } else if (lane < 16) { gu64_t* sp = gran + ((((size_t)(sq - NB) * 8 + chunk) * 2 + d) * DLRU + ch) * 2; gran_store(sp, tag, run.a); gran_store(sp + 1, tag, run.b); }
    __syncthreads();
}
__device__ __forceinline__ void lru_prep_wfrag(ArgsP A, const Ctx& C) {
    v4u* wf = (v4u*)(A->ws + WS_WFRAG);
    for (int it = C.gt; it < DEPTH * 2 * 4 * 2 * 8 * 4 * 64; it += C.ngt) {
        const int lane = it & 63, ks = (it >> 6) & 3, w = (it >> 8) & 7, g = (it >> 11) & 1, ldn = it >> 12;
        const float* W = (g == 0 ? A->in[I_LWA] : A->in[I_LWI]) + (size_t)ldn * 128 * 128;
        const int k0 = 32 * ks + 8 * (lane >> 4), j = 16 * w + (lane & 15);
        const float sc = -1.4426950408889634f;
        v4u o; o.x = pk2(sc * W[(k0 + 0) * 128 + j], sc * W[(k0 + 1) * 128 + j]); o.y = pk2(sc * W[(k0 + 2) * 128 + j], sc * W[(k0 + 3) * 128 + j]);
        o.z = pk2(sc * W[(k0 + 4) * 128 + j], sc * W[(k0 + 5) * 128 + j]); o.w = pk2(sc * W[(k0 + 6) * 128 + j], sc * W[(k0 + 7) * 128 + j]);
        wf[it] = o;
    }
}
namespace att {
using bf16x8 = __attribute__((ext_vector_type(8))) short;
using s16x4  = __attribute__((ext_vector_type(4))) short;
using f32x16 = __attribute__((ext_vector_type(16))) float;
using u32x4  = __attribute__((ext_vector_type(4))) unsigned;
constexpr float SCALE = 0.088388347648318440f, THR = 8.f;
constexpr int SHM_V = 16384, SHM_K = 16384, OFF_V = 0, OFF_K = 2 * SHM_V, OFF_WS = 2 * SHM_V + 2 * SHM_K, OFF_BT = OFF_WS + 8 * 256, BT_PITCH = 36, OFF_OT = OFF_BT + 4 * 15 * BT_PITCH * 4 + 64, LDS_ATT = OFF_OT + 8 * 32 * 272;
static_assert(LDS_ATT <= LDSCTL_OFF, "attention LDS tiles below the control words");
#define KSWZ(row, colB) ((row) * 256 + ((colB) ^ (((row) & 7) << 4)))
#define SBAR() __builtin_amdgcn_sched_barrier(0)
__device__ __forceinline__ int crow(int r, int hi) { return (r & 3) + 8 * (r >> 2) + 4 * hi; }
__device__ __forceinline__ unsigned cvtpk(float lo, float hi) { unsigned r; asm volatile("v_cvt_pk_bf16_f32 %0, %1, %2" : "=v"(r) : "v"(lo), "v"(hi)); return r; }
__device__ __forceinline__ void partialSM(f32x16& p0, f32x16& p1, float& m_reg, float& mn, float& alpha) {
  constexpr float C = SCALE * 1.4426950408889634f;
  float pmax = p0[0];
#pragma unroll
  for (int r = 1; r < 16; ++r) pmax = fmaxf(pmax, p0[r]);
#pragma unroll
  for (int r = 0; r < 16; ++r) pmax = fmaxf(pmax, p1[r]);
  pmax = xor32_max(pmax);
  if (__builtin_expect(__all(pmax - m_reg <= THR / SCALE), 1)) { mn = m_reg; alpha = 1.f; }
  else { mn = fmaxf(m_reg, pmax); alpha = __builtin_amdgcn_exp2f((m_reg - mn) * C); m_reg = mn; }
  float mnC = -mn * C;
#pragma unroll
  for (int r = 0; r < 16; ++r) p0[r] = fmaf(p0[r], C, mnC);
#pragma unroll
  for (int r = 0; r < 16; ++r) p1[r] = fmaf(p1[r], C, mnC);
#pragma unroll
  for (int r = 0; r < 16; ++r) p0[r] = __builtin_amdgcn_exp2f(p0[r]);
}
__device__ __forceinline__ void finishSM(f32x16& p0, f32x16& p1, float alpha, float& l_reg, bf16x8& pa0, bf16x8& pa1, bf16x8& pa2, bf16x8& pa3) {
#pragma unroll
  for (int r = 0; r < 16; ++r) p1[r] = __builtin_amdgcn_exp2f(p1[r]);
  float ps = 0;
#pragma unroll
  for (int r = 0; r < 16; ++r) ps += p0[r];
#pragma unroll
  for (int r = 0; r < 16; ++r) ps += p1[r];
  ps = xor32_sum(ps);
  l_reg = l_reg * alpha + ps;
#define PK4(P, BASE, OUT) do { unsigned a0 = cvtpk(P[BASE + 0], P[BASE + 1]), a1 = cvtpk(P[BASE + 2], P[BASE + 3]);   \
    unsigned b0 = cvtpk(P[BASE + 4], P[BASE + 5]), b1 = cvtpk(P[BASE + 6], P[BASE + 7]);                              \
    auto r0 = __builtin_amdgcn_permlane32_swap(a0, b0, false, false); auto r1 = __builtin_amdgcn_permlane32_swap(a1, b1, false, false); \
    u32x4 w = {r0[0], r1[0], r0[1], r1[1]}; OUT = *reinterpret_cast<bf16x8*>(&w); } while (0)
  PK4(p0, 0, pa0); PK4(p0, 8, pa1); PK4(p1, 0, pa2); PK4(p1, 8, pa3);
#undef PK4
}
__device__ __forceinline__ void qkt(f32x16& p0, f32x16& p1, const LAS unsigned char* Ks, const bf16x8* qr, int r32, int hi) {
  p0 = f32x16{}; p1 = f32x16{};
#pragma unroll
  for (int d0 = 0; d0 < 8; ++d0) { int cb = (d0 * 16 + hi * 8) * 2;
    bf16x8 b0 = *reinterpret_cast<const LAS bf16x8*>(Ks + KSWZ(r32, cb));
    bf16x8 b1 = *reinterpret_cast<const LAS bf16x8*>(Ks + KSWZ(32 + r32, cb));
    p0 = __builtin_amdgcn_mfma_f32_32x32x16_bf16(b0, qr[d0], p0, 0, 0, 0);
    p1 = __builtin_amdgcn_mfma_f32_32x32x16_bf16(b1, qr[d0], p1, 0, 0, 0); }
}
__device__ __forceinline__ int v_st(int k, int c) { const int kk = (k & ~0xC) | ((k & 4) << 1) | ((k & 8) >> 1); return ((kk >> 3) * 4 + (c >> 5)) * 512 + ((kk & 7) * 32 + (c & 31)) * 2; }
__device__ __forceinline__ int v_rd_base(int lane) { return ((lane & 3) << 3) | (((lane >> 2) & 3) << 6) | (((lane >> 4) & 1) << 5) | (((lane >> 5) & 1) << 8); }
constexpr int v_rd_off(int d0, int ks, int half) { return d0 * 512 + ks * 4096 + half * 2048; }
template <int OFF> __device__ __forceinline__ s16x4 tr_read(int vb) {
  s16x4 r; asm volatile("ds_read_b64_tr_b16 %0, %1 offset:%2" : "=&v"(r) : "v"(vb), "i"(OFF) : "memory"); return r;
}
template <int D0> __device__ __forceinline__ void pv_one(f32x16& od, int vb, bf16x8 pa0, bf16x8 pa1, bf16x8 pa2, bf16x8 pa3) {
  const s16x4 l0 = tr_read<v_rd_off(D0, 0, 0)>(vb), h0 = tr_read<v_rd_off(D0, 0, 1)>(vb), l1 = tr_read<v_rd_off(D0, 1, 0)>(vb), h1 = tr_read<v_rd_off(D0, 1, 1)>(vb);
  const s16x4 l2 = tr_read<v_rd_off(D0, 2, 0)>(vb), h2 = tr_read<v_rd_off(D0, 2, 1)>(vb), l3 = tr_read<v_rd_off(D0, 3, 0)>(vb), h3 = tr_read<v_rd_off(D0, 3, 1)>(vb);
  asm volatile("s_waitcnt lgkmcnt(0)" ::: "memory"); SBAR();
#define PK(L, H) (bf16x8){L[0], L[1], L[2], L[3], H[0], H[1], H[2], H[3]}
  od = __builtin_amdgcn_mfma_f32_32x32x16_bf16(pa0, PK(l0, h0), od, 0, 0, 0);
  od = __builtin_amdgcn_mfma_f32_32x32x16_bf16(pa1, PK(l1, h1), od, 0, 0, 0);
  od = __builtin_amdgcn_mfma_f32_32x32x16_bf16(pa2, PK(l2, h2), od, 0, 0, 0);
  od = __builtin_amdgcn_mfma_f32_32x32x16_bf16(pa3, PK(l3, h3), od, 0, 0, 0);
#undef PK
}
__device__ __forceinline__ void pv_d0(f32x16* o, int vb, bf16x8 pa0, bf16x8 pa1, bf16x8 pa2, bf16x8 pa3) {
  pv_one<0>(o[0], vb, pa0, pa1, pa2, pa3); pv_one<1>(o[1], vb, pa0, pa1, pa2, pa3); pv_one<2>(o[2], vb, pa0, pa1, pa2, pa3); pv_one<3>(o[3], vb, pa0, pa1, pa2, pa3);
}
__device__ __forceinline__ void qkt_half(f32x16& p0, const LAS unsigned char* Ks, const bf16x8* qr, int krow, int hi) {
  p0 = f32x16{};
#pragma unroll
  for (int d0 = 0; d0 < 8; ++d0) { int cb = (d0 * 16 + hi * 8) * 2;
    bf16x8 b0 = *reinterpret_cast<const LAS bf16x8*>(Ks + KSWZ(krow, cb));
    p0 = __builtin_amdgcn_mfma_f32_32x32x16_bf16(b0, qr[d0], p0, 0, 0, 0); }
}
__device__ __forceinline__ void partialSM_h(f32x16& p0, float& m_reg, float& mn, float& alpha) {
  constexpr float C = SCALE * 1.4426950408889634f;
  float pmax = p0[0];
#pragma unroll
  for (int r = 1; r < 16; ++r) pmax = fmaxf(pmax, p0[r]);
  pmax = xor32_max(pmax);
  if (__builtin_expect(__all(pmax - m_reg <= THR / SCALE), 1)) { mn = m_reg; alpha = 1.f; }
  else { mn = fmaxf(m_reg, pmax); alpha = __builtin_amdgcn_exp2f((m_reg - mn) * C); m_reg = mn; }
  float mnC = -mn * C;
#pragma unroll
  for (int r = 0; r < 16; ++r) p0[r] = __builtin_amdgcn_exp2f(fmaf(p0[r], C, mnC));
}
__device__ __forceinline__ void finishSM_h(f32x16& p0, float alpha, float& l_reg, bf16x8& pa0, bf16x8& pa1) {
  float ps = 0;
#pragma unroll
  for (int r = 0; r < 16; ++r) ps += p0[r];
  ps = xor32_sum(ps);
  l_reg = l_reg * alpha + ps;
#define PK4(P, BASE, OUT) do { unsigned a0 = cvtpk(P[BASE + 0], P[BASE + 1]), a1 = cvtpk(P[BASE + 2], P[BASE + 3]);   \
    unsigned b0 = cvtpk(P[BASE + 4], P[BASE + 5]), b1 = cvtpk(P[BASE + 6], P[BASE + 7]);                              \
    auto r0 = __builtin_amdgcn_permlane32_swap(a0, b0, false, false); auto r1 = __builtin_amdgcn_permlane32_swap(a1, b1, false, false); \
    u32x4 w = {r0[0], r1[0], r0[1], r1[1]}; OUT = *reinterpret_cast<bf16x8*>(&w); } while (0)
  PK4(p0, 0, pa0); PK4(p0, 8, pa1);
#undef PK4
}
template <int D0> __device__ __forceinline__ void pv_half_one(f32x16& od, int vb, bf16x8 pa0, bf16x8 pa1) {
  const s16x4 l0 = tr_read<v_rd_off(D0, 0, 0)>(vb), h0 = tr_read<v_rd_off(D0, 0, 1)>(vb), l1 = tr_read<v_rd_off(D0, 1, 0)>(vb), h1 = tr_read<v_rd_off(D0, 1, 1)>(vb);
  asm volatile("s_waitcnt lgkmcnt(0)" ::: "memory"); SBAR();
#define PK(L, H) (bf16x8){L[0], L[1], L[2], L[3], H[0], H[1], H[2], H[3]}
  od = __builtin_amdgcn_mfma_f32_32x32x16_bf16(pa0, PK(l0, h0), od, 0, 0, 0);
  od = __builtin_amdgcn_mfma_f32_32x32x16_bf16(pa1, PK(l1, h1), od, 0, 0, 0);
#undef PK
}
__device__ __forceinline__ void pv_half(f32x16* o, int vb, bf16x8 pa0, bf16x8 pa1) {
  pv_half_one<0>(o[0], vb, pa0, pa1); pv_half_one<1>(o[1], vb, pa0, pa1); pv_half_one<2>(o[2], vb, pa0, pa1); pv_half_one<3>(o[3], vb, pa0, pa1);
}
__device__ __forceinline__ float row16_sum(float s) {
  s += __builtin_bit_cast(float, __builtin_amdgcn_update_dpp(0, __builtin_bit_cast(int, s), 0xB1, 0xF, 0xF, true));
  s += __builtin_bit_cast(float, __builtin_amdgcn_update_dpp(0, __builtin_bit_cast(int, s), 0x4E, 0xF, 0xF, true));
  s += __builtin_bit_cast(float, __builtin_amdgcn_update_dpp(0, __builtin_bit_cast(int, s), 0x141, 0xF, 0xF, true));
  s += __builtin_bit_cast(float, __builtin_amdgcn_update_dpp(0, __builtin_bit_cast(int, s), 0x140, 0xF, 0xF, true));
  return s;
}
__device__ __forceinline__ float sq8(u32x4 w) { const float a0 = bflo(w.x), a1 = bfhi(w.x), a2 = bflo(w.y), a3 = bfhi(w.y), a4 = bflo(w.z), a5 = bfhi(w.z), a6 = bflo(w.w), a7 = bfhi(w.w);
  return ((a0 * a0 + a1 * a1) + (a2 * a2 + a3 * a3)) + ((a4 * a4 + a5 * a5) + (a6 * a6 + a7 * a7)); }
}

template <bool LATENT>
__device__ __forceinline__ void attn_unit(ArgsP A, const Ctx& C, int l, int uidx, float* outw) {
  using namespace att;
  const bf16* XIN = (const bf16*)(A->ws + WS_XIN); bf16* MIX = (bf16*)(A->ws + WS_MIX);
  int tid_ = C.tid, wid_ = C.wave; asm volatile("" : "+v"(tid_)); asm volatile("" : "+s"(wid_));
  const int tid = tid_, wid = wid_, lane = tid & 63, r32 = lane & 31, hi = lane >> 5;
  const int h = uidx & 7, b = LATENT ? (uidx >> 6) : (uidx >> 3), rg = (uidx >> 3) & 7;
  const int q0 = LATENT ? NCTX + b * DSEQ + rg * 256 : b * SEQ;
  const int R0 = (rg == 7) ? 24 : max(4 * rg - 4, 0);
  const int NT = LATENT ? ((rg == 0 || rg == 7) ? 12 : 15) : 4;
  LAS unsigned char* lds = C.lds;
  LAS float* wsf = (LAS float*)(lds + OFF_WS) + wid * 64; LAS float* li_l = wsf; LAS float* al_l = wsf + 32;
  LAS float* btab = (LAS float*)(lds + OFF_BT);
  const float* gkb = A->in[I_KG] + l * HD;
  const int sr = tid >> 4, sc = (tid & 15) * 8, vst0 = v_st(sr, sc), vst1 = v_st(32 + sr, sc);
  const int vb0 = (int)(uintptr_t)(lds + OFF_V) + v_rd_base(lane);
  bf16x8 sv0, sv1, sk0, sk1; int skrow = 0;
#define SLOAD(j) do { const bf16* kp; const bf16* vp; int ld; \
    if (!LATENT) { skrow = b * SEQ + 64 * (j) + sr; const size_t ro = (size_t)(b * SEQ + 64 * (j)) * DIN + h * HD; kp = XIN + ro + C_K; vp = XIN + ro + C_V; ld = DIN; } \
    else if ((j) < 4) { const size_t ro = (((size_t)b * DEPTH + l) * 256 + 64 * (j)) * 1024 + h * HD; kp = (const bf16*)(A->ws + WS_CKB) + ro; vp = (const bf16*)(A->ws + WS_CVB) + ro; ld = 1024; } \
    else { skrow = NCTX + b * DSEQ + (R0 + (j) - 4) * GW + sr; const size_t ro = (size_t)(NCTX + b * DSEQ + (R0 + (j) - 4) * GW) * DIN + h * HD; kp = XIN + ro + C_K; vp = XIN + ro + C_V; ld = DIN; } \
    sv0 = *reinterpret_cast<const bf16x8*>(vp + (size_t)sr * ld + sc); sv1 = *reinterpret_cast<const bf16x8*>(vp + (size_t)(32 + sr) * ld + sc); \
    sk0 = *reinterpret_cast<const bf16x8*>(kp + (size_t)sr * ld + sc); sk1 = *reinterpret_cast<const bf16x8*>(kp + (size_t)(32 + sr) * ld + sc); } while (0)
#define KNORM(skx, svx, rowx) do { const u32x4 w = *reinterpret_cast<const u32x4*>(&skx); const float rk = __builtin_amdgcn_rsqf(row16_sum(sq8(w)) * (1.0f / HD) + EPS); \
    const f32x4 y0 = {bflo(w.x) * rk * gk0.x, bfhi(w.x) * rk * gk0.y, bflo(w.y) * rk * gk0.z, bfhi(w.y) * rk * gk0.w}, y1 = {bflo(w.z) * rk * gk1.x, bfhi(w.z) * rk * gk1.y, bflo(w.w) * rk * gk1.z, bfhi(w.w) * rk * gk1.w}; \
    u32x4 o; o.x = cvtpk(y0.x, y0.y); o.y = cvtpk(y0.z, y0.w); o.z = cvtpk(y1.x, y1.y); o.w = cvtpk(y1.z, y1.w); skx = *reinterpret_cast<bf16x8*>(&o); \
    if (!LATENT) { const size_t oo = (((size_t)b * DEPTH + l) * SEQ + ((rowx) & 255)) * DATT + h * HD + sc; float* op = outw + OUT_K + oo; __builtin_nontemporal_store(y0, (f32x4*)op); __builtin_nontemporal_store(y1, (f32x4*)(op + 4)); \
      const u32x4 wv = *reinterpret_cast<const u32x4*>(&svx); const f32x4 z0 = {bflo(wv.x), bfhi(wv.x), bflo(wv.y), bfhi(wv.y)}, z1 = {bflo(wv.z), bfhi(wv.z), bflo(wv.w), bfhi(wv.w)}; \
      float* ov = outw + OUT_V + oo; __builtin_nontemporal_store(z0, (f32x4*)ov); __builtin_nontemporal_store(z1, (f32x4*)(ov + 4)); } } while (0)
#define SWRITE(bu, jn) do { if (!LATENT || (jn) >= 4) { int sc_ = sc; asm volatile("" : "+v"(sc_)); const f32x4 gk0 = *(const f32x4*)(gkb + sc_), gk1 = *(const f32x4*)(gkb + sc_ + 4); KNORM(sk0, sv0, skrow); KNORM(sk1, sv1, skrow + 32); } \
    *(LAS bf16x8*)(lds + OFF_V + (bu) * SHM_V + vst0) = sv0; *(LAS bf16x8*)(lds + OFF_V + (bu) * SHM_V + vst1) = sv1; const int kc = sc * 2; \
    *(LAS bf16x8*)(lds + OFF_K + (bu) * SHM_K + KSWZ(sr, kc)) = sk0; *(LAS bf16x8*)(lds + OFF_K + (bu) * SHM_K + KSWZ(32 + sr, kc)) = sk1; } while (0)
  float m_reg = -1e30f, l_reg = 0.f; f32x16 o[4] = {};
  SLOAD(0);
  bf16x8 qr[8];
  { const int qrow_ = LATENT ? q0 + (r32 >> 3) * 64 + 8 * wid + (r32 & 7) : q0 + wid * 32 + r32; const bf16* Qw = XIN + (size_t)qrow_ * DIN + C_Q + h * HD + hi * 8;
    const float* gq = A->in[I_QG] + l * HD + hi * 8;
    u32x4 qw[8]; float qs = 0.f;
#pragma unroll
    for (int d0 = 0; d0 < 8; ++d0) qw[d0] = *reinterpret_cast<const u32x4*>(Qw + d0 * 16);
#pragma unroll
    for (int d0 = 0; d0 < 8; ++d0) qs += sq8(qw[d0]);
    const float rq = __builtin_amdgcn_rsqf(xor32_sum(qs) * (1.0f / HD) + EPS);
#pragma unroll
    for (int d0 = 0; d0 < 8; ++d0) { const u32x4 w = qw[d0]; const f32x4 g0 = *(const f32x4*)(gq + d0 * 16), g1 = *(const f32x4*)(gq + d0 * 16 + 4);
      u32x4 o; o.x = cvtpk(bflo(w.x) * rq * g0.x, bfhi(w.x) * rq * g0.y); o.y = cvtpk(bflo(w.y) * rq * g0.z, bfhi(w.y) * rq * g0.w);
      o.z = cvtpk(bflo(w.z) * rq * g1.x, bfhi(w.z) * rq * g1.y); o.w = cvtpk(bflo(w.w) * rq * g1.z, bfhi(w.w) * rq * g1.w); qr[d0] = *reinterpret_cast<bf16x8*>(&o); } }
  if (LATENT) { for (int i = tid; i < 4 * 15 * 31; i += 512) { const int sft = i / 465, q = i % 465, dr = q / 31, dc = q % 31; btab[(sft * 15 + dr) * BT_PITCH + dc + sft] = A->in[I_NAB][((l * NH + h) * 15 + dr) * 31 + dc] * (1.0f / SCALE); } }
  asm volatile("s_waitcnt vmcnt(0)" ::: "memory"); SWRITE(0, 0); __syncthreads();
  const int ND = LATENT ? 4 : NT;
#pragma unroll 1
  for (int j = 0; j < ND; ++j) {
    const int bu = j & 1;
    if (j + 1 < NT) SLOAD(j + 1);
    {
      f32x16 p0, p1; float mn, alpha; bf16x8 pa0, pa1, pa2, pa3;
      qkt(p0, p1, lds + OFF_K + bu * SHM_K, qr, r32, hi);
      partialSM(p0, p1, m_reg, mn, alpha);
      if (__any(alpha < 1.f)) { if (hi == 0) al_l[r32] = alpha; asm volatile("s_waitcnt lgkmcnt(0)" ::: "memory");
#pragma unroll
        for (int d = 0; d < 4; ++d)
#pragma unroll
          for (int r = 0; r < 16; ++r) o[d][r] *= al_l[crow(r, hi)];
        asm volatile("s_waitcnt lgkmcnt(0)" ::: "memory"); }
      finishSM(p0, p1, alpha, l_reg, pa0, pa1, pa2, pa3); SBAR();
      pv_d0(o, vb0 + bu * SHM_V, pa0, pa1, pa2, pa3);
    }
    if (j + 1 < NT) { asm volatile("s_waitcnt vmcnt(0)" ::: "memory"); SWRITE(bu ^ 1, j + 1); }
    __syncthreads();
  }
  if (LATENT) {
    int tl2 = tid; asm volatile("" : "+v"(tl2));
    const int r32b = tl2 & 31, hib = (tl2 >> 5) & 1;
    const int qrow = 4 * rg + (r32b >> 3), qcol = 8 * wid + (r32b & 7), rs = min(max(qrow - 4, 0), 24), cs = min(max(qcol - 8, 0), 48);
    const int kb16 = wid < 3 ? 0 : (wid < 5 ? 1 : 2);
    const int wsh = cs - 4 * hib - 16 * kb16;
    const unsigned wlo = wsh >= 0 ? (0xFFFFu << wsh) : (0xFFFFu >> (-wsh));
    const int sft = (qcol + 1) & 3, bt0 = (sft * 15 + 7 - qrow) * BT_PITCH + (15 - qcol) + sft + 4 * hib + 16 * kb16;
#pragma unroll 1
    for (int j = 4; j < NT; ++j) {
      const int bu = j & 1;
      if (j + 1 < NT) SLOAD(j + 1);
      {
      const int kr = R0 + j - 4;
      f32x16 p0; float mn, alpha; bf16x8 pa0, pa1;
      qkt_half(p0, lds + OFF_K + bu * SHM_K, qr, 16 * kb16 + r32b, hib);
      {
        const LAS f32x4* brow = (const LAS f32x4*)(btab + bt0 + kr * BT_PITCH);
        unsigned wl = ((unsigned)(kr - rs) < 8u) ? wlo : 0u; asm volatile("" : "+v"(wl));
#define MSK1(V, B, X, W) do { const int m_ = ((int)((W) << (31 - (X)))) >> 31; const unsigned t_ = __builtin_bit_cast(unsigned, (V) + (B)); V = __builtin_bit_cast(float, (t_ & (unsigned)m_) | (0xff800000u & ~(unsigned)m_)); } while (0)
#pragma unroll
        for (int g = 0; g < 4; ++g) { const f32x4 b0 = brow[2 * g];
          MSK1(p0[4 * g + 0], b0.x, 8 * g + 0, wl); MSK1(p0[4 * g + 1], b0.y, 8 * g + 1, wl); MSK1(p0[4 * g + 2], b0.z, 8 * g + 2, wl); MSK1(p0[4 * g + 3], b0.w, 8 * g + 3, wl); }
#undef MSK1
      }
      partialSM_h(p0, m_reg, mn, alpha);
      if (__any(alpha < 1.f)) { if (hib == 0) al_l[r32b] = alpha; asm volatile("s_waitcnt lgkmcnt(0)" ::: "memory");
#pragma unroll
        for (int d = 0; d < 4; ++d)
#pragma unroll
          for (int r = 0; r < 16; ++r) o[d][r] *= al_l[crow(r, hib)];
        asm volatile("s_waitcnt lgkmcnt(0)" ::: "memory"); }
      finishSM_h(p0, alpha, l_reg, pa0, pa1); SBAR();
      pv_half(o, vb0 + bu * SHM_V + kb16 * 4096, pa0, pa1);
      }
      if (j + 1 < NT) { asm volatile("s_waitcnt vmcnt(0)" ::: "memory"); SWRITE(bu ^ 1, j + 1); }
      __syncthreads();
    }
  }
  int ln2 = lane; asm volatile("" : "+v"(ln2)); const int r32e = ln2 & 31, hie = ln2 >> 5;
  if (hie == 0) li_l[r32e] = l_reg; asm volatile("s_waitcnt lgkmcnt(0)" ::: "memory");
  float rli[16];
#pragma unroll
  for (int r = 0; r < 16; ++r) rli[r] = __builtin_amdgcn_rcpf(li_l[crow(r, hie)]);
  LAS unsigned char* ot = lds + OFF_OT + wid * (32 * 272);
#pragma unroll
  for (int r = 0; r < 16; ++r) { const int orow = crow(r, hie);
#pragma unroll
    for (int d0 = 0; d0 < 4; ++d0) *(LAS bf16*)(ot + orow * 272 + (d0 * 32 + r32e) * 2) = (bf16)f2bf(o[d0][r] * rli[r]); }
  asm volatile("s_waitcnt lgkmcnt(0)" ::: "memory");
  bf16* Ow = MIX + (size_t)(LATENT ? q0 + 8 * wid : q0 + wid * 32) * DM + h * HD;
#pragma unroll
  for (int i = 0; i < 8; ++i) { const int orow = 4 * i + (ln2 >> 4), oc = (ln2 & 15) * 8, grow = LATENT ? (orow >> 3) * 64 + (orow & 7) : orow;
    *(u32x4*)(Ow + (size_t)grow * DM + oc) = *(const LAS u32x4*)(ot + orow * 272 + oc * 2); }
  __syncthreads();
#undef SLOAD
#undef SWRITE
#undef KNORM
}
#undef KSWZ
#undef SBAR
__device__ __forceinline__ ConvItem conv_desc(ArgsP A, int l, int set, int r, const LAS float* sht) {
    ConvItem d;
    if (set == 0) {
        if (r < 5632) { const int kb = r / 176, nb = r % 176, n0 = 32 * nb; d.W = A->in[I_WIN] + (size_t)l * DM * DIN; d.WT = (bf16*)(A->ws + WS_WIN) + (size_t)l * DIN * DM; d.K = DM; d.N = DIN; d.k0 = 64 * kb; d.n0 = n0; d.drow0 = n0;
            d.sh = sht; d.shwp = (float*)(A->ws + WS_SHPI) + ((size_t)l * 32 + kb) * 3 * DIN; d.ntot = DIN; }
        else { const int q = r - 5632, kb = q / 64, nb = q % 64; d.W = A->in[I_WOUT] + (size_t)l * DM * DM; d.WT = (bf16*)(A->ws + WS_WOUT) + (size_t)l * DM * DM; d.K = DM; d.N = DM; d.k0 = 64 * kb; d.n0 = 32 * nb; d.drow0 = 32 * nb; d.sh = nullptr; d.shwp = nullptr; d.ntot = 0; }
    } else { const int m = r / 5632, q = r % 5632;
        if (m < 2) { const int kb = q / 176, nb = q % 176, n0 = 32 * nb; d.W = (m ? A->in[I_WU] : A->in[I_WG]) + (size_t)l * DM * DFF; d.WT = (bf16*)(A->ws + WS_WGU) + (size_t)l * 2 * DFF * DM; d.K = DM; d.N = DFF; d.k0 = 64 * kb; d.n0 = n0;
            d.drow0 = 256 * (n0 >> 7) + 128 * m + (n0 & 127); d.sh = sht; d.shwp = (float*)(A->ws + WS_SHPG) + ((size_t)l * 32 + kb) * 3 * 2 * DFF; d.ntot = 2 * DFF; }
        else { const int kb = q / 64, nb = q % 64; d.W = A->in[I_WD] + (size_t)l * DFF * DM; d.WT = (bf16*)(A->ws + WS_WDN) + (size_t)l * DM * DFF; d.K = DFF; d.N = DM; d.k0 = 64 * kb; d.n0 = 32 * nb; d.drow0 = 32 * nb; d.sh = nullptr; d.shwp = nullptr; d.ntot = 0; }
    }
    return d;
}
__device__ __forceinline__ void convert_layer(ArgsP A, const Ctx& C, int l, int set, int jw, int nw) {
    LAS float* scr = (LAS float*)(C.lds + C.wave * 8448);
    LAS float* sht = (LAS float*)(C.lds + 69632);
    const float* mod = (const float*)(A->ws + WS_MOD);
    __syncthreads();
    for (int i = C.tid; i < 3 * DM; i += 512) { const int c = i / DM, k = i % DM; sht[i] = mod[((size_t)l * 3 + c) * 12288 + (set ? 6144 : 0) + k]; }
    __syncthreads();
    const int nitems = set ? 3 * 5632 : 5632 + 2048;
    if (jw < nitems) {
        ConvItem c0 = conv_desc(A, l, set, jw, sht), c1, c2; float v0[32], v1[32], v2[32]; conv_load(c0, C.lane, v0);
        c1 = conv_desc(A, l, set, jw + nw < nitems ? jw + nw : 0, sht); conv_load(c1, C.lane, v1);
        int r = jw;
#define CONV_STEP(VA, CA, VC, CC) { CC = conv_desc(A, l, set, r + 2 * nw < nitems ? r + 2 * nw : 0, sht); conv_load(CC, C.lane, VC); conv_process(CA, C.lane, VA, scr); r += nw; if (r >= nitems) break; }
        for (;;) { CONV_STEP(v0, c0, v2, c2) CONV_STEP(v1, c1, v0, c0) CONV_STEP(v2, c2, v1, c1) }
#undef CONV_STEP
    }
    __syncthreads();
}
__device__ __forceinline__ void reduce_shw(ArgsP A, const Ctx& C, int l, int which, bool half_grid = true) {
    const int t0 = (int)blockIdx.x * (NWAVES * 64) + C.tid, nt = (half_grid ? C.G / 2 : C.G) * NWAVES * 64;
    if (which == 0) { const float* shpi = (const float*)(A->ws + WS_SHPI); float* shwi = (float*)(A->ws + WS_SHWI);
        for (int r = t0; r < 3 * DIN; r += nt) { float s = 0.f; for (int kb = 0; kb < 32; ++kb) s += shpi[((size_t)l * 32 + kb) * 3 * DIN + r]; shwi[(size_t)l * 3 * DIN + r] = s; } }
    else { const float* shpg = (const float*)(A->ws + WS_SHPG); float* shwg = (float*)(A->ws + WS_SHWG);
        for (int r = t0; r < 3 * 2 * DFF; r += nt) { float s = 0.f; for (int kb = 0; kb < 32; ++kb) s += shpg[((size_t)l * 32 + kb) * 3 * 2 * DFF + r]; shwg[(size_t)l * 3 * 2 * DFF + r] = s; } }
}
__device__ __forceinline__ void p0a(ArgsP A, const Ctx& C) {
    LAS float* st = (LAS float*)(C.lds + 98304);
    for (int i = C.tid; i < 3 * DM; i += 512) { const int c = i / DM, k = i % DM; const float x = (c == 0) ? A->in[I_CCTX][k] : A->in[I_C][(c - 1) * DM + k]; st[i] = x / (1.0f + expf(-x)); }
    __syncthreads();
    float* modp = (float*)(A->ws + WS_MODP);
    for (int it = C.gw; it < DEPTH * 32 * 48; it += C.ngw) {
        const int nb = it % 48, ks = (it / 48) % 32, l = it / (48 * 32), n = nb * 256 + C.lane * 4;
        const float* w = A->in[I_WMOD] + ((size_t)l * DM + ks * 64) * 12288 + n;
        f32x4 a0 = {0.f, 0.f, 0.f, 0.f}, a1 = a0, a2 = a0;
#pragma unroll 8
        for (int kk = 0; kk < 64; ++kk) { const f32x4 wv = __builtin_nontemporal_load((const f32x4*)(w + (size_t)kk * 12288)); const int k = ks * 64 + kk; a0 += st[k] * wv; a1 += st[DM + k] * wv; a2 += st[2 * DM + k] * wv; }
        float* o = modp + (((size_t)l * 32 + ks) * 3) * 12288 + n;
        *(f32x4*)o = a0; *(f32x4*)(o + 12288) = a1; *(f32x4*)(o + 2 * 12288) = a2;
    }
    lru_prep_wfrag(A, C);
    for (int i = C.gt; i < 2 * DB * DEPTH * 256 * 1024 / 8; i += C.ngt) {
        const int half = DB * DEPTH * 256 * 1024 / 8; const bool isk = i < half; const int j = isk ? i : i - half;
        const float* src = (isk ? A->in[I_CK] : A->in[I_CV]) + (size_t)j * 8; const f32x4 x0 = __builtin_nontemporal_load((const f32x4*)src), x1 = __builtin_nontemporal_load((const f32x4*)(src + 4));
        v4u o; o.x = pk2(x0.x, x0.y); o.y = pk2(x0.z, x0.w); o.z = pk2(x1.x, x1.y); o.w = pk2(x1.z, x1.w);
        *(v4u*)(A->ws + (isk ? WS_CKB : WS_CVB) + (size_t)j * 16) = o; }
}
__device__ __forceinline__ void p0b(ArgsP A, const Ctx& C) {
    const float* modp = (const float*)(A->ws + WS_MODP); float* mod = (float*)(A->ws + WS_MOD); float* gs = (float*)(A->ws + WS_GS);
    for (int i = C.gt; i < DEPTH * 3 * 12288; i += C.ngt) { const int n = i % 12288, c = (i / 12288) % 3, l = i / (3 * 12288);
        float s = A->in[I_BMOD][l * 12288 + n];
        for (int ks = 0; ks < 32; ++ks) s += modp[(((size_t)l * 32 + ks) * 3 + c) * 12288 + n];
        mod[i] = s;
        if (n >= 2048 && n < 4096) gs[(((size_t)l * 2 + 0) * 3 + c) * DM + (n - 2048)] = A->in[I_GMIX][l * DM + n - 2048] * (1.0f + s);
        if (n >= 8192 && n < 10240) gs[(((size_t)l * 2 + 1) * 3 + c) * DM + (n - 8192)] = A->in[I_GFFN][l * DM + n - 8192] * (1.0f + s); }
}
__device__ __forceinline__ void p0c(ArgsP A, const Ctx& C) {
    convert_layer(A, C, 0, 0, C.gw, C.ngw); convert_layer(A, C, 0, 1, C.gw, C.ngw);
    bf16* U = (bf16*)(A->ws + WS_U); float* hssq = (float*)(A->ws + WS_HSSQ); const float* gs0 = (const float*)(A->ws + WS_GS);
    for (int row = C.gw; row < MTOK; row += C.ngw) {
        const int cond = row < NCTX ? 0 : 1 + ((row - NCTX) >> 11);
        const float* hr = row < NCTX ? A->in[I_XP] + (size_t)row * DM : A->in[I_XS] + (size_t)(row - NCTX) * DM;
        const f32x4* xr = (const f32x4*)hr + C.lane; f32x4 v[8]; float s = 0.f;
#pragma unroll
        for (int j = 0; j < 8; ++j) { v[j] = __builtin_nontemporal_load(xr + 64 * j); s += (v[j].x * v[j].x + v[j].y * v[j].y) + (v[j].z * v[j].z + v[j].w * v[j].w); }
        s = wave_sum(s);
        if (C.lane < 32) hssq[(size_t)row * 32 + C.lane] = (C.lane == 0) ? s : 0.f;
#pragma unroll
        for (int j = 0; j < 8; ++j) { const int col = 4 * C.lane + 256 * j; const f32x4 y = v[j] * *(const f32x4*)(gs0 + (size_t)cond * DM + col);
            *(unsigned long long*)(U + (size_t)row * DM + col) = (unsigned long long)pk2(y.x, y.y) | ((unsigned long long)pk2(y.z, y.w) << 32); }
    }
}
__device__ __forceinline__ void p0d(ArgsP A, const Ctx& C) { reduce_shw(A, C, 0, 0, false); reduce_shw(A, C, 0, 1, false); }
__device__ __forceinline__ void mkctx(Ctx& C, LAS unsigned char* lds, const int wave) {
    int wv = wave; asm volatile("" : "+s"(wv));
    int t = wv * 64 + (int)__builtin_amdgcn_mbcnt_hi(~0u, __builtin_amdgcn_mbcnt_lo(~0u, 0u)); asm volatile("" : "+v"(t));
    C.lds = lds; C.tid = t; C.lane = t & 63; C.wave = wv;
    C.G = gridDim.x; C.gw = blockIdx.x * NWAVES + C.wave; C.ngw = C.G * NWAVES; C.gt = blockIdx.x * (NWAVES * 64) + t; C.ngt = C.G * NWAVES * 64;
}
__device__ __forceinline__ void m1_phase(ArgsP A, const Ctx& C, int l, float* outw) {
    const bf16* XIN = (const bf16*)(A->ws + WS_XIN); bf16* MIX = (bf16*)(A->ws + WS_MIX);
    const int half_g = C.G / 2, lt = ((int)blockIdx.x - half_g) * (NWAVES * 64) + C.tid, nlt = (C.G - half_g) * NWAVES * 64;
    if ((int)blockIdx.x >= half_g)
    for (int it = lt; it < (MTOK / 4) * 64; it += nlt) {
        const int ch = it & 63, row0 = (it >> 6) * 4, c0 = ch * 8; int t0, T; if (row0 < NCTX) { t0 = row0 & 255; T = SEQ; } else { t0 = (row0 - NCTX) & 2047; T = DSEQ; }
        v4u cg[6], sx[6], sb[4];
#pragma unroll
        for (int j = 0; j < 6; ++j) { const int tt = t0 + j - 1; cg[j] = (v4u){0u, 0u, 0u, 0u}; sx[j] = cg[j];
            if (tt >= 0 && tt < T) { const bf16* rp = XIN + (size_t)(row0 + j - 1) * DIN; cg[j] = *(const v4u*)(rp + C_SCG + c0); sx[j] = *(const v4u*)(rp + C_SX + c0); } }
#pragma unroll
        for (int j = 0; j < 4; ++j) sb[j] = *(const v4u*)(XIN + (size_t)(row0 + j) * DIN + C_SB + c0);
        float w[3][8];
#pragma unroll
        for (int dk = 0; dk < 3; ++dk)
#pragma unroll
            for (int i = 0; i < 8; ++i) w[dk][i] = A->in[I_SCW][(l * 3 + dk) * DSC + c0 + i];
        float z[6][8];
#pragma unroll
        for (int j = 0; j < 6; ++j) { z[j][0] = bflo(cg[j].x) * bflo(sx[j].x); z[j][1] = bfhi(cg[j].x) * bfhi(sx[j].x); z[j][2] = bflo(cg[j].y) * bflo(sx[j].y); z[j][3] = bfhi(cg[j].y) * bfhi(sx[j].y);
            z[j][4] = bflo(cg[j].z) * bflo(sx[j].z); z[j][5] = bfhi(cg[j].z) * bfhi(sx[j].z); z[j][6] = bflo(cg[j].w) * bflo(sx[j].w); z[j][7] = bfhi(cg[j].w) * bfhi(sx[j].w); }
#pragma unroll
        for (int j = 0; j < 4; ++j) { float acc[8];
#pragma unroll
            for (int i = 0; i < 8; ++i) acc[i] = w[0][i] * z[j][i] + w[1][i] * z[j + 1][i] + w[2][i] * z[j + 2][i];
            v4u o; o.x = pk2(bflo(sb[j].x) * acc[0], bfhi(sb[j].x) * acc[1]); o.y = pk2(bflo(sb[j].y) * acc[2], bfhi(sb[j].y) * acc[3]); o.z = pk2(bflo(sb[j].z) * acc[4], bfhi(sb[j].z) * acc[5]); o.w = pk2(bflo(sb[j].w) * acc[6], bfhi(sb[j].w) * acc[7]);
            *(v4u*)(MIX + (size_t)(row0 + j) * DM + 1536 + c0) = o; }
    }
    for (int u = blockIdx.x; u < 256; u += C.G) {
        if (u < 128) lru_unit<false>(A, C, l, NB + (u >> 6), (u >> 3) & 7, (u >> 1) & 3, u & 1, outw);
        else { const int v = u - 128; lru_unit<true>(A, C, l, v >> 3, 0, (v >> 1) & 3, v & 1, outw); }
    }
}
__device__ __forceinline__ void m2_phase(ArgsP A, LAS unsigned char* lds, const int wave0, int l, float* outw) {
    { Ctx C; mkctx(C, lds, wave0);
      for (int u = blockIdx.x; u < 256; u += C.G) { if (u < 128) attn_unit<true>(A, C, l, u, outw); else attn_unit<false>(A, C, l, u - 128, outw); } }
    { Ctx C; mkctx(C, lds, wave0);
      for (int u = (int)((blockIdx.x + (unsigned)C.G - (128u % (unsigned)C.G)) % (unsigned)C.G); u < 128; u += C.G) lru_unit<true>(A, C, l, NB + (u >> 6), (u >> 3) & 7, (u >> 1) & 3, u & 1, outw); }
}

#define PHASE_BEGIN() ArgsP A = (ArgsP)__builtin_amdgcn_kernarg_segment_ptr(); asm volatile("" : "+s"(A)); Ctx C; mkctx(C, (LAS unsigned char*)lds_raw, wave0); \
    float* mod = (float*)(A->ws + WS_MOD); bf16* U = (bf16*)(A->ws + WS_U); bf16* XIN = (bf16*)(A->ws + WS_XIN); bf16* ACT = (bf16*)(A->ws + WS_ACT); bf16* MIX = (bf16*)(A->ws + WS_MIX); \
    float* outw = A->out; (void)mod; (void)U; (void)XIN; (void)ACT; (void)MIX; (void)outw;
__global__ void __launch_bounds__(NWAVES * 64, 2) fwd(Args A_) {
    extern __shared__ __attribute__((aligned(16))) unsigned char lds_raw[];
    const int wave0 = __builtin_amdgcn_readfirstlane((int)threadIdx.x >> 6);
    { const int t0 = threadIdx.x; for (int u = t0; u < (LDS_BYTES - LDSCTL_OFF) / 4; u += NWAVES * 64) ((LAS unsigned*)((LAS unsigned char*)lds_raw + LDSCTL_OFF))[u] = 0u; }
    __syncthreads();
    volatile LAS unsigned* MISC = (volatile LAS unsigned*)((LAS unsigned char*)lds_raw + MISC_OFF);
    unsigned* barw = (unsigned*)(A_.ws + WS_CTL) + CW_BAR;
    XcdBarrier bar; bar.bar = barw; bar.x = 0; bar.st = nullptr;
    if (MK_MODE == 0) bar = xcd_barrier_post(barw, MISC + 8);
    const int lo = A_.ph_lo, hi = A_.ph_hi;
#define IN(k) (lo <= (k) && (k) < hi)
#define SEAM(k) do { if (IN(k) && IN((k) + 1)) xcd_barrier(bar); } while (0)
    if (IN(0)) { PHASE_BEGIN(); p0a(A, C); } SEAM(0);
    if (IN(1)) { PHASE_BEGIN(); p0b(A, C); } SEAM(1);
    if (IN(2)) { PHASE_BEGIN(); p0c(A, C); } SEAM(2);
    if (IN(3)) { PHASE_BEGIN(); p0d(A, C); } SEAM(3);
    for (int l = 0; l < DEPTH; ++l) {
        const int s0 = NPRO + l * STEPS_PER_LAYER;
        if (IN(s0 + 0)) { PHASE_BEGIN();
            pg8::Gemm g{U, (const bf16*)(A->ws + WS_WIN) + (size_t)l * DIN * DM, MTOK, DIN, DM}; pg8::StaticOrder S; S.init(MTOK, DIN, C.G, (int)blockIdx.x);
            const pg8::RstdTab rt = pg8::rstd_table(C.lds, S, (const float*)(A->ws + WS_HSSQ), C.tid);
            pg8::EpiIn E{XIN, (float*)(A->ws + WS_SSQ), outw + OUT_V + (size_t)l * SEQ * DATT, (const float*)(A->ws + WS_HSSQ), (const float*)(A->ws + WS_SHWI) + (size_t)l * 3 * DIN, rt};
            pg8::gemm_phase<pg8::EpiIn, pg8::StaticOrder, false, true>(C.lds + RING_OFF, g, S, E, wave0);
            { const int rem = (MTOK / 256 * (DIN / 256)) % C.G; if (l + 1 < DEPTH && rem && (int)blockIdx.x >= rem) convert_layer(A, C, l + 1, 0, ((int)blockIdx.x - rem) * NWAVES + C.wave, (C.G - rem) * NWAVES); }
        } SEAM(s0 + 0);
        if (IN(s0 + 1)) { PHASE_BEGIN(); if ((int)blockIdx.x < C.G / 2) { if (l + 1 < DEPTH) reduce_shw(A, C, l + 1, 0); if (l >= 1) reduce_shw(A, C, l, 1); } m1_phase(A, C, l, outw); m2_phase(A, (LAS unsigned char*)lds_raw, wave0, l, outw); } SEAM(s0 + 1);
        if (IN(s0 + 2)) { PHASE_BEGIN();
            pg8::Gemm g{MIX, (const bf16*)(A->ws + WS_WOUT) + (size_t)l * DM * DM, MTOK, DM, DM}; pg8::StaticOrder S; S.init(MTOK, DM, C.G, (int)blockIdx.x);
            bf16* HB = (bf16*)(A->ws + WS_HB);
            pg8::EpiRes E{A->in[I_XP], A->in[I_XS], (l == 0) ? (const bf16*)nullptr : (const bf16*)HB, nullptr, HB, mod + (size_t)l * 3 * 12288 + 4096, (const float*)(A->ws + WS_GS) + ((size_t)l * 2 + 1) * 3 * DM, U, (float*)(A->ws + WS_HSSQ)};
            pg8::gemm_phase<pg8::EpiRes, pg8::StaticOrder, true, true>(C.lds + RING_OFF, g, S, E, wave0);
        } SEAM(s0 + 2);
        if (IN(s0 + 3)) { PHASE_BEGIN();
            pg8::Gemm g{U, (const bf16*)(A->ws + WS_WGU) + (size_t)l * 2 * DFF * DM, MTOK, 2 * DFF, DM}; pg8::StaticOrder S; S.init(MTOK, 2 * DFF, C.G, (int)blockIdx.x);
            const pg8::RstdTab rt = pg8::rstd_table(C.lds, S, (const float*)(A->ws + WS_HSSQ), C.tid);
            pg8::EpiSwiGLU E{ACT, (const float*)(A->ws + WS_HSSQ), (const float*)(A->ws + WS_SHWG) + (size_t)l * 3 * 2 * DFF, rt};
            pg8::gemm_phase<pg8::EpiSwiGLU, pg8::StaticOrder, false, true>(C.lds + RING_OFF, g, S, E, wave0);
            { const int rem = (MTOK / 256 * (2 * DFF / 256)) % C.G; if (l + 1 < DEPTH && rem && (int)blockIdx.x >= rem) convert_layer(A, C, l + 1, 1, ((int)blockIdx.x - rem) * NWAVES + C.wave, (C.G - rem) * NWAVES); }
        } SEAM(s0 + 3);
        if (IN(s0 + 4)) { PHASE_BEGIN();
            pg8::Gemm g{ACT, (const bf16*)(A->ws + WS_WDN) + (size_t)l * DM * DFF, MTOK, DM, DFF}; pg8::StaticOrder S; S.init(MTOK, DM, C.G, (int)blockIdx.x);
            bf16* HB = (bf16*)(A->ws + WS_HB); const bool last = (l + 1 == DEPTH);
            pg8::EpiRes E{nullptr, nullptr, HB, outw, last ? (bf16*)nullptr : HB, mod + (size_t)l * 3 * 12288 + 10240, last ? (const float*)nullptr : (const float*)(A->ws + WS_GS) + ((size_t)(l + 1) * 2 + 0) * 3 * DM, U, (float*)(A->ws + WS_HSSQ)};
            pg8::gemm_phase<pg8::EpiRes, pg8::StaticOrder, true, true>(C.lds + RING_OFF, g, S, E, wave0);
        } SEAM(s0 + 4);
    }
#undef IN
#undef SEAM
}

extern "C" void kernel_launch(void* const* d_in, const int* in_sizes, int n_in, void* d_out, int out_size, void* d_ws, size_t ws_size, hipStream_t stream) {
    static int grid = 0;
    if (grid == 0) {
        if (n_in != 27 || (size_t)out_size != OUT_END || ws_size < WS_END3) { fprintf(stderr, "kernel_launch: shape mismatch: n_in %d out %d ws %zu (need 27, %zu, >= %zu)\n", n_in, out_size, ws_size, (size_t)OUT_END, (size_t)WS_END3); grid = -1; return; }
        int dev = 0, cus = 0, per_cu = 0;
        if (hipGetDevice(&dev) != hipSuccess || hipDeviceGetAttribute(&cus, hipDeviceAttributeMultiprocessorCount, dev) != hipSuccess) { fprintf(stderr, "kernel_launch: device query failed\n"); grid = -1; return; }
        if (hipFuncSetAttribute((const void*)fwd, hipFuncAttributeMaxDynamicSharedMemorySize, LDS_BYTES) != hipSuccess) { fprintf(stderr, "kernel_launch: hipFuncSetAttribute failed\n"); grid = -1; return; }
        if (hipOccupancyMaxActiveBlocksPerMultiprocessor(&per_cu, (const void*)fwd, NWAVES * 64, LDS_BYTES) != hipSuccess || per_cu < 1) fprintf(stderr, "kernel_launch: note: occupancy query reports %d workgroups per CU\n", per_cu);
        (void)hipGetLastError();
        grid = cus;
    }
    if (grid < 0) return;
    if (hipMemsetAsync((char*)d_ws + WS_CTL, 0, CTL_ZERO_BYTES, stream) != hipSuccess) { fprintf(stderr, "kernel_launch: memset failed\n"); return; }
    Args a{};
    for (int i = 0; i < 27; ++i) a.in[i] = (const float*)d_in[i];
    a.out = (float*)d_out; a.ws = (unsigned char*)d_ws;
#if MK_MODE == 0
    a.ph_lo = 0; a.ph_hi = NSTEPS;
    hipLaunchKernelGGL(fwd, dim3(grid), dim3(NWAVES * 64), LDS_BYTES, stream, a);
#else
    for (int s = 0; s < NSTEPS; ++s) { a.ph_lo = s; a.ph_hi = s + 1; hipLaunchKernelGGL(fwd, dim3(grid), dim3(NWAVES * 64), LDS_BYTES, stream, a); }
#endif
    const hipError_t le = hipPeekAtLastError();
    if (le != hipSuccess) fprintf(stderr, "kernel_launch: launch failed: %s\n", hipGetErrorName(le));
}
```
